# Optimizing an MI355X kernel written in HIP

```python
import math
import jax, jax.numpy as jnp
from jax import lax
import numpy as np

D_MODEL = 1024
BATCH = 16
SEQ = 4096
DEPTH = 1

DIFF_HEADS = D_MODEL // 256
DIFF_QK_DIM = 64
DIFF_V_DIM = 2 * DIFF_QK_DIM
DIFF_WIDTH = DIFF_HEADS * DIFF_V_DIM
MOBA_HEADS = D_MODEL // 128
MOBA_HEAD_DIM = 64
MOBA_WIDTH = MOBA_HEADS * MOBA_HEAD_DIM
MOBA_BLOCK = 256
MOBA_TOPK = 3
MIX_WIDTH = DIFF_WIDTH + MOBA_WIDTH
Q_BLOCK = 128
DIFF_QK_COLS = DIFF_HEADS * 2 * DIFF_QK_DIM
IN_COLS = 2 * DIFF_QK_COLS + DIFF_WIDTH + 3 * MOBA_WIDTH
REL_BUCKETS = 32
REL_MAX_DIST = 128
N_BIAS_COLS = 2 * DIFF_HEADS + MOBA_HEADS
PEER_HEADS = 8
PEER_NKEYS = 128
PEER_N_EXPERTS = PEER_NKEYS * PEER_NKEYS
PEER_KEY_DIM = 128
PEER_TOPK = 16
PEER_CHUNK = 128
NORM_EPS = 1e-6
NEG_INF = -1e30

kernel_name = 'hymba_diffattn_moba_peer_block'


def rmsnorm(x, g):
    xf = x.astype(jnp.float32)
    y = xf * lax.rsqrt(jnp.mean(xf * xf, axis=-1, keepdims=True) + NORM_EPS)
    return (y * g.astype(jnp.float32)).astype(x.dtype)


def t5_bucket(n):
    max_exact = REL_BUCKETS // 2
    nf = jnp.maximum(n, 1).astype(jnp.float32)
    large = max_exact + (jnp.log(nf / max_exact) / math.log(REL_MAX_DIST / max_exact)
                         * (REL_BUCKETS - max_exact)).astype(jnp.int32)
    large = jnp.minimum(large, REL_BUCKETS - 1)
    return jnp.where(n < max_exact, n, large)


def diff_attention(q, k, v, lam, bias_t, lambda_init, subln_g):
    B, S = q.shape[0], q.shape[1]
    H = DIFF_HEADS
    nqb = S // Q_BLOCK
    scale = DIFF_QK_DIM ** -0.5
    qb = q.reshape(B, nqb, Q_BLOCK, H, 2, DIFF_QK_DIM).transpose(1, 0, 3, 4, 2, 5)
    kt = k.transpose(0, 2, 3, 1, 4)
    vt = v.transpose(0, 2, 1, 3)
    kpos = jnp.arange(S)

    def one_block(args):
        qi, i = args
        q_pos = i * Q_BLOCK + jnp.arange(Q_BLOCK)
        dist = q_pos[:, None] - kpos[None, :]
        bias = bias_t[:, :, jnp.clip(dist, 0, S - 1)].astype(jnp.float32)
        logits = jnp.einsum('bhmqd,bhmkd->bhmqk', qi, kt).astype(jnp.float32) * scale + bias[None]
        logits = jnp.where(dist >= 0, logits, NEG_INF)
        p = jax.nn.softmax(logits, axis=-1)
        attn = (p[:, :, 0] - lam * p[:, :, 1]).astype(vt.dtype)
        return jnp.einsum('bhqk,bhkd->bhqd', attn, vt)

    out = lax.map(one_block, (qb, jnp.arange(nqb)))
    out = out.transpose(1, 0, 3, 2, 4).reshape(B, S, H, DIFF_V_DIM)
    out = rmsnorm(out, subln_g) * (1.0 - lambda_init)
    return out.reshape(B, S, H * DIFF_V_DIM)


def moba_attention(q, k, v, bias_t):
    B, S = q.shape[0], q.shape[1]
    H, dh = MOBA_HEADS, MOBA_HEAD_DIM
    nblk = -(-S // MOBA_BLOCK)
    S_pad = nblk * MOBA_BLOCK
    nqb = S // Q_BLOCK
    scale = dh ** -0.5
    qt = q.transpose(0, 2, 1, 3)
    pad = ((0, 0), (0, 0), (0, S_pad - S), (0, 0))
    kb = jnp.pad(k.transpose(0, 2, 1, 3), pad).reshape(B, H, nblk, MOBA_BLOCK, dh)
    vb = jnp.pad(v.transpose(0, 2, 1, 3), pad).reshape(B, H, nblk, MOBA_BLOCK, dh)
    kmean = kb.astype(jnp.float32).mean(axis=3)
    gate = jnp.einsum('bhsd,bhnd->bhsn', qt.astype(jnp.float32), kmean)
    past = jnp.arange(nblk)[None, :] < (jnp.arange(S) // MOBA_BLOCK)[:, None]
    gate = jnp.where(past, gate, NEG_INF)
    ksel = min(MOBA_TOPK, nblk)
    _, sel = lax.top_k(gate, ksel)

    q_items = qt.reshape(B, H, nqb, Q_BLOCK, dh).transpose(0, 2, 1, 3, 4).reshape(B * nqb, H, Q_BLOCK, dh)
    sel_items = sel.reshape(B, H, nqb, Q_BLOCK, ksel).transpose(0, 2, 1, 3, 4).reshape(B * nqb, H, Q_BLOCK, ksel)
    b_ids = jnp.repeat(jnp.arange(B), nqb)
    qb_ids = jnp.tile(jnp.arange(nqb), B)
    head_ids = jnp.arange(H)
    offs = jnp.arange(MOBA_BLOCK)

    def one_item(args):
        qi, si, b, i = args
        kbb, vbb = kb[b], vb[b]
        q_pos = i * Q_BLOCK + jnp.arange(Q_BLOCK)
        own = (i * Q_BLOCK) // MOBA_BLOCK
        k_own = lax.dynamic_index_in_dim(kbb, own, axis=1, keepdims=False)
        v_own = lax.dynamic_index_in_dim(vbb, own, axis=1, keepdims=False)
        k_sel = kbb[head_ids[:, None, None], si]
        v_sel = vbb[head_ids[:, None, None], si]
        dist_sel = q_pos[None, :, None, None] - (si[..., None] * MOBA_BLOCK + offs)
        bias_sel = bias_t[head_ids[:, None, None, None], jnp.clip(dist_sel, 0, S_pad - 1)].astype(jnp.float32)
        l_sel = jnp.einsum('hqd,hqjpd->hqjp', qi, k_sel).astype(jnp.float32) * scale + bias_sel
        l_sel = jnp.where((si < own)[..., None], l_sel, NEG_INF)
        dist_own = q_pos[:, None] - (own * MOBA_BLOCK + offs)[None, :]
        bias_own = bias_t[:, jnp.clip(dist_own, 0, S_pad - 1)].astype(jnp.float32)
        l_own = jnp.einsum('hqd,hpd->hqp', qi, k_own).astype(jnp.float32) * scale + bias_own
        l_own = jnp.where(dist_own >= 0, l_own, NEG_INF)
        logits = jnp.concatenate([l_sel.reshape(H, Q_BLOCK, ksel * MOBA_BLOCK), l_own], axis=-1)
        p = jax.nn.softmax(logits, axis=-1).astype(v.dtype)
        p_sel = p[..., :ksel * MOBA_BLOCK].reshape(H, Q_BLOCK, ksel, MOBA_BLOCK)
        p_own = p[..., ksel * MOBA_BLOCK:]
        return (jnp.einsum('hqjp,hqjpd->hqd', p_sel, v_sel)
                + jnp.einsum('hqp,hpd->hqd', p_own, v_own))

    out = lax.map(one_item, (q_items, sel_items, b_ids, qb_ids))
    out = out.reshape(B, nqb, H, Q_BLOCK, dh).transpose(0, 1, 3, 2, 4)
    return out.reshape(B, S, H * dh)


def peer(h, wq, sub_keys, exp_u, exp_v):
    B, S, D = h.shape
    tokens = h.reshape(-1, PEER_CHUNK, D)

    def chunk(hc):
        T = hc.shape[0]
        q = (hc @ wq).reshape(T, PEER_HEADS, 2, PEER_KEY_DIM)
        s1 = jnp.einsum('thd,hnd->thn', q[:, :, 0], sub_keys[:, 0]).astype(jnp.float32)
        s2 = jnp.einsum('thd,hnd->thn', q[:, :, 1], sub_keys[:, 1]).astype(jnp.float32)
        v1, i1 = lax.top_k(s1, PEER_TOPK)
        v2, i2 = lax.top_k(s2, PEER_TOPK)
        cand = (v1[..., :, None] + v2[..., None, :]).reshape(T, PEER_HEADS, PEER_TOPK * PEER_TOPK)
        sc, ci = lax.top_k(cand, PEER_TOPK)
        e = (jnp.take_along_axis(i1, ci // PEER_TOPK, axis=-1) * PEER_NKEYS
             + jnp.take_along_axis(i2, ci % PEER_TOPK, axis=-1))
        g = jax.nn.softmax(sc, axis=-1)
        u_g = exp_u[e]
        act = jax.nn.gelu(jnp.einsum('td,thkd->thk', hc, u_g).astype(jnp.float32), approximate=False)
        w = (g * act).astype(hc.dtype)
        return jnp.einsum('thk,thkd->td', w, exp_v[e])

    return lax.map(chunk, tokens).reshape(B, S, D)


def setup_inputs(seed: int = 0) -> dict:
    key = jax.random.key(seed)
    ks = jax.random.split(key, 18)
    D = D_MODEL
    f32 = jnp.float32
    nrm = lambda k, shape, s: jax.random.normal(k, shape, f32) * s
    return {
        'x': nrm(ks[0], (BATCH, SEQ, D), 1.0),
        'c': nrm(ks[1], (BATCH, D), 1.0),
        'rel_bias': nrm(ks[2], (REL_BUCKETS, N_BIAS_COLS), 0.5),
        'w_ada': nrm(ks[3], (DEPTH, D, 6 * D), D ** -0.5),
        'b_ada': nrm(ks[4], (DEPTH, 6 * D), 0.02),
        'norm1_g': 1.0 + nrm(ks[5], (DEPTH, D), 0.05),
        'w_in': nrm(ks[6], (DEPTH, D, IN_COLS), D ** -0.5),
        'diff_lambda': nrm(ks[7], (DEPTH, 4, DIFF_QK_DIM), 0.1),
        'diff_subln_g': 1.0 + nrm(ks[8], (DEPTH, DIFF_V_DIM), 0.05),
        'w_out': nrm(ks[9], (DEPTH, MIX_WIDTH, D), MIX_WIDTH ** -0.5),
        'norm2_g': 1.0 + nrm(ks[10], (DEPTH, D), 0.05),
        'peer_wq': nrm(ks[11], (DEPTH, D, PEER_HEADS * 2 * PEER_KEY_DIM), D ** -0.5),
        'peer_keys': nrm(ks[12], (DEPTH, PEER_HEADS, 2, PEER_NKEYS, PEER_KEY_DIM), PEER_KEY_DIM ** -0.5),
        'peer_u': nrm(ks[13], (DEPTH, PEER_N_EXPERTS, D), D ** -0.5),
        'peer_v': nrm(ks[14], (DEPTH, PEER_N_EXPERTS, D), PEER_HEADS ** -0.5),
        'final_g': 1.0 + nrm(ks[15], (D,), 0.05),
    }


def reference(x, c, rel_bias, w_ada, b_ada, norm1_g, w_in, diff_lambda, diff_subln_g,
              w_out, norm2_g, peer_wq, peer_keys, peer_u, peer_v, final_g):
    B, S, D = x.shape
    S_pad = -(-S // MOBA_BLOCK) * MOBA_BLOCK
    bias_by_dist = rel_bias[t5_bucket(jnp.arange(S_pad))]
    diff_bias_t = bias_by_dist[:, :2 * DIFF_HEADS].reshape(S_pad, 2, DIFF_HEADS).transpose(2, 1, 0)
    moba_bias_t = bias_by_dist[:, 2 * DIFF_HEADS:].T
    c_act = jax.nn.silu(c)
    splits = np.cumsum([DIFF_QK_COLS, DIFF_QK_COLS, DIFF_WIDTH, MOBA_WIDTH, MOBA_WIDTH]).tolist()
    for l in range(DEPTH):
        mod = c_act @ w_ada[l] + b_ada[l]
        sh1, sc1, g1, sh2, sc2, g2 = jnp.split(mod, 6, axis=-1)
        h = rmsnorm(x, norm1_g[l]) * (1.0 + sc1[:, None]) + sh1[:, None]
        proj = h @ w_in[l]
        dq, dk, dv, mq, mk, mv = jnp.split(proj, splits, axis=-1)
        lambda_init = 0.8 - 0.6 * math.exp(-0.3 * l)
        lp = diff_lambda[l].astype(jnp.float32)
        lam = jnp.exp(jnp.sum(lp[0] * lp[1])) - jnp.exp(jnp.sum(lp[2] * lp[3])) + lambda_init
        d_out = diff_attention(
            dq.reshape(B, S, DIFF_HEADS, 2, DIFF_QK_DIM),
            dk.reshape(B, S, DIFF_HEADS, 2, DIFF_QK_DIM),
            dv.reshape(B, S, DIFF_HEADS, DIFF_V_DIM),
            lam, diff_bias_t, lambda_init, diff_subln_g[l])
        m_out = moba_attention(
            mq.reshape(B, S, MOBA_HEADS, MOBA_HEAD_DIM),
            mk.reshape(B, S, MOBA_HEADS, MOBA_HEAD_DIM),
            mv.reshape(B, S, MOBA_HEADS, MOBA_HEAD_DIM),
            moba_bias_t)
        mix = jnp.concatenate([d_out, m_out], axis=-1) @ w_out[l]
        x = x + g1[:, None] * mix
        h2 = rmsnorm(x, norm2_g[l]) * (1.0 + sc2[:, None]) + sh2[:, None]
        x = x + g2[:, None] * peer(h2, peer_wq[l], peer_keys[l], peer_u[l], peer_v[l])
    return rmsnorm(x, final_g)
```

```cpp
#include <hip/hip_runtime.h>
#include <type_traits>
#include <cstdio>
#include <cstdint>
#include <cmath>

#define LAS __attribute__((address_space(3)))
#define GAS __attribute__((address_space(1)))

constexpr int NB = 16, SEQ = 4096, DM = 1024, MT = NB * SEQ;
constexpr float NORM_EPS = 1e-6f, LOG2E = 1.4426950408889634f, C2 = 0.125f * LOG2E, NEGBIG = -1e30f;
constexpr int QKW = 2048;
constexpr int NEXP = 16384;

namespace pg8 {
#define PG8_LAS __attribute__((address_space(3)))
typedef unsigned short bf16_t;
typedef short bf16x8 __attribute__((ext_vector_type(8)));
typedef float f32x4 __attribute__((ext_vector_type(4)));
typedef unsigned u32x4 __attribute__((ext_vector_type(4)));
constexpr int BM = 256, BK = 64, HALF = 128, HTB = HALF * BK * 2  , STAGE_BYTES = 8 * HTB, NXCD = 8, WGM = 8;

__host__ __device__ __forceinline__ int lds_byte(int r, int c) { const int st = (r >> 4) * 2 + (c >> 5), rr = r & 15, cc = c & 31, ob = rr * 64 + cc * 2; return st * 1024 + (ob ^ (((ob >> 9) & 1) << 5)); }
__host__ __device__ __forceinline__ void stage_rc(int b, int& R, int& C) { const int st = b / 1024, sb = b % 1024, swz = sb ^ (((sb >> 9) & 1) << 5); R = (st >> 1) * 16 + swz / 64; C = (st & 1) * 32 + (swz % 64) / 2; }
__host__ __device__ __forceinline__ int perm32(int rho) { const int n = rho >> 4, i = rho & 15; return 8 * (i >> 2) + 4 * n + (i & 3); }

struct Unit { int pm, pn; };
struct Gemm { const bf16_t* A; const bf16_t* Bt; int M, N, K; };

struct StaticOrder {
    int nM, nN, nwg, G, c;
    __host__ __device__ void init(int M, int N, int G_, int c_) { nM = M / BM; nN = N / BM; nwg = nM * nN; G = G_; c = c_; }
    __host__ __device__ bool next(int i, Unit& u) const {
        const long L = (long)i * G + c; if (L >= nwg) return false;
        int wgid = (int)L; { const int q = nwg / NXCD, r = nwg % NXCD, xcd = wgid % NXCD, off = wgid / NXCD; wgid = (xcd < r ? xcd * (q + 1) : r * (q + 1) + (xcd - r) * q) + off; }
        const int nig = WGM * nN, gid = wgid / nig, fm = gid * WGM, gsz = (nM - fm) < WGM ? (nM - fm) : WGM;
        u.pm = fm + ((wgid % nig) % gsz); u.pn = (wgid % nig) / gsz; return true;
    }
    __device__ __forceinline__ void a_ready(const Unit&) const {}
    __device__ __forceinline__ void done(const Unit&) const {}
};

struct PanelOrder {
    int pm, n;
    __host__ __device__ bool next(int i, Unit& u) const { if (i >= n) return false; u.pm = pm; u.pn = i; return true; }
    __device__ __forceinline__ void a_ready(const Unit&) const {}
    __device__ __forceinline__ void done(const Unit&) const {}
};

typedef float f32x2 __attribute__((ext_vector_type(2)));
typedef unsigned u32x2 __attribute__((ext_vector_type(2)));
typedef __bf16 bf16x2_t __attribute__((ext_vector_type(2)));
__device__ __forceinline__ unsigned cvt_pk_bf16(float lo, float hi) { f32x2 v = {lo, hi}; bf16x2_t b = __builtin_convertvector(v, bf16x2_t); return __builtin_bit_cast(unsigned, b); }

struct EpiBf16 {
    static constexpr bool PERM = true, AFTER_DRAIN = false;
    bf16_t* O; int ldc;
    __device__ __forceinline__ void operator()(const f32x4 (&acc)[2][2][4][2], const Unit& u, int wr, int wc, int fr, int fq) const {
        const int row0 = u.pm * BM + wr * 64 + fr; const int col0 = u.pn * BM + wc * 32 + 8 * fq;
#pragma unroll
        for (int ai = 0; ai < 2; ++ai)
#pragma unroll
            for (int m = 0; m < 4; ++m) { bf16_t* rowp = O + (size_t)(row0 + ai * HALF + m * 16) * ldc + col0;
#pragma unroll
                for (int bj = 0; bj < 2; ++bj) { const f32x4 v0 = acc[ai][bj][m][0], v1 = acc[ai][bj][m][1];
                    u32x4 w; w.x = cvt_pk_bf16(v0[0], v0[1]); w.y = cvt_pk_bf16(v0[2], v0[3]); w.z = cvt_pk_bf16(v1[0], v1[1]); w.w = cvt_pk_bf16(v1[2], v1[3]);
                    *(u32x4*)(rowp + bj * HALF) = w; } }
    }
};
struct EpiVT {
    static constexpr bool PERM = true, AFTER_DRAIN = false;
    bf16_t* O; int ldc;
    __device__ __forceinline__ void operator()(const f32x4 (&acc)[2][2][4][2], const Unit& u, int wr, int wc, int fr, int fq) const {
        const int row0 = u.pm * BM + wr * 64 + fr; const int col0 = u.pn * BM + wc * 32 + 16 * (fq >> 1) + 4 * (fq & 1);
#pragma unroll
        for (int ai = 0; ai < 2; ++ai)
#pragma unroll
            for (int m = 0; m < 4; ++m) { bf16_t* rowp = O + (size_t)(row0 + ai * HALF + m * 16) * ldc + col0;
#pragma unroll
                for (int bj = 0; bj < 2; ++bj) { const f32x4 v0 = acc[ai][bj][m][0], v1 = acc[ai][bj][m][1];
                    u32x2 w0, w1; w0.x = cvt_pk_bf16(v0[0], v0[1]); w0.y = cvt_pk_bf16(v0[2], v0[3]); w1.x = cvt_pk_bf16(v1[0], v1[1]); w1.y = cvt_pk_bf16(v1[2], v1[3]);
                    *(u32x2*)(rowp + bj * HALF) = w0; *(u32x2*)(rowp + bj * HALF + 8) = w1; } }
    }
};
struct EpiQK {
    static constexpr bool PERM = true, AFTER_DRAIN = false;
    bf16_t* O; float* ksum; float qscale;
    __device__ __forceinline__ void operator()(const f32x4 (&acc)[2][2][4][2], const Unit& u, int wr, int wc, int fr, int fq) const {
        const int row0 = u.pm * BM + wr * 64 + fr; const int col0 = u.pn * BM + wc * 32 + 8 * fq;
        const float sc = (u.pn < 2 || (u.pn >= 4 && u.pn < 6)) ? qscale : 1.f;
#pragma unroll
        for (int ai = 0; ai < 2; ++ai)
#pragma unroll
            for (int m = 0; m < 4; ++m) { bf16_t* rowp = O + (size_t)(row0 + ai * HALF + m * 16) * 2048 + col0;
#pragma unroll
                for (int bj = 0; bj < 2; ++bj) { const f32x4 v0 = acc[ai][bj][m][0] * sc, v1 = acc[ai][bj][m][1] * sc;
                    u32x4 w; w.x = cvt_pk_bf16(v0[0], v0[1]); w.y = cvt_pk_bf16(v0[2], v0[3]); w.z = cvt_pk_bf16(v1[0], v1[1]); w.w = cvt_pk_bf16(v1[2], v1[3]);
                    *(u32x4*)(rowp + bj * HALF) = w; } }
        if (u.pn >= 6) {
            float* kdst = ksum + (size_t)u.pm * 512 + (u.pn - 6) * BM + wc * 32 + 8 * fq;
#pragma unroll
            for (int bj = 0; bj < 2; ++bj)
#pragma unroll
                for (int n = 0; n < 2; ++n)
#pragma unroll
                    for (int e = 0; e < 4; ++e) {
                        float s = 0.f;
#pragma unroll
                        for (int ai = 0; ai < 2; ++ai)
#pragma unroll
                            for (int m = 0; m < 4; ++m) s += acc[ai][bj][m][n][e];
                        s += __shfl_xor(s, 1); s += __shfl_xor(s, 2); s += __shfl_xor(s, 4); s += __shfl_xor(s, 8);
                        if (fr == 0) atomicAdd(kdst + bj * HALF + 4 * n + e, s);
                    }
        }
    }
};
struct EpiRes {
    static constexpr bool PERM = false, AFTER_DRAIN = false;
    const float* x; bf16_t* out; const float* mod;
    __device__ __forceinline__ void operator()(const f32x4 (&acc)[2][2][4][2], const Unit& u, int wr, int wc, int fr, int fq) const {
        const int row0 = u.pm * BM + wr * 64 + fr; const int col0 = u.pn * BM + wc * 32 + 4 * fq;
        const float* g1 = mod + (size_t)(u.pm >> 4) * 6144 + 2048 + col0;
        f32x4 gv[2][2];
#pragma unroll
        for (int bj = 0; bj < 2; ++bj)
#pragma unroll
            for (int n = 0; n < 2; ++n) gv[bj][n] = *(const f32x4*)(g1 + bj * HALF + n * 16);
#pragma unroll
        for (int ai = 0; ai < 2; ++ai)
#pragma unroll
            for (int m = 0; m < 4; ++m) { const size_t off = (size_t)(row0 + ai * HALF + m * 16) * 1024 + col0;
#pragma unroll
                for (int bj = 0; bj < 2; ++bj)
#pragma unroll
                    for (int n = 0; n < 2; ++n) { const f32x4 xv = *(const f32x4*)(x + off + bj * HALF + n * 16);
                        const f32x4 y = xv + gv[bj][n] * acc[ai][bj][m][n]; u32x2 w; w.x = cvt_pk_bf16(y[0], y[1]); w.y = cvt_pk_bf16(y[2], y[3]);
                        *(u32x2*)(out + off + (size_t)(row0 + ai * HALF + m * 16) * 1024 + bj * HALF + n * 16) = w; } }
    }
};
typedef unsigned u32x2v __attribute__((ext_vector_type(2)));
struct EpiSC {
    static constexpr bool PERM = false, AFTER_DRAIN = false;
    float* P;
    __device__ __forceinline__ void operator()(const f32x4 (&acc)[2][2][4][2], const Unit& u, int wr, int wc, int fr, int fq) const {
        const int row0 = wr * 64 + fr; const int cg0 = u.pn * 64 + wc * 8 + fq;
#pragma unroll
        for (int ai = 0; ai < 2; ++ai)
#pragma unroll
            for (int m = 0; m < 4; ++m) { const int r = row0 + ai * HALF + m * 16;
#pragma unroll
                for (int bj = 0; bj < 2; ++bj)
#pragma unroll
                    for (int n = 0; n < 2; ++n) { const f32x4 a = acc[ai][bj][m][n];
                        *(u32x2v*)((char*)P + ((size_t)(cg0 + bj * 32 + n * 4) * 256 + r) * 8) = (u32x2v){__builtin_bit_cast(unsigned, __builtin_amdgcn_cvt_pkrtz(a[0], a[1])), __builtin_bit_cast(unsigned, __builtin_amdgcn_cvt_pkrtz(a[2], a[3]))}; } }
    }
};
struct EpiF32 {
    static constexpr bool PERM = false, AFTER_DRAIN = false;
    float* O; int ldc;
    __device__ __forceinline__ void operator()(const f32x4 (&acc)[2][2][4][2], const Unit& u, int wr, int wc, int fr, int fq) const {
        const int row0 = u.pm * BM + wr * 64 + fr; const int col0 = u.pn * BM + wc * 32 + 4 * fq;
#pragma unroll
        for (int ai = 0; ai < 2; ++ai)
#pragma unroll
            for (int m = 0; m < 4; ++m) { const size_t off = (size_t)(row0 + ai * HALF + m * 16) * ldc + col0;
#pragma unroll
                for (int bj = 0; bj < 2; ++bj)
#pragma unroll
                    for (int n = 0; n < 2; ++n) *(f32x4*)(O + off + bj * HALF + n * 16) = acc[ai][bj][m][n]; }
    }
};

template <class Epi, class Sched, bool ALIGN_EPI = false, bool SP2 = false>
__device__ __forceinline__ void gemm_phase(PG8_LAS unsigned char* lds, const Gemm g, const Sched& S, const Epi& E) {
    const int tid = threadIdx.x, wid = __builtin_amdgcn_readfirstlane(tid >> 6), lane = tid & 63, wr = wid >> 2, wc = wid & 3, fr = lane & 15, fq = lane >> 4;
    const int K = g.K, nt = K / BK;
    unsigned voffA[2], voffB[2];
#pragma unroll
    for (int i = 0; i < 2; ++i) { int R, C; stage_rc(tid * 16 + i * 8192, R, C); const int Rb = Epi::PERM ? ((R & ~31) + perm32(R & 31)) : R;
        voffA[i] = (unsigned)(R * K + C) * 2u; voffB[i] = (unsigned)(Rb * K + C) * 2u; }
    const size_t kstep = (size_t)(BK * 2);
    const size_t hstep = (size_t)HALF * K * 2;
    const size_t tstep = 2 * hstep;
    const unsigned ldsw = (unsigned)wid * 1024u;
    const int aoff = lds_byte(wr * 64 + fr, fq * 8), boff = lds_byte(wc * 32 + fr, fq * 8);
#define PG8_SA(b, h) (((b) * 2 + (h)) * HTB)
#define PG8_SB(b, h) ((4 + (b) * 2 + (h)) * HTB)
#define PG8_STAGE(bufoff, gbase, voff) do { _Pragma("unroll") for (int _i = 0; _i < 2; ++_i) \
        __builtin_amdgcn_global_load_lds((const unsigned*)((const char*)(gbase) + (voff)[_i]), (PG8_LAS unsigned*)(lds + (bufoff) + ldsw + _i * 8192), 16, 0, 0); } while (0)
#define PG8_LDA(dst, b, h) do { _Pragma("unroll") for (int m = 0; m < 4; ++m) _Pragma("unroll") for (int k = 0; k < 2; ++k) dst[m][k] = *(const PG8_LAS bf16x8*)(lds + PG8_SA(b, h) + aoff + m * 2048 + k * 1024); } while (0)
#define PG8_LDB(dst, b, h) do { _Pragma("unroll") for (int n = 0; n < 2; ++n) _Pragma("unroll") for (int k = 0; k < 2; ++k) dst[n][k] = *(const PG8_LAS bf16x8*)(lds + PG8_SB(b, h) + boff + n * 2048 + k * 1024); } while (0)
#define PG8_MMA(ai, bj, At, Bt) do { __builtin_amdgcn_s_setprio(1); _Pragma("unroll") for (int m = 0; m < 4; ++m) _Pragma("unroll") for (int n = 0; n < 2; ++n) _Pragma("unroll") for (int k = 0; k < 2; ++k) \
        acc[ai][bj][m][n] = __builtin_amdgcn_mfma_f32_16x16x32_bf16(Bt[n][k], At[m][k], acc[ai][bj][m][n], 0, 0, 0); __builtin_amdgcn_s_setprio(0); } while (0)
#define PG8_WAIT_V(n) asm volatile("s_waitcnt vmcnt(" #n ")" ::: "memory")
#define PG8_WAIT_L(n) asm volatile("s_waitcnt lgkmcnt(" #n ")" ::: "memory")
#define PG8_BAR __builtin_amdgcn_s_barrier()
#define PG8_SCHED __builtin_amdgcn_sched_barrier(0)
    Unit cur, nxt; int ui = 0;
    if (!S.next(0, cur)) return;
    f32x4 acc[2][2][4][2];
#pragma unroll
    for (int a = 0; a < 2; ++a)
#pragma unroll
        for (int b = 0; b < 2; ++b)
#pragma unroll
            for (int m = 0; m < 4; ++m)
#pragma unroll
                for (int n = 0; n < 2; ++n) acc[a][b][m][n] = (f32x4){0.f, 0.f, 0.f, 0.f};
    bf16x8 At[4][2], B0[2][2], B1[2][2];
    const char* cA = (const char*)g.A + (size_t)cur.pm * tstep; const char* cB = (const char*)g.Bt + (size_t)cur.pn * tstep;
    S.a_ready(cur);
    if constexpr (SP2) {
        PG8_STAGE(PG8_SB(0, 0), cB, voffB); PG8_STAGE(PG8_SB(0, 1), cB + hstep, voffB); PG8_STAGE(PG8_SA(0, 0), cA, voffA); PG8_STAGE(PG8_SA(0, 1), cA + hstep, voffA);
        if (wr == 1) PG8_BAR;
        PG8_WAIT_V(2); PG8_BAR;
        PG8_STAGE(PG8_SB(1, 0), cB + kstep, voffB); PG8_STAGE(PG8_SA(1, 0), cA + kstep, voffA); PG8_STAGE(PG8_SB(1, 1), cB + hstep + kstep, voffB);
        PG8_WAIT_V(6); PG8_BAR;
    } else {
        PG8_STAGE(PG8_SB(0, 0), cB, voffB); PG8_STAGE(PG8_SA(0, 0), cA, voffA); PG8_STAGE(PG8_SB(0, 1), cB + hstep, voffB); PG8_STAGE(PG8_SA(0, 1), cA + hstep, voffA);
        if (wr == 1) PG8_BAR;
        PG8_WAIT_V(4); PG8_BAR;
        PG8_STAGE(PG8_SB(1, 0), cB + kstep, voffB); PG8_STAGE(PG8_SA(1, 0), cA + kstep, voffA); PG8_STAGE(PG8_SB(1, 1), cB + hstep + kstep, voffB);
        PG8_WAIT_V(6); PG8_BAR;
    }
    for (;;) {
        const bool has_next = S.next(ui + 1, nxt);
        const char* nA = has_next ? (const char*)g.A + (size_t)nxt.pm * tstep : cA; const char* nB = has_next ? (const char*)g.Bt + (size_t)nxt.pn * tstep : cB;
        for (int t = 0; t < nt; t += 2) {
            const bool last = (t == nt - 2);
            const char* a1 = cA + (size_t)(t + 1) * kstep;
            const char* a2 = last ? nA : cA + (size_t)(t + 2) * kstep; const char* b2 = last ? nB : cB + (size_t)(t + 2) * kstep;
            const char* a3 = a2 + kstep; const char* b3 = b2 + kstep;
            if (last && has_next) S.a_ready(nxt);
            if constexpr (SP2) {
            PG8_LDB(B0, 0, 0); PG8_LDB(B1, 0, 1); PG8_SCHED; PG8_LDA(At, 0, 0); PG8_STAGE(PG8_SA(1, 1), a1 + hstep, voffA);
            PG8_WAIT_V(8); PG8_WAIT_L(0); PG8_BAR; PG8_MMA(0, 0, At, B0); PG8_MMA(0, 1, At, B1); PG8_BAR; PG8_SCHED;
            PG8_LDA(At, 0, 1); PG8_STAGE(PG8_SB(0, 0), b2, voffB); PG8_STAGE(PG8_SB(0, 1), b2 + hstep, voffB); PG8_STAGE(PG8_SA(0, 0), a2, voffA);
            PG8_WAIT_V(8); PG8_WAIT_L(0); PG8_BAR; PG8_MMA(1, 0, At, B0); PG8_MMA(1, 1, At, B1); PG8_BAR; PG8_SCHED;
            PG8_LDB(B0, 1, 0); PG8_LDB(B1, 1, 1); PG8_SCHED; PG8_LDA(At, 1, 0); PG8_STAGE(PG8_SA(0, 1), a2 + hstep, voffA);
            PG8_WAIT_V(8); PG8_WAIT_L(0); PG8_BAR; PG8_MMA(0, 0, At, B0); PG8_MMA(0, 1, At, B1); PG8_BAR; PG8_SCHED;
            PG8_LDA(At, 1, 1); PG8_STAGE(PG8_SB(1, 0), b3, voffB); PG8_STAGE(PG8_SB(1, 1), b3 + hstep, voffB); PG8_STAGE(PG8_SA(1, 0), a3, voffA);
            PG8_WAIT_V(8); PG8_WAIT_L(0); PG8_BAR; PG8_MMA(1, 0, At, B0); PG8_MMA(1, 1, At, B1); PG8_BAR; PG8_SCHED;
            } else {
            PG8_LDB(B0, 0, 0); PG8_SCHED; PG8_LDA(At, 0, 0); PG8_STAGE(PG8_SA(1, 1), a1 + hstep, voffA);
            PG8_WAIT_L(8); PG8_BAR; PG8_WAIT_L(0); PG8_MMA(0, 0, At, B0); PG8_BAR; PG8_SCHED;
            PG8_LDB(B1, 0, 1); PG8_STAGE(PG8_SB(0, 0), b2, voffB);
            PG8_BAR; PG8_WAIT_L(0); PG8_MMA(0, 1, At, B1); PG8_BAR;
            PG8_LDA(At, 0, 1); PG8_STAGE(PG8_SA(0, 0), a2, voffA);
            PG8_BAR; PG8_WAIT_L(0); PG8_MMA(1, 0, At, B0); PG8_BAR; PG8_SCHED;
            PG8_STAGE(PG8_SB(0, 1), b2 + hstep, voffB);
            PG8_WAIT_V(6); PG8_BAR; PG8_MMA(1, 1, At, B1); PG8_BAR;
            PG8_LDB(B0, 1, 0); PG8_SCHED; PG8_LDA(At, 1, 0); PG8_STAGE(PG8_SA(0, 1), a2 + hstep, voffA);
            PG8_WAIT_L(8); PG8_BAR; PG8_WAIT_L(0); PG8_MMA(0, 0, At, B0); PG8_BAR; PG8_SCHED;
            PG8_LDB(B1, 1, 1); PG8_STAGE(PG8_SB(1, 0), b3, voffB);
            PG8_BAR; PG8_WAIT_L(0); PG8_MMA(0, 1, At, B1); PG8_BAR;
            PG8_LDA(At, 1, 1); PG8_STAGE(PG8_SA(1, 0), a3, voffA);
            PG8_BAR; PG8_WAIT_L(0); PG8_MMA(1, 0, At, B0); PG8_BAR; PG8_SCHED;
            PG8_STAGE(PG8_SB(1, 1), b3 + hstep, voffB);
            PG8_WAIT_V(6); PG8_BAR; PG8_MMA(1, 1, At, B1); PG8_BAR;
            }
        }
        if constexpr (ALIGN_EPI) { if (wr == 0) PG8_BAR; }
        if constexpr (!Epi::AFTER_DRAIN) { E(acc, cur, wr, wc, fr, fq); S.done(cur); }
        if (!has_next) break;
#pragma unroll
        for (int a = 0; a < 2; ++a)
#pragma unroll
            for (int b = 0; b < 2; ++b)
#pragma unroll
                for (int m = 0; m < 4; ++m)
#pragma unroll
                    for (int n = 0; n < 2; ++n) acc[a][b][m][n] = (f32x4){0.f, 0.f, 0.f, 0.f};
        cur = nxt; cA = nA; cB = nB; ++ui;
        if constexpr (ALIGN_EPI) { if (wr == 1) PG8_BAR; }
    }
    PG8_WAIT_V(0);
    if constexpr (!ALIGN_EPI) { if (wr == 0) PG8_BAR; }
    PG8_BAR;
    if constexpr (Epi::AFTER_DRAIN) { E.fused(acc, cur, wr, wc, fr, fq, lds, wid, lane); S.done(cur); }
#undef PG8_SA
#undef PG8_SB
#undef PG8_STAGE
#undef PG8_LDA
#undef PG8_LDB
#undef PG8_MMA
#undef PG8_WAIT_V
#undef PG8_WAIT_L
#undef PG8_BAR
#undef PG8_SCHED
}
}

typedef unsigned short bf16_t;
typedef short bf16x8 __attribute__((ext_vector_type(8)));
typedef float f32x4 __attribute__((ext_vector_type(4)));
typedef float f32x16 __attribute__((ext_vector_type(16)));
typedef unsigned u32x4 __attribute__((ext_vector_type(4)));
typedef unsigned u32x2 __attribute__((ext_vector_type(2)));
typedef __bf16 bf16x2v __attribute__((ext_vector_type(2)));
#define LDS_WAIT() asm volatile("s_waitcnt lgkmcnt(0)" ::: "memory")
__device__ __forceinline__ unsigned pk2(float lo, float hi) { return pg8::cvt_pk_bf16(lo, hi); }
__device__ __forceinline__ float bf_lo(unsigned w) { return __uint_as_float(w << 16); }
__device__ __forceinline__ float bf_hi(unsigned w) { return __uint_as_float(w & 0xffff0000u); }
__device__ __forceinline__ float wave_sum(float v) {
#pragma unroll
    for (int o = 1; o < 64; o <<= 1) v += __shfl_xor(v, o);
    return v;
}
__device__ __forceinline__ float swap32_f(float v) {
    auto rr = __builtin_amdgcn_permlane32_swap(__float_as_uint(v), __float_as_uint(v), false, false);
    return (threadIdx.x & 32) ? __uint_as_float(rr[0]) : __uint_as_float(rr[1]);
}
__device__ __forceinline__ float dot2bf(unsigned a, unsigned b, float acc) { return __builtin_amdgcn_fdot2_f32_bf16(__builtin_bit_cast(bf16x2v, a), __builtin_bit_cast(bf16x2v, b), acc, false); }

constexpr size_t MiB = 1u << 20;
constexpr size_t WS_CTL = 0, CTL_ZERO_BYTES = 1 * MiB;
constexpr size_t WS_KSUM = 512 * 1024;
constexpr size_t WS_MOD = 1 * MiB;
constexpr size_t WS_WQK = 2 * MiB;
constexpr size_t WS_WV = 6 * MiB;
constexpr size_t WS_WO = 8 * MiB;
constexpr size_t WS_WC = 10 * MiB;
constexpr size_t WS_U8 = 16 * MiB, WS_V8 = 32 * MiB;
constexpr size_t WS_US = 51 * MiB;
constexpr size_t WS_WB = 52 * MiB;
constexpr size_t WS_VS = 50 * MiB;
constexpr size_t WS_H = 128 * MiB;
constexpr size_t WS_QK = 256 * MiB;
constexpr size_t WS_VT = 512 * MiB;
constexpr size_t WS_AO = 640 * MiB, WS_H8 = 640 * MiB, WS_Y = 640 * MiB;
constexpr size_t WS_SCA = 256 * MiB, WS_SCB = 832 * MiB;
constexpr size_t WS_PART = 256 * MiB;
constexpr size_t WS_PE = 960 * MiB, WS_PG = 976 * MiB;
constexpr size_t WS_END = 1008 * MiB;
constexpr int CW_BAR = 4096;

constexpr int LDS_BYTES = 163840, MISC_OFF = LDS_BYTES - 256;

#define XB_TMO      128
#define XB_XCNT(j)  (256  + 64 * (j))
#define XB_XSUB(j)  (1280 + 64 * (j))
#define XB_XGEN(j)  (2304 + 64 * (j))
#define XB_TOP      3328
#define XB_TOPGEN   3392
#define XCD_BAR_WORDS 3456
#define XB_SPIN_CAP (1u << 18)
__device__ __forceinline__ unsigned xb_ld(unsigned* p)              { return __hip_atomic_load(p, __ATOMIC_RELAXED, __HIP_MEMORY_SCOPE_AGENT); }
__device__ __forceinline__ unsigned xb_add(unsigned* p, unsigned v) { return __hip_atomic_fetch_add(p, v, __ATOMIC_RELAXED, __HIP_MEMORY_SCOPE_AGENT); }
__device__ __forceinline__ unsigned xb_xcc_id() { return (unsigned)__builtin_amdgcn_s_getreg((3 << 11) | 20) & 0xFu; }
#define XB_SPIN(cond, bar) do { unsigned _sp = 0; while (cond) { __builtin_amdgcn_s_sleep(1); \
    if ((++_sp & 255u) == 0u) { if (xb_ld(&(bar)[XB_TMO])) break; if (_sp > XB_SPIN_CAP) { atomicAdd(&(bar)[XB_TMO], 1u); break; } } } } while (0)
struct XcdBarrier { unsigned* bar; unsigned x; volatile LAS unsigned* st; };
__device__ __forceinline__ XcdBarrier xcd_barrier_post(unsigned* bar, volatile LAS unsigned* st) {
    XcdBarrier b; b.bar = bar; b.x = xb_xcc_id(); b.st = st;
    if (threadIdx.x == 0) (void)xb_add(&bar[XB_XCNT(b.x)], 1u);
    return b;
}
__device__ __forceinline__ void xcd_barrier_complete(unsigned* bar, unsigned x, unsigned& nloc, unsigned& nx) {
    const unsigned G = gridDim.x * gridDim.y * gridDim.z;
    unsigned sum, cnt, mine, sp = 0u;
    for (;;) {
        sum = 0u; cnt = 0u; mine = 0u;
#pragma unroll
        for (unsigned j = 0; j < 16; ++j) { const unsigned c = xb_ld(&bar[XB_XCNT(j)]); sum += c; cnt += (c > 0u) ? 1u : 0u; mine = (j == x) ? c : mine; }
        if (sum == G) break;
        __builtin_amdgcn_s_sleep(1);
        if ((++sp & 255u) == 0u) { if (xb_ld(&bar[XB_TMO])) break; if (sp > XB_SPIN_CAP) { atomicAdd(&bar[XB_TMO], 1u); break; } }
    }
    nloc = mine > 0u ? mine : 1u; nx = cnt > 0u ? cnt : 1u;
}
__device__ __forceinline__ void xcd_barrier(const XcdBarrier& b) {
    asm volatile("s_waitcnt vmcnt(0)" ::: "memory");
    __syncthreads();
    if (threadIdx.x == 0) {
        unsigned* bar = b.bar;
        __builtin_amdgcn_s_waitcnt(0);
        unsigned nloc = b.st[0], nx = b.st[1];
        if (nloc == 0u) { xcd_barrier_complete(bar, b.x, nloc, nx); b.st[0] = nloc; b.st[1] = nx; }
        const unsigned old = xb_add(&bar[XB_XSUB(b.x)], 1u);
        const unsigned gen = old / nloc;
        if (old + 1u == (gen + 1u) * nloc) {
            __builtin_amdgcn_fence(__ATOMIC_RELEASE, "agent");
            asm volatile("s_waitcnt vmcnt(0)" ::: "memory");
            const unsigned og = xb_add(&bar[XB_TOP], 1u);
            const unsigned tg = og / nx;
            if (og + 1u == (tg + 1u) * nx) xb_add(&bar[XB_TOPGEN], 1u);
            else XB_SPIN(xb_ld(&bar[XB_TOPGEN]) == tg, bar);
            __builtin_amdgcn_fence(__ATOMIC_ACQUIRE, "agent");
            xb_add(&bar[XB_XGEN(b.x)], 1u);
            asm volatile("s_waitcnt vmcnt(0)" ::: "memory");
        } else {
            XB_SPIN(xb_ld(&bar[XB_XGEN(b.x)]) == gen, bar);
            __builtin_amdgcn_fence(__ATOMIC_ACQUIRE, "agent");
            asm volatile("s_waitcnt vmcnt(0)" ::: "memory");
        }
    }
    __syncthreads();
}

struct Frame {
    LAS unsigned char* lds;
    int tid, lane, wave, vcu, G;
    const float *x, *c, *rel_bias, *w_ada, *b_ada, *norm1_g, *w_in, *diff_lambda, *subln_g, *w_out, *norm2_g, *peer_wq, *peer_keys, *peer_u, *peer_v, *final_g;
    float* out; unsigned char* ws;
};

__device__ __forceinline__ void p0_transpose_item(const float* W, int K, int N, bf16_t* WT, int row_off, LAS float* scr, int item, int lane) {
    const int nblk = N / 32, kb = item / nblk, nb = item % nblk, k0 = 64 * kb, n0 = 32 * nb;
#pragma unroll 8
    for (int i = 0; i < 32; ++i) { const int kk = 2 * i + (lane >> 5); scr[kk * 33 + (lane & 31)] = W[(size_t)(k0 + kk) * N + n0 + (lane & 31)]; }
    LDS_WAIT(); asm volatile("" ::: "memory");
    const int c = lane & 7;
#pragma unroll
    for (int j = 0; j < 4; ++j) { const int n = (lane >> 3) + 8 * j; const LAS float* s = scr + (8 * c) * 33 + n;
        u32x4 o; o.x = pk2(s[0 * 33], s[1 * 33]); o.y = pk2(s[2 * 33], s[3 * 33]); o.z = pk2(s[4 * 33], s[5 * 33]); o.w = pk2(s[6 * 33], s[7 * 33]);
        *(u32x4*)(WT + (size_t)(row_off + n0 + n) * K + k0 + 8 * c) = o; }
    LDS_WAIT(); asm volatile("" ::: "memory");
}
__device__ __forceinline__ void p0_prologue(Frame& F) {
    const int tid = F.tid, lane = F.lane, wave = F.wave;
    float* mod = (float*)(F.ws + WS_MOD);
    for (int it = blockIdx.x; it < 96; it += F.G) {
        LAS float* sc = (LAS float*)F.lds;
        LAS float* red = (LAS float*)(F.lds + 65536);
        for (int idx = tid; idx < 16384; idx += 512) { const int b = idx >> 10, k = idx & 1023; const float v = F.c[idx]; sc[k * 16 + b] = v / (1.f + __expf(-v)); }
        __syncthreads();
        const int n0 = it * 64;
        float acc[16];
#pragma unroll
        for (int b = 0; b < 16; ++b) acc[b] = 0.f;
        const float* wp = F.w_ada + (size_t)(wave * 128) * 6144 + n0 + lane;
#pragma unroll 4
        for (int k = 0; k < 128; ++k) {
            const float wv = wp[(size_t)k * 6144];
            const LAS f32x4* s4 = (const LAS f32x4*)(sc + (wave * 128 + k) * 16);
#pragma unroll
            for (int q = 0; q < 4; ++q) { const f32x4 s = s4[q]; acc[4 * q + 0] += s[0] * wv; acc[4 * q + 1] += s[1] * wv; acc[4 * q + 2] += s[2] * wv; acc[4 * q + 3] += s[3] * wv; }
        }
#pragma unroll
        for (int b = 0; b < 16; ++b) red[(wave * 16 + b) * 64 + lane] = acc[b];
        __syncthreads();
        for (int o = tid; o < 1024; o += 512) { const int b = o >> 6, ln = o & 63; float s = F.b_ada[n0 + ln];
#pragma unroll
            for (int w = 0; w < 8; ++w) s += red[(w * 16 + b) * 64 + ln];
            mod[b * 6144 + n0 + ln] = s; }
        __syncthreads();
    }
    for (int it = blockIdx.x; it < 256; it += F.G) {
        const int g = it >> 4, k0 = (it & 15) * 64;
        LAS float* KK = (LAS float*)F.lds;
        LAS float* AA = (LAS float*)(F.lds + 67584);
#pragma unroll
        for (int i = 0; i < 8; ++i) { const int idx = tid * 4 + 2048 * i, n = idx >> 7, d = idx & 127; *(LAS f32x4*)(KK + n * 132 + d) = *(const f32x4*)(F.peer_keys + (size_t)g * 16384 + idx); }
#pragma unroll
        for (int i = 0; i < 4; ++i) { const int idx = tid * 4 + 2048 * i, r = idx >> 7, d = idx & 127; *(LAS f32x4*)(AA + r * 132 + d) = *(const f32x4*)(F.peer_wq + (size_t)(k0 + r) * 2048 + g * 128 + d); }
        __syncthreads();
        const int kk = tid & 63, nq = wave;
        float acc[16];
#pragma unroll
        for (int j = 0; j < 16; ++j) acc[j] = 0.f;
        for (int d4 = 0; d4 < 32; ++d4) {
            const f32x4 a = *(const LAS f32x4*)(AA + kk * 132 + 4 * d4);
#pragma unroll
            for (int j = 0; j < 16; ++j) { const f32x4 kv = *(const LAS f32x4*)(KK + (nq * 16 + j) * 132 + 4 * d4); acc[j] += a[0] * kv[0] + a[1] * kv[1] + a[2] * kv[2] + a[3] * kv[3]; }
        }
        bf16_t* wc = (bf16_t*)(F.ws + WS_WC);
#pragma unroll
        for (int j = 0; j < 16; ++j) wc[(size_t)(g * 128 + nq * 16 + j) * 1024 + k0 + kk] = (bf16_t)(pk2(acc[j], 0.f) & 0xffffu);
        __syncthreads();
    }
    {
        LAS float* scr = (LAS float*)(F.lds + wave * 8448);
        const int gw = F.vcu * 8 + wave, NGW = F.G * 8;
        bf16_t* wqk = (bf16_t*)(F.ws + WS_WQK); bf16_t* wv = (bf16_t*)(F.ws + WS_WV); bf16_t* wo = (bf16_t*)(F.ws + WS_WO);
        constexpr int I_IN = 16 * 96, I_O = 16 * 32;
        for (int it = gw; it < I_IN + I_O; it += NGW) {
            if (it < I_IN) {
                const int nb = it % 96, n0 = nb * 32;
                if (n0 < 1024) p0_transpose_item(F.w_in, 1024, 3072, wqk, 0, scr, it, lane);
                else if (n0 < 1536) p0_transpose_item(F.w_in, 1024, 3072, wv, -1024, scr, it, lane);
                else if (n0 < 2560) p0_transpose_item(F.w_in, 1024, 3072, wqk, -512, scr, it, lane);
                else p0_transpose_item(F.w_in, 1024, 3072, wv, -2048, scr, it, lane);
            } else p0_transpose_item(F.w_out, 1024, 1024, wo, 0, scr, it - I_IN, lane);
        }
    }
    {
        const int gw = F.vcu * 8 + wave, NGW = F.G * 8;
        float* us = (float*)(F.ws + WS_US);
        for (int e = gw; e < NEXP; e += NGW) {
            const f32x4* src = (const f32x4*)(F.peer_u + (size_t)e * 1024 + lane * 16);
            f32x4 a[4]; float mx = 0.f;
#pragma unroll
            for (int q = 0; q < 4; ++q) { a[q] = src[q]; mx = fmaxf(mx, fmaxf(fmaxf(fabsf(a[q][0]), fabsf(a[q][1])), fmaxf(fabsf(a[q][2]), fabsf(a[q][3])))); }
#pragma unroll
            for (int o = 1; o < 64; o <<= 1) mx = fmaxf(mx, __shfl_xor(mx, o));
            const float sc = mx > 0.f ? mx * (0.9f / 6.f) : 1.f, inv = 1.f / sc;
            if (lane == 0) us[e] = sc;
            unsigned w[2] = {0u, 0u};
#pragma unroll
            for (int q = 0; q < 4; ++q)
#pragma unroll
                for (int k = 0; k < 4; ++k) {
                    const float v = a[q][k], t = fabsf(v) * inv;
                    unsigned code = (t > 0.25f) + (t > 0.75f) + (t > 1.25f) + (t > 1.75f) + (t > 2.5f) + (t > 3.5f) + (t > 5.0f);
                    code |= (v < 0.f) ? 8u : 0u;
                    const int el = q * 4 + k;
                    w[el >> 3] |= code << (4 * (el & 7));
                }
            *(u32x2*)(F.ws + WS_U8 + (size_t)(lane >> 4) * (NEXP * 128) + (size_t)e * 128 + (lane & 15) * 8) = (u32x2){w[0], w[1]};
        }
    }
    {
        const int gw = F.vcu * 8 + wave, NGW = F.G * 8;
        float* vs = (float*)(F.ws + WS_VS);
        for (int e = gw; e < NEXP; e += NGW) {
            const f32x4* src = (const f32x4*)(F.peer_v + (size_t)e * 1024 + lane * 16);
            f32x4 a[4]; float mx = 0.f;
#pragma unroll
            for (int q = 0; q < 4; ++q) { a[q] = src[q]; mx = fmaxf(mx, fmaxf(fmaxf(fabsf(a[q][0]), fabsf(a[q][1])), fmaxf(fabsf(a[q][2]), fabsf(a[q][3])))); }
#pragma unroll
            for (int o = 1; o < 64; o <<= 1) mx = fmaxf(mx, __shfl_xor(mx, o));
            const float sc = mx > 0.f ? mx * (0.9f / 6.f) : 1.f, inv = 1.f / sc;
            if (lane == 0) vs[e] = sc;
            unsigned w[2] = {0u, 0u};
#pragma unroll
            for (int q = 0; q < 4; ++q)
#pragma unroll
                for (int k = 0; k < 4; ++k) {
                    const float v = a[q][k], t = fabsf(v) * inv;
                    unsigned code = (t > 0.25f) + (t > 0.75f) + (t > 1.25f) + (t > 1.75f) + (t > 2.5f) + (t > 3.5f) + (t > 5.0f);
                    code |= (v < 0.f) ? 8u : 0u;
                    const int el = q * 4 + k;
                    w[el >> 3] |= code << (4 * (el & 7));
                }
            unsigned o2[2] = {0u, 0u}; const int nn = lane & 15, gb = lane & 48;
#pragma unroll
            for (int j = 0; j < 16; ++j) { const unsigned w0 = __shfl(w[0], gb + j), w1 = __shfl(w[1], gb + j); const unsigned nib = (((nn < 8) ? w0 : w1) >> (4 * (nn & 7))) & 15u; o2[j >> 3] |= nib << (4 * (j & 7)); }
            *(u32x2*)(F.ws + WS_V8 + (size_t)(lane >> 4) * (NEXP * 128) + (size_t)e * 128 + (lane & 15) * 8) = (u32x2){o2[0], o2[1]};
        }
    }
}

template <bool WITH8> __device__ __forceinline__ void norm_phase(Frame& F, const float* xin, const float* g, int sh_off, int sc_off, bf16_t* H, unsigned char* H8) {
    const float* mod = (const float*)(F.ws + WS_MOD);
    for (int tile = blockIdx.x; tile < MT / 256; tile += F.G) {
        const int b = tile >> 4, r0 = tile * 256 + F.wave * 32;
        f32x4 A[4], Bv[4];
#pragma unroll
        for (int j = 0; j < 4; ++j) { const int cix = 4 * F.lane + 256 * j;
            const f32x4 gg = *(const f32x4*)(g + cix), sc = *(const f32x4*)(mod + b * 6144 + sc_off + cix);
            A[j] = gg * (sc + 1.0f); Bv[j] = *(const f32x4*)(mod + b * 6144 + sh_off + cix); }
#pragma unroll 2
        for (int rr = 0; rr < 32; ++rr) {
            const float* xr = xin + (size_t)(r0 + rr) * 1024 + 4 * F.lane;
            f32x4 v[4]; float s = 0.f;
#pragma unroll
            for (int j = 0; j < 4; ++j) {
                if constexpr (WITH8) { const u32x2 w = *(const u32x2*)((const bf16_t*)xin + (size_t)(r0 + rr) * 2048 + 4 * F.lane + 256 * j); v[j] = (f32x4){bf_lo(w.x), bf_hi(w.x), bf_lo(w.y), bf_hi(w.y)}; }
                else v[j] = *(const f32x4*)(xr + 256 * j);
                s += (v[j][0] * v[j][0] + v[j][1] * v[j][1]) + (v[j][2] * v[j][2] + v[j][3] * v[j][3]); }
            const float rstd = 1.0f / sqrtf(wave_sum(s) * (1.f / 1024.f) + NORM_EPS);
            bf16_t* hr = H + (size_t)(r0 + rr) * 1024 + 4 * F.lane;
#pragma unroll
            for (int j = 0; j < 4; ++j) { const f32x4 y = v[j] * rstd * A[j] + Bv[j]; u32x2 o; o.x = pk2(y[0], y[1]); o.y = pk2(y[2], y[3]); *(u32x2*)(hr + 256 * j) = o;
                if constexpr (WITH8) {
                    int wh = 0; wh = __builtin_amdgcn_cvt_pk_fp8_f32(y[0], y[1], wh, false); wh = __builtin_amdgcn_cvt_pk_fp8_f32(y[2], y[3], wh, true);
                    const auto h01 = __builtin_amdgcn_cvt_pk_f32_fp8(wh, false), h23 = __builtin_amdgcn_cvt_pk_f32_fp8(wh, true);
                    int wl = 0; wl = __builtin_amdgcn_cvt_pk_fp8_f32((y[0] - h01[0]) * 16.f, (y[1] - h01[1]) * 16.f, wl, false); wl = __builtin_amdgcn_cvt_pk_fp8_f32((y[2] - h23[0]) * 16.f, (y[3] - h23[1]) * 16.f, wl, true);
                    unsigned char* h8 = H8 + (size_t)(r0 + rr) * 2048 + 4 * F.lane + 256 * j;
                    *(int*)h8 = wh; *(int*)(h8 + 1024) = wl; } }
        }
    }
}

namespace att {
constexpr int LDS_TAB = 98304;
constexpr int LDS_KM = LDS_TAB + 8192;
constexpr int LDS_SG = LDS_KM + 4096;
constexpr int LDS_LAM = LDS_SG + 512;
constexpr float THR = 8.0f;
__device__ __forceinline__ int crow(int r, int hi) { return (r & 3) + 8 * (r >> 2) + 4 * hi; }
__device__ __forceinline__ float pair_max(float v) { auto rr = __builtin_amdgcn_permlane32_swap(__float_as_uint(v), __float_as_uint(v), false, false); return fmaxf(__uint_as_float(rr[0]), __uint_as_float(rr[1])); }
__device__ __forceinline__ float pair_sum(float v) { auto rr = __builtin_amdgcn_permlane32_swap(__float_as_uint(v), __float_as_uint(v), false, false); return __uint_as_float(rr[0]) + __uint_as_float(rr[1]); }
__device__ __forceinline__ float max3f(float a, float b, float c) { return fmaxf(fmaxf(a, b), c); }

template <bool DIFF>
__device__ __forceinline__ bool unit(LAS unsigned char* lds, const bf16_t* __restrict__ QK, const bf16_t* __restrict__ VT, bf16_t* AO, const float* __restrict__ ksum, int b, int hh, int qt, float& mshift) {
    constexpr int DV = DIFF ? 128 : 64, ND0 = DV / 32;
    constexpr int STG = DIFF ? 32768 : 16384, VOFF = DIFF ? 16384 : 8192;
    const int tid = threadIdx.x, lane = tid & 63, r32 = lane & 31, hi = lane >> 5;
    const int wid = __builtin_amdgcn_readfirstlane(tid >> 6);
    const int map = DIFF ? (wid >> 2) : 0;
    const int qw0 = DIFF ? (qt * 128 + 32 * (wid & 3)) : (qt * 256 + 32 * wid);
    const int qpos = qw0 + r32;
    const size_t tok0 = (size_t)b * SEQ;
    const int srow = wid * 8 + (lane >> 3), sch = (lane & 7) ^ ((srow >> 1) & 7);
    const bf16_t* kg0 = QK + (tok0 + srow) * QKW + (DIFF ? (512 + hh * 128) : (1536 + hh * 64)) + sch * 8;
    const bf16_t* vg0 = VT + (size_t)((DIFF ? hh * 128 : 512 + hh * 64) + srow) * MT + tok0 + sch * 8;
    const int kx = (r32 >> 1) & 7;
    const int kr_base = r32 * 128 + (DIFF ? map * 8192 : 0);
    const int vr_base = VOFF + r32 * 128;
    bf16x8 qf[4];
    {
        const bf16_t* qp = QK + (tok0 + qpos) * QKW + (DIFF ? (hh * 128 + map * 64) : (1024 + hh * 64)) + hi * 8;
#pragma unroll
        for (int s = 0; s < 4; ++s) qf[s] = *(const bf16x8*)(qp + 16 * s);
    }
    const LAS float* tab = (const LAS float*)(lds + LDS_TAB) + (DIFF ? (map * 4 + hh) : (8 + hh)) * 128;
    unsigned selmask = 0u;
    if constexpr (!DIFF) {
        LAS float* km = (LAS float*)(lds + LDS_KM);
        for (int i = tid; i < 1024; i += 512) { const int n = i >> 6, dd = i & 63; km[i] = ksum[(size_t)(b * 16 + n) * 512 + hh * 64 + dd] * (1.f / 256.f); }
        __syncthreads();
        float qv[32];
#pragma unroll
        for (int s = 0; s < 4; ++s)
#pragma unroll
            for (int j = 0; j < 8; ++j) qv[s * 8 + j] = __uint_as_float(((unsigned)(unsigned short)qf[s][j]) << 16);
        float v0 = -INFINITY, v1 = -INFINITY, v2 = -INFINITY; int i0 = -1, i1 = -1, i2 = -1;
        for (int n = 0; n < qt; ++n) {
            float part = 0.f;
#pragma unroll
            for (int s = 0; s < 4; ++s) {
                const f32x4 ka = *(const LAS f32x4*)(km + n * 64 + 16 * s + 8 * hi), kb = *(const LAS f32x4*)(km + n * 64 + 16 * s + 8 * hi + 4);
                part += qv[s * 8 + 0] * ka[0] + qv[s * 8 + 1] * ka[1] + qv[s * 8 + 2] * ka[2] + qv[s * 8 + 3] * ka[3] + qv[s * 8 + 4] * kb[0] + qv[s * 8 + 5] * kb[1] + qv[s * 8 + 6] * kb[2] + qv[s * 8 + 7] * kb[3];
            }
            const float gte = pair_sum(part);
            if (gte > v0) { v2 = v1; i2 = i1; v1 = v0; i1 = i0; v0 = gte; i0 = n; }
            else if (gte > v1) { v2 = v1; i2 = i1; v1 = gte; i1 = n; }
            else if (gte > v2) { v2 = gte; i2 = n; }
        }
        if (i0 >= 0) selmask |= 1u << i0;
        if (i1 >= 0) selmask |= 1u << i1;
        if (i2 >= 0) selmask |= 1u << i2;
    }
    const int NTILE = DIFF ? 2 * (qt + 1) : 4 * (qt + 1);
    auto tile_k0 = [&](int i) -> int { if constexpr (DIFF) return 64 * i; else return (i < 4) ? (qt * 256 + 64 * i) : (((i - 4) >> 2) * 256 + 64 * ((i - 4) & 3)); };
    auto stage_from = [&](const bf16_t* kp, const bf16_t* vp, int buf) {
        LAS unsigned char* sb = lds + buf * STG + wid * 1024;
        __builtin_amdgcn_global_load_lds((const unsigned*)kp, (LAS unsigned*)sb, 16, 0, 0);
        if constexpr (DIFF) {
            __builtin_amdgcn_global_load_lds((const unsigned*)(kp + 64), (LAS unsigned*)(sb + 8192), 16, 0, 0);
            __builtin_amdgcn_global_load_lds((const unsigned*)vp, (LAS unsigned*)(sb + VOFF), 16, 0, 0);
            __builtin_amdgcn_global_load_lds((const unsigned*)(vp + (size_t)64 * MT), (LAS unsigned*)(sb + VOFF + 8192), 16, 0, 0);
        } else {
            __builtin_amdgcn_global_load_lds((const unsigned*)vp, (LAS unsigned*)(sb + VOFF), 16, 0, 0);
        }
    };
    auto stage = [&](int k0, int buf) { stage_from(kg0 + (size_t)k0 * QKW, vg0 + k0, buf); };
    float m_ref = 0.f, l_run = 0.f, smax = 0.f;
    float cblk = 0.f;
    f32x16 o[ND0];
#pragma unroll
    for (int d0 = 0; d0 < ND0; ++d0) o[d0] = f32x16{};
    constexpr int NMF = 4 * ND0, EPM = 32 / NMF;
    u32x4 pkA[4], pkB[4];
    constexpr int VB = DIFF ? 1 : 2;
    bf16x8 vfr[VB][ND0];
    auto qk_tile = [&](int t, int bufi, int bufprev, f32x16& p0, f32x16& p1, auto firstc) {
        constexpr bool FIRST = decltype(firstc)::value;
        const int k0 = tile_k0(t);
        const LAS unsigned char* sb = lds + bufi * STG;
        if constexpr (!DIFF) {
            if (t >= 4 && ((t & 3) == 0)) { const bool msk = ((selmask >> ((t - 4) >> 2)) & 1u) == 0u; cblk = msk ? NEGBIG : -m_ref; }
        }
        bf16x8 kfa[4], kfb[4];
#pragma unroll
        for (int s = 0; s < 4; ++s) { const int co = ((2 * s + hi) ^ kx) << 4; kfa[s] = *(const LAS bf16x8*)(sb + kr_base + co); kfb[s] = *(const LAS bf16x8*)(sb + kr_base + 4096 + co); }
        if constexpr (!FIRST) {
            const LAS unsigned char* sp = lds + bufprev * STG;
#pragma unroll
            for (int ks = 0; ks < VB; ++ks) { const int vo = ((2 * ks + hi) ^ kx) << 4;
#pragma unroll
                for (int d0 = 0; d0 < ND0; ++d0) vfr[ks][d0] = *(const LAS bf16x8*)(sp + vr_base + d0 * 4096 + vo); }
        }
        __builtin_amdgcn_sched_barrier(0);
        if constexpr (FIRST) { p0 = __builtin_amdgcn_mfma_f32_32x32x16_bf16(kfa[0], qf[0], f32x16{}, 0, 0, 0); p1 = __builtin_amdgcn_mfma_f32_32x32x16_bf16(kfb[0], qf[0], f32x16{}, 0, 0, 0); }
        else {
            const float c0 = (!DIFF && t >= 4) ? cblk : -m_ref;
#pragma unroll
            for (int r = 0; r < 16; ++r) { p0[r] = c0; p1[r] = c0; }
            p0 = __builtin_amdgcn_mfma_f32_32x32x16_bf16(kfa[0], qf[0], p0, 0, 0, 0); p1 = __builtin_amdgcn_mfma_f32_32x32x16_bf16(kfb[0], qf[0], p1, 0, 0, 0); }
#pragma unroll
        for (int s = 1; s < 4; ++s) {
            p0 = __builtin_amdgcn_mfma_f32_32x32x16_bf16(kfa[s], qf[s], p0, 0, 0, 0);
            p1 = __builtin_amdgcn_mfma_f32_32x32x16_bf16(kfb[s], qf[s], p1, 0, 0, 0);
        }
        __builtin_amdgcn_sched_barrier(0);
        if (qw0 - (k0 + 63) < 128) {
            int dbase = qpos - k0 - 4 * hi; asm volatile("" : "+v"(dbase));
#pragma unroll
            for (int rq = 0; rq < 4; ++rq) {
#pragma unroll
                for (int r = 4 * rq; r < 4 * rq + 4; ++r) {
                    const int d0_ = dbase - crow(r, 0), d1_ = d0_ - 32;
                    const float b0 = tab[min(max(d0_, 0), 127)], b1 = tab[min(max(d1_, 0), 127)];
                    p0[r] = d0_ < 0 ? NEGBIG : p0[r] + b0; p1[r] = d1_ < 0 ? NEGBIG : p1[r] + b1;
                }
                __builtin_amdgcn_sched_barrier(0);
            }
        }
    };
    auto softmax_only = [&](f32x16& p0, f32x16& p1, u32x4 (&pkn)[4]) {
        float sum = 0.f;
#pragma unroll
        for (int r = 0; r < 16; ++r) { p0[r] = __builtin_amdgcn_exp2f(p0[r]); p1[r] = __builtin_amdgcn_exp2f(p1[r]); sum += p0[r] + p1[r]; }
        l_run += sum; smax = fmaxf(smax, sum);
        pkn[0] = (u32x4){pk2(p0[0], p0[1]), pk2(p0[2], p0[3]), pk2(p0[4], p0[5]), pk2(p0[6], p0[7])};
        pkn[1] = (u32x4){pk2(p0[8], p0[9]), pk2(p0[10], p0[11]), pk2(p0[12], p0[13]), pk2(p0[14], p0[15])};
        pkn[2] = (u32x4){pk2(p1[0], p1[1]), pk2(p1[2], p1[3]), pk2(p1[4], p1[5]), pk2(p1[6], p1[7])};
        pkn[3] = (u32x4){pk2(p1[8], p1[9]), pk2(p1[10], p1[11]), pk2(p1[12], p1[13]), pk2(p1[14], p1[15])};
    };
    auto pv_exp = [&](int bufprev, const u32x4 (&pkp)[4], f32x16& p0, f32x16& p1, u32x4 (&pkn)[4], auto withexp) {
        constexpr bool WE = decltype(withexp)::value;
        const LAS unsigned char* sp = lds + bufprev * STG;
        float sum = 0.f;
#pragma unroll
        for (int i = 0; i < NMF; ++i) {
            const int ks = i / ND0, d0 = i % ND0;
            const bf16x8 pf = __builtin_bit_cast(bf16x8, pkp[ks]);
            o[d0] = __builtin_amdgcn_mfma_f32_32x32x16_bf16(vfr[ks % VB][d0], pf, o[d0], 0, 0, 0);
            if (d0 == ND0 - 1 && ks + VB < 4) { const int vo = ((2 * (ks + VB) + hi) ^ kx) << 4;
#pragma unroll
                for (int dd = 0; dd < ND0; ++dd) vfr[ks % VB][dd] = *(const LAS bf16x8*)(sp + vr_base + dd * 4096 + vo); }
            if constexpr (WE) {
#pragma unroll
                for (int e2 = 0; e2 < EPM; e2 += 2) {
                    const int j = i * EPM + e2;
                    float a = (j < 16) ? p0[j] : p1[j - 16], b2 = (j < 16) ? p0[j + 1] : p1[j - 15];
                    a = __builtin_amdgcn_exp2f(a); b2 = __builtin_amdgcn_exp2f(b2);
                    sum += a; sum += b2;
                    unsigned wv = pk2(a, b2);
                    asm volatile("" : "+v"(wv), "+v"(sum));
                    pkn[j >> 3][(j >> 1) & 3] = wv;
                }
            }
            __builtin_amdgcn_sched_barrier(0);
        }
        l_run += sum; if constexpr (WE) smax = fmaxf(smax, sum);
    };
    stage(tile_k0(0), 0);
    __syncthreads();
    {
        f32x16 p0, p1;
        stage(tile_k0(1), 1);
        qk_tile(0, 0, 0, p0, p1, std::true_type{});
        float mx = max3f(p0[0], p0[1], p1[0]);
#pragma unroll
        for (int r = 2; r < 16; r += 2) mx = max3f(mx, p0[r], p0[r + 1]);
#pragma unroll
        for (int r = 1; r < 15; r += 2) mx = max3f(mx, p1[r], p1[r + 1]);
        mx = fmaxf(mx, p1[15]);
        m_ref = pair_max(mx) + mshift;
#pragma unroll
        for (int r = 0; r < 16; ++r) { p0[r] -= m_ref; p1[r] -= m_ref; }
        softmax_only(p0, p1, pkA);
        __syncthreads();
    }
    int bp = 0, bc = 1, bn = 2;
    for (int t = 1; t < NTILE; t += 2) {
        {   f32x16 p0, p1;
            if (t + 1 < NTILE) stage(tile_k0(t + 1), bn);
            qk_tile(t, bc, bp, p0, p1, std::false_type{});
            pv_exp(bp, pkA, p0, p1, pkB, std::true_type{});
            __syncthreads();
            const int tmp = bp; bp = bc; bc = bn; bn = tmp; }
        if (t + 1 < NTILE) {
            f32x16 p0, p1;
            if (t + 2 < NTILE) stage(tile_k0(t + 2), bn);
            qk_tile(t + 1, bc, bp, p0, p1, std::false_type{});
            pv_exp(bp, pkB, p0, p1, pkA, std::true_type{});
            __syncthreads();
            const int tmp = bp; bp = bc; bc = bn; bn = tmp; }
    }
    {
        const LAS unsigned char* sp = lds + bp * STG;
#pragma unroll
        for (int ks = 0; ks < VB; ++ks) { const int vo = ((2 * ks + hi) ^ kx) << 4;
#pragma unroll
            for (int d0 = 0; d0 < ND0; ++d0) vfr[ks][d0] = *(const LAS bf16x8*)(sp + vr_base + d0 * 4096 + vo); }
        f32x16 dz0, dz1;
        pv_exp(bp, pkB, dz0, dz1, pkA, std::false_type{});
        __syncthreads();
    }
    {
        const bool badl = !(smax <= 0x1p60f);
        const int badp = __shfl_xor((int)badl, 32);
        const bool badrow = badl || (badp != 0);
        if (badrow) mshift += 64.f;
        LAS unsigned* flag = (LAS unsigned*)(lds + MISC_OFF + 64);
        if (tid == 0) *flag = 0u;
        __syncthreads();
        if (badrow) *flag = 1u;
        __syncthreads();
        const bool redo = *flag != 0u;
        __syncthreads();
        if (redo) return true;
    }
    const float linv = 1.0f / pair_sum(l_run);
    if constexpr (DIFF) {
        LAS float* ex = (LAS float*)lds;
        if (map == 1) {
#pragma unroll
            for (int d0 = 0; d0 < ND0; ++d0)
#pragma unroll
                for (int r = 0; r < 16; ++r) ex[(d0 * 16 + r) * 256 + (wid & 3) * 64 + lane] = o[d0][r] * linv;
        }
        __syncthreads();
        if (map == 0) {
            const float lam = *(const LAS float*)(lds + LDS_LAM);
            const LAS float* sg = (const LAS float*)(lds + LDS_SG);
            float ss = 0.f;
#pragma unroll
            for (int d0 = 0; d0 < ND0; ++d0)
#pragma unroll
                for (int r = 0; r < 16; ++r) { const float v = o[d0][r] * linv - lam * ex[(d0 * 16 + r) * 256 + (wid & 3) * 64 + lane]; o[d0][r] = v; ss += v * v; }
            ss = pair_sum(ss);
            const float rstd = 0.8f / sqrtf(ss * (1.f / 128.f) + NORM_EPS);
            bf16_t* op = AO + (tok0 + qpos) * 1024 + hh * 128 + 4 * hi;
#pragma unroll
            for (int d0 = 0; d0 < ND0; ++d0)
#pragma unroll
                for (int rg = 0; rg < 4; ++rg) {
                    const int dcol = 32 * d0 + 8 * rg + 4 * hi;
                    const f32x4 gg = *(const LAS f32x4*)(sg + dcol);
                    u32x2 w; w.x = pk2(o[d0][4 * rg] * rstd * gg[0], o[d0][4 * rg + 1] * rstd * gg[1]); w.y = pk2(o[d0][4 * rg + 2] * rstd * gg[2], o[d0][4 * rg + 3] * rstd * gg[3]);
                    *(u32x2*)(op + 32 * d0 + 8 * rg) = w;
                }
        }
        __syncthreads();
    } else {
        bf16_t* op = AO + (tok0 + qpos) * 1024 + 512 + hh * 64 + 4 * hi;
#pragma unroll
        for (int d0 = 0; d0 < ND0; ++d0)
#pragma unroll
            for (int rg = 0; rg < 4; ++rg) {
                u32x2 w; w.x = pk2(o[d0][4 * rg] * linv, o[d0][4 * rg + 1] * linv); w.y = pk2(o[d0][4 * rg + 2] * linv, o[d0][4 * rg + 3] * linv);
                *(u32x2*)(op + 32 * d0 + 8 * rg) = w;
            }
    }
    return false;
}
}

__device__ __forceinline__ void attn_phase(Frame& F) {
    const int tid = F.tid;
    {
        LAS float* tabs = (LAS float*)(F.lds + att::LDS_TAB);
        for (int i = tid; i < 2048; i += 512) {
            const int col = i >> 7, n = i & 127;
            int bucket;
            if (n < 16) bucket = n;
            else { const float nf = (float)n; int lg = 16 + (int)(logf(nf / 16.0f) / 2.0794415416798357f * 16.0f); bucket = lg < 31 ? lg : 31; }
            tabs[col * 128 + n] = (F.rel_bias[bucket * 16 + col] - F.rel_bias[31 * 16 + col]) * LOG2E;
        }
        LAS float* sg = (LAS float*)(F.lds + att::LDS_SG);
        if (tid < 128) sg[tid] = F.subln_g[tid];
        if (F.wave == 7) {
            const float a = F.diff_lambda[F.lane] * F.diff_lambda[64 + F.lane], bq = F.diff_lambda[128 + F.lane] * F.diff_lambda[192 + F.lane];
            const float sa = wave_sum(a), sb = wave_sum(bq);
            if (F.lane == 0) *(LAS float*)(F.lds + att::LDS_LAM) = expf(sa) - expf(sb) + 0.2f;
        }
        __syncthreads();
    }
    const bf16_t* QK = (const bf16_t*)(F.ws + WS_QK); const bf16_t* VT = (const bf16_t*)(F.ws + WS_VT); bf16_t* AO = (bf16_t*)(F.ws + WS_AO);
    const float* ksum = (const float*)(F.ws + WS_KSUM);
    if (F.G == 256) {
        { const int bh = F.vcu >> 2, quarter = F.vcu & 3;
          for (int i = 0; i < 8; ++i) { const int s = quarter * 4 + (i >> 1), qt = (i & 1) ? 31 - s : s; const int i2 = i + 1, s2 = quarter * 4 + (i2 >> 1), qt2 = (i2 & 1) ? 31 - s2 : s2;
              (void)qt2; float msh = 0.f; for (int a = 0; a < 8 && att::unit<true>(F.lds, QK, VT, AO, ksum, bh >> 2, bh & 3, qt, msh); ++a) {} } }
        { const int bh = F.vcu >> 1, half = F.vcu & 1;
          for (int i = 0; i < 8; ++i) { const int s = half * 4 + (i >> 1), qt = (i & 1) ? 15 - s : s; const int i2 = i + 1, s2 = half * 4 + (i2 >> 1), qt2 = (i2 & 1) ? 15 - s2 : s2;
              (void)qt2; float msh = 0.f; for (int a = 0; a < 8 && att::unit<false>(F.lds, QK, VT, AO, ksum, bh >> 3, bh & 7, qt, msh); ++a) {} } }
    } else {
        for (int u = blockIdx.x; u < 2048; u += F.G) { const int bh = u >> 5; float msh = 0.f; for (int a = 0; a < 8 && att::unit<true>(F.lds, QK, VT, AO, ksum, bh >> 2, bh & 3, u & 31, msh); ++a) {} }
        for (int u = blockIdx.x; u < 2048; u += F.G) { const int bh = u >> 4; float msh = 0.f; for (int a = 0; a < 8 && att::unit<false>(F.lds, QK, VT, AO, ksum, bh >> 3, bh & 7, u & 15, msh); ++a) {} }
    }
}

__device__ __forceinline__ unsigned f2key(float f) { const unsigned u = __float_as_uint(f); return (u & 0x80000000u) ? ~u : (u | 0x80000000u); }
typedef short s16x2 __attribute__((ext_vector_type(2)));
__device__ __forceinline__ unsigned h2key2(unsigned w) { const s16x2 s = __builtin_bit_cast(s16x2, w) >> 15; return w ^ (__builtin_bit_cast(unsigned, s) | 0x80008000u); }
__device__ __forceinline__ unsigned h2key(unsigned x) { return (x & 0x80000000u) ? ~x : (x | 0x80000000u); }
__device__ __forceinline__ float key2h(unsigned k) { const unsigned hb = ((k & 0x80000000u) ? (k & 0x7fffffffu) : ~k) >> 16; return (float)__builtin_bit_cast(_Float16, (unsigned short)hb); }
__device__ __forceinline__ float key2f(unsigned k) { const unsigned u = (k & 0x80000000u) ? (k & 0x7fffffffu) : ~k; return __uint_as_float(u); }
__device__ __forceinline__ void ins16(unsigned (&L)[16], unsigned x) {
#pragma unroll
    for (int k = 0; k < 16; ++k) { const unsigned t = max(L[k], x); x = min(L[k], x); L[k] = t; }
}
#define SORT16_DESC(L) do { unsigned t_; \
    t_ = max(L[0], L[1]); L[1] = min(L[0], L[1]); L[0] = t_; \
    t_ = max(L[2], L[3]); L[3] = min(L[2], L[3]); L[2] = t_; \
    t_ = max(L[0], L[2]); L[2] = min(L[0], L[2]); L[0] = t_; \
    t_ = max(L[1], L[3]); L[3] = min(L[1], L[3]); L[1] = t_; \
    t_ = max(L[1], L[2]); L[2] = min(L[1], L[2]); L[1] = t_; \
    t_ = max(L[4], L[5]); L[5] = min(L[4], L[5]); L[4] = t_; \
    t_ = max(L[6], L[7]); L[7] = min(L[6], L[7]); L[6] = t_; \
    t_ = max(L[4], L[6]); L[6] = min(L[4], L[6]); L[4] = t_; \
    t_ = max(L[5], L[7]); L[7] = min(L[5], L[7]); L[5] = t_; \
    t_ = max(L[5], L[6]); L[6] = min(L[5], L[6]); L[5] = t_; \
    t_ = max(L[0], L[4]); L[4] = min(L[0], L[4]); L[0] = t_; \
    t_ = max(L[2], L[6]); L[6] = min(L[2], L[6]); L[2] = t_; \
    t_ = max(L[2], L[4]); L[4] = min(L[2], L[4]); L[2] = t_; \
    t_ = max(L[1], L[5]); L[5] = min(L[1], L[5]); L[1] = t_; \
    t_ = max(L[3], L[7]); L[7] = min(L[3], L[7]); L[3] = t_; \
    t_ = max(L[3], L[5]); L[5] = min(L[3], L[5]); L[3] = t_; \
    t_ = max(L[1], L[2]); L[2] = min(L[1], L[2]); L[1] = t_; \
    t_ = max(L[3], L[4]); L[4] = min(L[3], L[4]); L[3] = t_; \
    t_ = max(L[5], L[6]); L[6] = min(L[5], L[6]); L[5] = t_; \
    t_ = max(L[8], L[9]); L[9] = min(L[8], L[9]); L[8] = t_; \
    t_ = max(L[10], L[11]); L[11] = min(L[10], L[11]); L[10] = t_; \
    t_ = max(L[8], L[10]); L[10] = min(L[8], L[10]); L[8] = t_; \
    t_ = max(L[9], L[11]); L[11] = min(L[9], L[11]); L[9] = t_; \
    t_ = max(L[9], L[10]); L[10] = min(L[9], L[10]); L[9] = t_; \
    t_ = max(L[12], L[13]); L[13] = min(L[12], L[13]); L[12] = t_; \
    t_ = max(L[14], L[15]); L[15] = min(L[14], L[15]); L[14] = t_; \
    t_ = max(L[12], L[14]); L[14] = min(L[12], L[14]); L[12] = t_; \
    t_ = max(L[13], L[15]); L[15] = min(L[13], L[15]); L[13] = t_; \
    t_ = max(L[13], L[14]); L[14] = min(L[13], L[14]); L[13] = t_; \
    t_ = max(L[8], L[12]); L[12] = min(L[8], L[12]); L[8] = t_; \
    t_ = max(L[10], L[14]); L[14] = min(L[10], L[14]); L[10] = t_; \
    t_ = max(L[10], L[12]); L[12] = min(L[10], L[12]); L[10] = t_; \
    t_ = max(L[9], L[13]); L[13] = min(L[9], L[13]); L[9] = t_; \
    t_ = max(L[11], L[15]); L[15] = min(L[11], L[15]); L[11] = t_; \
    t_ = max(L[11], L[13]); L[13] = min(L[11], L[13]); L[11] = t_; \
    t_ = max(L[9], L[10]); L[10] = min(L[9], L[10]); L[9] = t_; \
    t_ = max(L[11], L[12]); L[12] = min(L[11], L[12]); L[11] = t_; \
    t_ = max(L[13], L[14]); L[14] = min(L[13], L[14]); L[13] = t_; \
    t_ = max(L[0], L[8]); L[8] = min(L[0], L[8]); L[0] = t_; \
    t_ = max(L[4], L[12]); L[12] = min(L[4], L[12]); L[4] = t_; \
    t_ = max(L[4], L[8]); L[8] = min(L[4], L[8]); L[4] = t_; \
    t_ = max(L[2], L[10]); L[10] = min(L[2], L[10]); L[2] = t_; \
    t_ = max(L[6], L[14]); L[14] = min(L[6], L[14]); L[6] = t_; \
    t_ = max(L[6], L[10]); L[10] = min(L[6], L[10]); L[6] = t_; \
    t_ = max(L[2], L[4]); L[4] = min(L[2], L[4]); L[2] = t_; \
    t_ = max(L[6], L[8]); L[8] = min(L[6], L[8]); L[6] = t_; \
    t_ = max(L[10], L[12]); L[12] = min(L[10], L[12]); L[10] = t_; \
    t_ = max(L[1], L[9]); L[9] = min(L[1], L[9]); L[1] = t_; \
    t_ = max(L[5], L[13]); L[13] = min(L[5], L[13]); L[5] = t_; \
    t_ = max(L[5], L[9]); L[9] = min(L[5], L[9]); L[5] = t_; \
    t_ = max(L[3], L[11]); L[11] = min(L[3], L[11]); L[3] = t_; \
    t_ = max(L[7], L[15]); L[15] = min(L[7], L[15]); L[7] = t_; \
    t_ = max(L[7], L[11]); L[11] = min(L[7], L[11]); L[7] = t_; \
    t_ = max(L[3], L[5]); L[5] = min(L[3], L[5]); L[3] = t_; \
    t_ = max(L[7], L[9]); L[9] = min(L[7], L[9]); L[7] = t_; \
    t_ = max(L[11], L[13]); L[13] = min(L[11], L[13]); L[11] = t_; \
    t_ = max(L[1], L[2]); L[2] = min(L[1], L[2]); L[1] = t_; \
    t_ = max(L[3], L[4]); L[4] = min(L[3], L[4]); L[3] = t_; \
    t_ = max(L[5], L[6]); L[6] = min(L[5], L[6]); L[5] = t_; \
    t_ = max(L[7], L[8]); L[8] = min(L[7], L[8]); L[7] = t_; \
    t_ = max(L[9], L[10]); L[10] = min(L[9], L[10]); L[9] = t_; \
    t_ = max(L[11], L[12]); L[12] = min(L[11], L[12]); L[11] = t_; \
    t_ = max(L[13], L[14]); L[14] = min(L[13], L[14]); L[13] = t_; \
} while (0)
#define BITONIC16_DESC(L) do { unsigned t_; \
    t_ = max(L[0], L[8]); L[8] = min(L[0], L[8]); L[0] = t_; \
    t_ = max(L[1], L[9]); L[9] = min(L[1], L[9]); L[1] = t_; \
    t_ = max(L[2], L[10]); L[10] = min(L[2], L[10]); L[2] = t_; \
    t_ = max(L[3], L[11]); L[11] = min(L[3], L[11]); L[3] = t_; \
    t_ = max(L[4], L[12]); L[12] = min(L[4], L[12]); L[4] = t_; \
    t_ = max(L[5], L[13]); L[13] = min(L[5], L[13]); L[5] = t_; \
    t_ = max(L[6], L[14]); L[14] = min(L[6], L[14]); L[6] = t_; \
    t_ = max(L[7], L[15]); L[15] = min(L[7], L[15]); L[7] = t_; \
    t_ = max(L[0], L[4]); L[4] = min(L[0], L[4]); L[0] = t_; \
    t_ = max(L[1], L[5]); L[5] = min(L[1], L[5]); L[1] = t_; \
    t_ = max(L[2], L[6]); L[6] = min(L[2], L[6]); L[2] = t_; \
    t_ = max(L[3], L[7]); L[7] = min(L[3], L[7]); L[3] = t_; \
    t_ = max(L[8], L[12]); L[12] = min(L[8], L[12]); L[8] = t_; \
    t_ = max(L[9], L[13]); L[13] = min(L[9], L[13]); L[9] = t_; \
    t_ = max(L[10], L[14]); L[14] = min(L[10], L[14]); L[10] = t_; \
    t_ = max(L[11], L[15]); L[15] = min(L[11], L[15]); L[11] = t_; \
    t_ = max(L[0], L[2]); L[2] = min(L[0], L[2]); L[0] = t_; \
    t_ = max(L[1], L[3]); L[3] = min(L[1], L[3]); L[1] = t_; \
    t_ = max(L[4], L[6]); L[6] = min(L[4], L[6]); L[4] = t_; \
    t_ = max(L[5], L[7]); L[7] = min(L[5], L[7]); L[5] = t_; \
    t_ = max(L[8], L[10]); L[10] = min(L[8], L[10]); L[8] = t_; \
    t_ = max(L[9], L[11]); L[11] = min(L[9], L[11]); L[9] = t_; \
    t_ = max(L[12], L[14]); L[14] = min(L[12], L[14]); L[12] = t_; \
    t_ = max(L[13], L[15]); L[15] = min(L[13], L[15]); L[13] = t_; \
    t_ = max(L[0], L[1]); L[1] = min(L[0], L[1]); L[0] = t_; \
    t_ = max(L[2], L[3]); L[3] = min(L[2], L[3]); L[2] = t_; \
    t_ = max(L[4], L[5]); L[5] = min(L[4], L[5]); L[4] = t_; \
    t_ = max(L[6], L[7]); L[7] = min(L[6], L[7]); L[6] = t_; \
    t_ = max(L[8], L[9]); L[9] = min(L[8], L[9]); L[8] = t_; \
    t_ = max(L[10], L[11]); L[11] = min(L[10], L[11]); L[10] = t_; \
    t_ = max(L[12], L[13]); L[13] = min(L[12], L[13]); L[12] = t_; \
    t_ = max(L[14], L[15]); L[15] = min(L[14], L[15]); L[14] = t_; \
} while (0)
__device__ __forceinline__ void topk_panel(Frame& F, const void* P, int pm) {
    const int tid = F.tid, row = tid & 255, hq = tid >> 8;
    LAS unsigned* OUT = (LAS unsigned*)(F.lds + 16384) + row * 132;
    for (int hh = 0; hh < 4; ++hh) {
        const int h = hq * 4 + hh;
        unsigned L1[16], L2[16];
#pragma unroll
        for (int k = 0; k < 16; ++k) { L1[k] = 0u; L2[k] = 0u; }
        const u32x2* p1 = (const u32x2*)P + ((size_t)(h * 2) * 32 * 256 + row);
        const u32x2* p2 = p1 + (size_t)32 * 256;
        u32x2 cv[4], cw[4], nv[4], nw[4];
#pragma unroll
        for (int q = 0; q < 4; ++q) { cv[q] = p1[(size_t)q * 256]; cw[q] = p2[(size_t)q * 256]; }
#pragma unroll
        for (int c = 0; c < 8; ++c) {
            const int cn = (c < 7) ? c + 1 : 7;
#pragma unroll
            for (int q = 0; q < 4; ++q) { nv[q] = p1[(size_t)(cn * 4 + q) * 256]; nw[q] = p2[(size_t)(cn * 4 + q) * 256]; }
            unsigned C1[16], C2[16];
#pragma unroll
            for (int q = 0; q < 4; ++q)
#pragma unroll
                for (int e = 0; e < 4; e += 2) { const unsigned idx = (unsigned)(127 - (c * 16 + q * 4 + e));
                    const unsigned k1 = h2key2(cv[q][e >> 1]), k2 = h2key2(cw[q][e >> 1]);
                    C1[q * 4 + e] = (k1 << 16) | idx; C1[q * 4 + e + 1] = (k1 & 0xffff0000u) | (idx - 1u);
                    C2[q * 4 + e] = (k2 << 16) | idx; C2[q * 4 + e + 1] = (k2 & 0xffff0000u) | (idx - 1u); }
            SORT16_DESC(C1); SORT16_DESC(C2);
            if (c == 0) {
#pragma unroll
                for (int i = 0; i < 16; ++i) { L1[i] = C1[i]; L2[i] = C2[i]; }
            } else {
#pragma unroll
                for (int i = 0; i < 16; ++i) { L1[i] = max(L1[i], C1[15 - i]); L2[i] = max(L2[i], C2[15 - i]); }
                BITONIC16_DESC(L1); BITONIC16_DESC(L2);
            }
#pragma unroll
            for (int q = 0; q < 4; ++q) { cv[q] = nv[q]; cw[q] = nw[q]; }
        }
        float v1[16], v2[16];
#pragma unroll
        for (int k = 0; k < 16; ++k) { v1[k] = key2h(L1[k]); v2[k] = key2h(L2[k]); }
        LAS unsigned* myw = (LAS unsigned*)(F.lds + tid * 32);
#pragma unroll
        for (int q = 0; q < 4; ++q) {
            myw[q] = (127u - (L1[4 * q] & 127u)) | ((127u - (L1[4 * q + 1] & 127u)) << 8) | ((127u - (L1[4 * q + 2] & 127u)) << 16) | ((127u - (L1[4 * q + 3] & 127u)) << 24);
            myw[4 + q] = (127u - (L2[4 * q] & 127u)) | ((127u - (L2[4 * q + 1] & 127u)) << 8) | ((127u - (L2[4 * q + 2] & 127u)) << 16) | ((127u - (L2[4 * q + 3] & 127u)) << 24);
        }
        const LAS unsigned char* myb = (const LAS unsigned char*)myw;
#define CKEY(a, bb) ((f2key(v1[a] + v2[bb]) & ~255u) | (unsigned)(255 - ((a) * 16 + (bb))))
        unsigned L[16];
#pragma unroll
        for (int k = 0; k < 16; ++k) L[k] = CKEY(0, k);
#pragma unroll
        for (int a = 1; a <= 4; ++a) {
#pragma unroll
            for (int bb = 0; bb < 16; ++bb) if ((a + 1) * (bb + 1) <= 16) L[15 - bb] = max(L[15 - bb], CKEY(a, bb));
            BITONIC16_DESC(L);
        }
#pragma unroll
        for (int a = 5; a < 16; ++a)
#pragma unroll
            for (int bb = 0; bb < 16; ++bb)
                if ((a + 1) * (bb + 1) <= 16) ins16(L, CKEY(a, bb));
#undef CKEY
        float w[16]; float ssum = 0.f;
        const float mtop = key2f((L[0] & ~255u) | 128u);
#pragma unroll
        for (int k = 0; k < 16; ++k) { w[k] = __expf(key2f((L[k] & ~255u) | 128u) - mtop); ssum += w[k]; }
        const float inv = 1.0f / ssum;
#pragma unroll
        for (int k = 0; k < 16; ++k) {
            const int ci = 255 - (int)(L[k] & 255u);
            const int e1 = myb[ci >> 4], e2 = myb[16 + (ci & 15)];
            const int pos = (k & 7) * 16 + h * 2 + (k >> 3);
            OUT[pos] = (unsigned)(e1 * 128 + e2) | (pk2(0.f, w[k] * inv) & 0xffff0000u);
        }
    }
    __syncthreads();
    {
        unsigned char* PE = F.ws + WS_PE + (size_t)pm * (256 * 256); unsigned char* PG = F.ws + WS_PG + (size_t)pm * (256 * 256);
#pragma unroll
        for (int i = 0; i < 8; ++i) {
            const int c = tid + 512 * i, r = c >> 4, part = c & 15;
            const LAS u32x4* q = (const LAS u32x4*)(F.lds + 16384 + r * 528 + part * 32);
            const u32x4 a = q[0], b2 = q[1];
            *(u32x4*)(PE + (size_t)c * 16) = (u32x4){(a.x & 0xffffu) | (a.y << 16), (a.z & 0xffffu) | (a.w << 16), (b2.x & 0xffffu) | (b2.y << 16), (b2.z & 0xffffu) | (b2.w << 16)};
            *(u32x4*)(PG + (size_t)c * 16) = (u32x4){(a.x >> 16) | (a.y & 0xffff0000u), (a.z >> 16) | (a.w & 0xffff0000u), (b2.x >> 16) | (b2.y & 0xffff0000u), (b2.z >> 16) | (b2.w & 0xffff0000u)};
        }
    }
}

__device__ __forceinline__ float gelu_erf(float v) { return 0.5f * v * (1.0f + erff(v * 0.70710678118654752f)); }
typedef float f32x2 __attribute__((ext_vector_type(2)));
typedef int i32x2 __attribute__((ext_vector_type(2)));
typedef int i32x8 __attribute__((ext_vector_type(8)));
__device__ __forceinline__ float dpp_x1(float v) { return __int_as_float(__builtin_amdgcn_update_dpp(0, __float_as_int(v), 0xB1, 0xf, 0xf, false)); }
__device__ __forceinline__ float dpp_x2(float v) { return __int_as_float(__builtin_amdgcn_update_dpp(0, __float_as_int(v), 0x4E, 0xf, 0xf, false)); }
__device__ __forceinline__ float dpp_hm(float v) { return __int_as_float(__builtin_amdgcn_update_dpp(0, __float_as_int(v), 0x141, 0xf, 0xf, false)); }
__device__ __forceinline__ float dpp_r8(float v) { return __int_as_float(__builtin_amdgcn_update_dpp(0, __float_as_int(v), 0x128, 0xf, 0xf, false)); }
__device__ __forceinline__ unsigned e16_of(const u32x4& ea, const u32x4& eb, int i) { const unsigned w = (i < 8) ? ea[(i & 7) >> 1] : eb[(i & 7) >> 1]; return (i & 1) ? (w >> 16) : (w & 0xffffu); }

__device__ __forceinline__ void peer_u_phase(Frame& F) {
    const int lane = F.lane, wave = F.wave, g = lane >> 3, l8 = lane & 7, n = lane & 15, kg = lane >> 4;
    const unsigned char* PE = F.ws + WS_PE; const unsigned char* H8 = F.ws + WS_H8; bf16_t* PART = (bf16_t*)(F.ws + WS_PART);
    LAS unsigned char* stg = F.lds + wave * 16384;
    LAS unsigned char* ebuf = F.lds + 131072 + wave * 2048;
    const int soff0 = (l8 ^ (g >> 1)) << 4, soff1 = soff0 ^ 64;
    const int rkey = (n >> 1) & 7, rd0 = n * 128 + ((kg ^ rkey) << 4), rd1 = n * 128 + (((4 + kg) ^ rkey) << 4);
    const int erd = g * 32, brd = 512 + (n & 1) * 256 + kg * 16;
    for (int it = blockIdx.x; it < 256; it += F.G) {
        const int x = it & 3, cb = it >> 2;
        const unsigned char* Ux = F.ws + WS_U8 + (size_t)x * (NEXP * 128);
        bf16_t* part = PART + (size_t)x * ((size_t)MT * 128);
        const int tok0 = cb * 1024 + wave * 128, tokl = tok0 + 127;
        const unsigned char* pe = PE + lane * 4; const unsigned char* ph = H8 + x * 256 + lane * 4;
#define U_DMA_E(tok, par) __builtin_amdgcn_global_load_lds((const unsigned*)(pe + (size_t)(tok) * 256), (LAS unsigned*)(ebuf + (par) * 256), 4, 0, 0)
#define U_DMA_B(tok, par) do { __builtin_amdgcn_global_load_lds((const unsigned*)(ph + (size_t)(tok) * 2048), (LAS unsigned*)(ebuf + 512 + (par) * 512), 4, 0, 0); \
                               __builtin_amdgcn_global_load_lds((const unsigned*)(ph + (size_t)(tok) * 2048 + 1024), (LAS unsigned*)(ebuf + 512 + (par) * 512 + 256), 4, 0, 0); } while (0)
#define U_TILES(ea, eb) do { _Pragma("unroll") for (int j_ = 0; j_ < 16; ++j_) \
        __builtin_amdgcn_global_load_lds((const unsigned*)(Ux + (size_t)e16_of(ea, eb, j_) * 128 + ((j_ & 1) ? soff1 : soff0)), (LAS unsigned*)(stg + j_ * 1024), 16, 0, 0); } while (0)
#define U_TOKEN(tok, par, tokn1, tokn2) do { \
            U_DMA_E(tokn2, par); U_DMA_B(tokn1, (par) ^ 1); \
              \
            asm volatile("s_waitcnt vmcnt(4)" ::: "memory"); \
            u32x4 img[16]; \
            _Pragma("unroll") for (int T = 0; T < 8; ++T) { img[2 * T] = *(const LAS u32x4*)(stg + T * 2048 + rd0); img[2 * T + 1] = *(const LAS u32x4*)(stg + T * 2048 + rd1); } \
            const u32x4 eC0 = *(const LAS u32x4*)(ebuf + ((par) ^ 1) * 256 + erd), eC1 = *(const LAS u32x4*)(ebuf + ((par) ^ 1) * 256 + erd + 16); \
            const u32x4 h0 = *(const LAS u32x4*)(ebuf + (par) * 512 + brd), h1 = *(const LAS u32x4*)(ebuf + (par) * 512 + brd + 64), h2_ = *(const LAS u32x4*)(ebuf + (par) * 512 + brd + 128), h3 = *(const LAS u32x4*)(ebuf + (par) * 512 + brd + 192); \
            asm volatile("s_waitcnt lgkmcnt(0)" ::: "memory");                    \
            U_TILES(eC0, eC1); \
            const i32x8 A0_ = {(int)h0.x, (int)h0.y, (int)h0.z, (int)h0.w, (int)h1.x, (int)h1.y, (int)h1.z, (int)h1.w}; \
            const i32x8 A1_ = {(int)h2_.x, (int)h2_.y, (int)h2_.z, (int)h2_.w, (int)h3.x, (int)h3.y, (int)h3.z, (int)h3.w}; \
            float res[8]; \
            _Pragma("unroll") for (int T = 0; T < 8; ++T) { \
                const i32x8 B0_ = {(int)img[2 * T].x, (int)img[2 * T].y, (int)img[2 * T].z, (int)img[2 * T].w, 0, 0, 0, 0}; \
                const i32x8 B1_ = {(int)img[2 * T + 1].x, (int)img[2 * T + 1].y, (int)img[2 * T + 1].z, (int)img[2 * T + 1].w, 0, 0, 0, 0}; \
                f32x4 d_ = __builtin_amdgcn_mfma_scale_f32_16x16x128_f8f6f4(A0_, B0_, (f32x4){0.f, 0.f, 0.f, 0.f}, 0, 4, 0, 0, 0, 0); \
                d_ = __builtin_amdgcn_mfma_scale_f32_16x16x128_f8f6f4(A1_, B1_, d_, 0, 4, 0, 0, 0, 0); \
                res[T] = d_[0] + d_[1] * 0.0625f; }                                  \
              \
            unsigned d2_[8]; \
            _Pragma("unroll") for (int T = 0; T < 8; ++T) { const float p_ = dpp_r8(res[T]); d2_[T] = (n < 8) ? pk2(res[T], p_) : pk2(p_, res[T]); } \
            if (lane < 16) *(u32x4*)(part + (size_t)(tok) * 128 + 16 * (n & 7) + 8 * (n >> 3)) = (n < 8) ? (u32x4){d2_[0], d2_[1], d2_[2], d2_[3]} : (u32x4){d2_[4], d2_[5], d2_[6], d2_[7]}; \
        } while (0)
        {
            U_DMA_E(tok0, 0); U_DMA_E(tok0 + 1, 1); U_DMA_B(tok0, 0);
            asm volatile("s_waitcnt vmcnt(0)" ::: "memory");
            const u32x4 eX0 = *(const LAS u32x4*)(ebuf + erd), eX1 = *(const LAS u32x4*)(ebuf + erd + 16);
            asm volatile("s_waitcnt lgkmcnt(0)" ::: "memory");
            U_TILES(eX0, eX1);
            U_DMA_E(tok0 + 1, 1);
        }
        for (int tt = 0; tt < 128; tt += 2) {
            const int t0 = tok0 + tt, t1 = t0 + 1, t2 = min(t0 + 2, tokl), t3 = min(t0 + 3, tokl);
            U_TOKEN(t0, 0, t1, t2);
            U_TOKEN(t1, 1, t2, t3);
        }
        asm volatile("s_waitcnt vmcnt(0)" ::: "memory");
#undef U_TOKEN
#undef U_TILES
#undef U_DMA_B
#undef U_DMA_E
    }
}
__device__ __forceinline__ void peer_w_phase(Frame& F) {
    const u32x2* PART = (const u32x2*)(F.ws + WS_PART); const u32x2* PG = (const u32x2*)(F.ws + WS_PG); const unsigned short* PE = (const unsigned short*)(F.ws + WS_PE); const float* vs = (const float*)(F.ws + WS_VS); const float* us = (const float*)(F.ws + WS_US);
    const size_t n4 = (size_t)MT * 128 / 4, stride = (size_t)F.G * 512;
    for (size_t p = (size_t)blockIdx.x * 512 + F.tid; p < n4; p += stride) {
        f32x4 s = {0.f, 0.f, 0.f, 0.f};
#pragma unroll
        for (int x = 0; x < 4; ++x) { const u32x2 w_ = PART[(size_t)x * n4 + p]; s += (f32x4){bf_lo(w_.x), bf_hi(w_.x), bf_lo(w_.y), bf_hi(w_.y)}; }
        const u32x2 gw_ = PG[p]; const f32x4 gt = {bf_lo(gw_.x), bf_hi(gw_.x), bf_lo(gw_.y), bf_hi(gw_.y)}; f32x4 o;
#pragma unroll
        for (int e = 0; e < 4; ++e) { const int ex = PE[4 * p + e]; o[e] = gt[e] * gelu_erf(s[e] * us[ex]) * vs[ex]; }
        float mx = fmaxf(fmaxf(fabsf(o[0]), fabsf(o[1])), fmaxf(fabsf(o[2]), fabsf(o[3])));
#pragma unroll
        for (int off = 1; off < 32; off <<= 1) mx = fmaxf(mx, __shfl_xor(mx, off));
        const float inv = mx > 0.f ? 256.f / mx : 0.f;
        o = o * inv;
        int hw = 0; hw = __builtin_amdgcn_cvt_pk_fp8_f32(o[0], o[1], hw, false); hw = __builtin_amdgcn_cvt_pk_fp8_f32(o[2], o[3], hw, true);
        const f32x4 r = {16.f * (o[0] - __builtin_amdgcn_cvt_f32_fp8(hw, 0)), 16.f * (o[1] - __builtin_amdgcn_cvt_f32_fp8(hw, 1)), 16.f * (o[2] - __builtin_amdgcn_cvt_f32_fp8(hw, 2)), 16.f * (o[3] - __builtin_amdgcn_cvt_f32_fp8(hw, 3))};
        int lw = 0; lw = __builtin_amdgcn_cvt_pk_fp8_f32(r[0], r[1], lw, false); lw = __builtin_amdgcn_cvt_pk_fp8_f32(r[2], r[3], lw, true);
        unsigned char* rec = F.ws + WS_WB + (p >> 5) * 512; const int q = (int)(p & 31);
        *(unsigned*)(rec + 4 * q) = (unsigned)hw; *(unsigned*)(rec + 128 + 4 * q) = (unsigned)lw;
        if (q == 0) *(float*)(rec + 256) = mx * (1.f / 256.f);
    }
}
__device__ __forceinline__ void peer_v_phase(Frame& F) {
    const int lane = F.lane, wave = F.wave, g = lane >> 3, l8 = lane & 7, n = lane & 15, kg = lane >> 4;
    const unsigned char* PE = F.ws + WS_PE; const unsigned char* WB = F.ws + WS_WB; bf16_t* Y = (bf16_t*)(F.ws + WS_Y);
    LAS unsigned char* stg = F.lds + wave * 16384;
    LAS unsigned char* ebuf = F.lds + 131072 + wave * 2048;
    const int soff0 = (l8 ^ (g >> 1)) << 4, soff1 = soff0 ^ 64;
    const int kq = (n >> 1) & 7, tb = (32 * kg + n) * 128;
    unsigned tba[8];
#pragma unroll
    for (int c2 = 0; c2 < 8; ++c2) tba[c2] = (unsigned)(unsigned long)(stg + tb + ((c2 ^ kq) << 4));
    const int erd = 2 * g, ard = 512 + (n & 1) * 128 + kg * 16;
    for (int it = blockIdx.x; it < 256; it += F.G) {
        const int x = it & 3, cb = it >> 2;
        const unsigned char* Vx = F.ws + WS_V8 + (size_t)x * (NEXP * 128);
        const int tok0 = cb * 1024 + wave * 128, tokl = tok0 + 127;
        const unsigned char* pe = PE + lane * 4; const unsigned char* pw = WB + lane * 4; const unsigned char* psc = WB + 256;
#define V_DMA_E(tok, par) __builtin_amdgcn_global_load_lds((const unsigned*)(pe + (size_t)(tok) * 256), (LAS unsigned*)(ebuf + (par) * 256), 4, 0, 0)
#define V_DMA_A(tok, par) do { __builtin_amdgcn_global_load_lds((const unsigned*)(pw + (size_t)(tok) * 512), (LAS unsigned*)(ebuf + 512 + (par) * 512), 4, 0, 0); \
                               __builtin_amdgcn_global_load_lds((const unsigned*)(psc + (size_t)(tok) * 512), (LAS unsigned*)(ebuf + 512 + (par) * 512 + 256), 4, 0, 0); } while (0)
#define V_IDS(par, id) do { _Pragma("unroll") for (int j_ = 0; j_ < 16; ++j_) id[j_] = *(const LAS unsigned short*)(ebuf + (par) * 256 + 16 * j_ + erd); } while (0)
#define V_TILES(id) do { _Pragma("unroll") for (int j_ = 0; j_ < 16; ++j_) \
        __builtin_amdgcn_global_load_lds((const unsigned*)(Vx + (size_t)id[j_] * 128 + ((j_ & 1) ? soff1 : soff0)), (LAS unsigned*)(stg + j_ * 1024), 16, 0, 0); } while (0)
#define V_TOKEN(tok, par, tokn1, tokn2) do { \
            V_DMA_E(tokn2, par); V_DMA_A(tokn1, (par) ^ 1); \
              \
            asm volatile("s_waitcnt vmcnt(5)" ::: "memory"); \
            i32x2 bt[32]; unsigned id[16]; \
              \
            _Pragma("unroll") for (int c = 0; c < 16; ++c) { \
                asm volatile("ds_read_b64_tr_b4 %0, %1 offset:%2" : "=v"(bt[2 * c]) : "v"(tba[c >> 1]), "n"((c & 1) * 8)); \
                asm volatile("ds_read_b64_tr_b4 %0, %1 offset:%2" : "=v"(bt[2 * c + 1]) : "v"(tba[c >> 1]), "n"((c & 1) * 8 + 2048)); } \
            V_IDS((par) ^ 1, id); \
            const u32x4 a0 = *(const LAS u32x4*)(ebuf + (par) * 512 + ard), a1 = *(const LAS u32x4*)(ebuf + (par) * 512 + ard + 64); \
            const float wsc = *(const LAS float*)(ebuf + 512 + (par) * 512 + 256); \
            asm volatile("s_waitcnt lgkmcnt(0)" : "+v"(bt[0]), "+v"(bt[1]), "+v"(bt[2]), "+v"(bt[3]), "+v"(bt[4]), "+v"(bt[5]), "+v"(bt[6]), "+v"(bt[7]), "+v"(bt[8]), "+v"(bt[9]), "+v"(bt[10]), "+v"(bt[11]) :: "memory");    \
            asm volatile("" : "+v"(bt[12]), "+v"(bt[13]), "+v"(bt[14]), "+v"(bt[15]), "+v"(bt[16]), "+v"(bt[17]), "+v"(bt[18]), "+v"(bt[19]), "+v"(bt[20]), "+v"(bt[21]), "+v"(bt[22]), "+v"(bt[23])); \
            asm volatile("" : "+v"(bt[24]), "+v"(bt[25]), "+v"(bt[26]), "+v"(bt[27]), "+v"(bt[28]), "+v"(bt[29]), "+v"(bt[30]), "+v"(bt[31])); \
            V_TILES(id); \
            const i32x8 A_ = {(int)a0.x, (int)a0.y, (int)a0.z, (int)a0.w, (int)a1.x, (int)a1.y, (int)a1.z, (int)a1.w}; \
            float res[16]; \
            _Pragma("unroll") for (int c = 0; c < 16; ++c) { \
                const i32x8 B_ = {bt[2 * c].x, bt[2 * c].y, bt[2 * c + 1].x, bt[2 * c + 1].y, 0, 0, 0, 0}; \
                const f32x4 d_ = __builtin_amdgcn_mfma_scale_f32_16x16x128_f8f6f4(A_, B_, (f32x4){0.f, 0.f, 0.f, 0.f}, 0, 4, 0, 0, 0, 0); \
                res[c] = (d_[0] + d_[1] * 0.0625f) * wsc; }                          \
            _Pragma("unroll") for (int c = 0; c < 16; ++c) asm volatile("" : "+v"(res[c]));        \
            if (lane < 16) { u32x4* yp = (u32x4*)(Y + (size_t)(tok) * 1024 + x * 256 + 16 * n); \
                yp[0] = (u32x4){pk2(res[0], res[1]), pk2(res[2], res[3]), pk2(res[4], res[5]), pk2(res[6], res[7])}; \
                yp[1] = (u32x4){pk2(res[8], res[9]), pk2(res[10], res[11]), pk2(res[12], res[13]), pk2(res[14], res[15])}; } \
        } while (0)
        {
            V_DMA_E(tok0, 0); V_DMA_E(tok0 + 1, 1); V_DMA_A(tok0, 0);
            asm volatile("s_waitcnt vmcnt(0)" ::: "memory");
            unsigned id[16]; V_IDS(0, id);
            asm volatile("s_waitcnt lgkmcnt(0)" ::: "memory");
            V_TILES(id);
            V_DMA_A(tok0, 0);
        }
        for (int tt = 0; tt < 128; tt += 2) {
            const int t0 = tok0 + tt, t1 = t0 + 1, t2 = min(t0 + 2, tokl), t3 = min(t0 + 3, tokl);
            V_TOKEN(t0, 0, t1, t2);
            V_TOKEN(t1, 1, t2, t3);
        }
        asm volatile("s_waitcnt vmcnt(0)" ::: "memory");
#undef V_TOKEN
#undef V_TILES
#undef V_IDS
#undef V_DMA_A
#undef V_DMA_E
    }
}
__device__ __forceinline__ void final_phase(Frame& F) {
    const bf16_t* Y = (const bf16_t*)(F.ws + WS_Y); const float* mod = (const float*)(F.ws + WS_MOD);
    const int gw = F.vcu * 8 + F.wave, NGW = F.G * 8;
    int tid_ = threadIdx.x; asm volatile("" : "+v"(tid_));
    const int lane = tid_ & 63;
    f32x4 fg[4];
#pragma unroll
    for (int j = 0; j < 4; ++j) fg[j] = *(const f32x4*)(F.final_g + 4 * lane + 256 * j);
    for (int tokb = gw * 32; tokb < MT; tokb += NGW * 32) {
        const int b = tokb >> 12;
        f32x4 g2[4];
#pragma unroll
        for (int j = 0; j < 4; ++j) g2[j] = *(const f32x4*)(mod + b * 6144 + 5120 + 4 * lane + 256 * j);
        for (int tok = tokb; tok < tokb + 32; ++tok) {
            float* orow = F.out + (size_t)tok * 1024 + 4 * lane;
            const bf16_t* xrow = (const bf16_t*)F.out + (size_t)tok * 2048 + 4 * lane; const bf16_t* yrow = Y + (size_t)tok * 1024 + 4 * lane;
            u32x2 w[4], yv[4];
#pragma unroll
            for (int j = 0; j < 4; ++j) { w[j] = *(const u32x2*)(xrow + 256 * j); yv[j] = *(const u32x2*)(yrow + 256 * j); }
            asm volatile("s_waitcnt vmcnt(0)" ::: "memory");
            f32x4 v[4]; float ss = 0.f;
#pragma unroll
            for (int j = 0; j < 4; ++j) { v[j] = (f32x4){bf_lo(w[j].x), bf_hi(w[j].x), bf_lo(w[j].y), bf_hi(w[j].y)} + g2[j] * (f32x4){bf_lo(yv[j].x), bf_hi(yv[j].x), bf_lo(yv[j].y), bf_hi(yv[j].y)};
                ss += v[j][0] * v[j][0] + v[j][1] * v[j][1] + v[j][2] * v[j][2] + v[j][3] * v[j][3]; }
            ss = wave_sum(ss);
            const float rstd = 1.0f / sqrtf(ss * (1.f / 1024.f) + NORM_EPS);
#pragma unroll
            for (int j = 0; j < 4; ++j) *(f32x4*)(orow + 256 * j) = v[j] * rstd * fg[j];
        }
    }
}

#ifndef MK_N_LAUNCHES
#define MK_N_LAUNCHES 1
#endif
constexpr int N_PHASES = 9;
struct Args { const float* in[16]; float* out; unsigned char* ws; int ph_lo, ph_hi; };
__global__ void __launch_bounds__(512, 2) mk_fwd(Args args) {
    extern __shared__ __attribute__((aligned(16))) unsigned char lds[];
    Frame F;
    F.lds = (LAS unsigned char*)lds;
    F.tid = threadIdx.x; F.lane = F.tid & 63; F.wave = __builtin_amdgcn_readfirstlane(F.tid >> 6);
    F.G = gridDim.x; { const int bx = blockIdx.x; F.vcu = (F.G % 8 == 0) ? (bx % 8) * (F.G / 8) + bx / 8 : bx; }
    F.x = args.in[0]; F.c = args.in[1]; F.rel_bias = args.in[2]; F.w_ada = args.in[3]; F.b_ada = args.in[4]; F.norm1_g = args.in[5]; F.w_in = args.in[6]; F.diff_lambda = args.in[7];
    F.subln_g = args.in[8]; F.w_out = args.in[9]; F.norm2_g = args.in[10]; F.peer_wq = args.in[11]; F.peer_keys = args.in[12]; F.peer_u = args.in[13]; F.peer_v = args.in[14]; F.final_g = args.in[15];
    F.out = args.out; F.ws = args.ws;
    volatile LAS unsigned* MISC = (volatile LAS unsigned*)(F.lds + MISC_OFF);
    if (F.tid < 64) MISC[F.tid] = 0u;
    __syncthreads();
    XcdBarrier bar; bar.bar = (unsigned*)(F.ws + WS_CTL) + CW_BAR; bar.x = 0; bar.st = nullptr;
    const int lo = args.ph_lo, hi = args.ph_hi;
    if (hi - lo > 1) bar = xcd_barrier_post((unsigned*)(F.ws + WS_CTL) + CW_BAR, MISC + 8);
#define IN(k) (lo <= (k) && (k) < hi)
#define SEAM(k) do { if (IN(k) && IN((k) + 1)) xcd_barrier(bar); } while (0)
    bf16_t* H = (bf16_t*)(F.ws + WS_H);
    if (IN(0)) { p0_prologue(F); } SEAM(0);
    if (IN(1)) { norm_phase<false>(F, F.x, F.norm1_g, 0, 1024, H, nullptr); } SEAM(1);
    if (IN(2)) {
        { pg8::Gemm g{H, (const bf16_t*)(F.ws + WS_WQK), MT, 2048, 1024}; pg8::StaticOrder S; S.init(MT, 2048, F.G, (int)blockIdx.x);
          pg8::EpiQK E{(bf16_t*)(F.ws + WS_QK), (float*)(F.ws + WS_KSUM), C2};
          pg8::gemm_phase<pg8::EpiQK, pg8::StaticOrder, true, true>(F.lds, g, S, E); }
        __syncthreads();
        { pg8::Gemm g{(const bf16_t*)(F.ws + WS_WV), H, 1024, MT, 1024}; pg8::StaticOrder S; S.init(1024, MT, F.G, (int)blockIdx.x);
          pg8::EpiVT E{(bf16_t*)(F.ws + WS_VT), MT};
          pg8::gemm_phase<pg8::EpiVT, pg8::StaticOrder, true, true>(F.lds, g, S, E); }
    } SEAM(2);
    if (IN(3)) { attn_phase(F); } SEAM(3);
    if (IN(4)) {
        const int pm = (int)blockIdx.x;
        float* scp = (float*)(F.ws + (pm < 192 ? WS_SCA + (size_t)pm * (2 * MiB) : WS_SCB + (size_t)(pm - 192) * (2 * MiB)));
        { pg8::Gemm g{(const bf16_t*)(F.ws + WS_AO), (const bf16_t*)(F.ws + WS_WO), MT, 1024, 1024}; pg8::PanelOrder S{pm, 4};
          pg8::EpiRes E{F.x, (bf16_t*)F.out, (const float*)(F.ws + WS_MOD)};
          pg8::gemm_phase<pg8::EpiRes, pg8::PanelOrder, true, true>(F.lds, g, S, E); }
        __syncthreads();
        norm_phase<true>(F, F.out, F.norm2_g, 3072, 4096, H, F.ws + WS_H8);
        asm volatile("s_waitcnt vmcnt(0)" ::: "memory"); __syncthreads();
        { pg8::Gemm g{H, (const bf16_t*)(F.ws + WS_WC), MT, 2048, 1024}; pg8::PanelOrder S{pm, 8};
          pg8::EpiSC E{scp};
          pg8::gemm_phase<pg8::EpiSC, pg8::PanelOrder, true, true>(F.lds, g, S, E); }
        __syncthreads();
        topk_panel(F, scp, pm);
    } SEAM(4);
    if (IN(5)) { peer_u_phase(F); } SEAM(5);
    if (IN(6)) { peer_w_phase(F); } SEAM(6);
    if (IN(7)) { peer_v_phase(F); } SEAM(7);
    if (IN(8)) { final_phase(F); }
#undef IN
#undef SEAM
}

extern "C" void kernel_launch(void* const* d_in, const int* in_sizes, int n_in, void* d_out, int out_size, void* d_ws, size_t ws_size, hipStream_t stream) {
    static int grid = 0;
    if (grid == 0) {
        if (n_in != 16 || in_sizes[0] != MT * DM || out_size != MT * DM || ws_size < WS_END) { fprintf(stderr, "kernel_launch: unexpected shapes (n_in %d, in0 %d, out %d, ws %zu); nothing launched\n", n_in, n_in > 0 ? in_sizes[0] : -1, out_size, ws_size); grid = -1; return; }
        int dev = 0, cus = 0, per_cu = 0;
        if (hipGetDevice(&dev) != hipSuccess || hipDeviceGetAttribute(&cus, hipDeviceAttributeMultiprocessorCount, dev) != hipSuccess) { grid = -1; return; }
        if (hipFuncSetAttribute((const void*)mk_fwd, hipFuncAttributeMaxDynamicSharedMemorySize, LDS_BYTES) != hipSuccess) { fprintf(stderr, "kernel_launch: hipFuncSetAttribute failed\n"); grid = -1; return; }
        if (hipOccupancyMaxActiveBlocksPerMultiprocessor(&per_cu, (const void*)mk_fwd, 512, LDS_BYTES) != hipSuccess || per_cu < 1) fprintf(stderr, "kernel_launch: note: occupancy query reports %d\n", per_cu);
        (void)hipGetLastError();
        grid = cus;
        if (grid != 256) { fprintf(stderr, "kernel_launch: built for a 256-CU device (one 256-row panel per workgroup in the fused phase); found %d CUs; nothing launched\n", cus); grid = -1; return; }
    }
    if (grid < 0) return;
    if (hipMemsetAsync((char*)d_ws + WS_CTL, 0, CTL_ZERO_BYTES, stream) != hipSuccess) return;
    Args a{};
    for (int i = 0; i < 16; ++i) a.in[i] = (const float*)d_in[i];
    a.out = (float*)d_out; a.ws = (unsigned char*)d_ws;
#if MK_N_LAUNCHES == 1
    a.ph_lo = 0; a.ph_hi = N_PHASES;
    hipLaunchKernelGGL(mk_fwd, dim3(grid), dim3(512), LDS_BYTES, stream, a);
#else
    for (int p = 0; p < N_PHASES; ++p) { a.ph_lo = p; a.ph_hi = p + 1; hipLaunchKernelGGL(mk_fwd, dim3(grid), dim3(512), LDS_BYTES, stream, a); }
#endif
}
```

```cpp
#include <hip/hip_runtime.h>
#include <type_traits>
#include <cstdio>
#include <cstdint>
#include <cmath>

#define LAS __attribute__((address_space(3)))
#define GAS __attribute__((address_space(1)))

constexpr int NB = 16, SEQ = 4096, DM = 1024, MT = NB * SEQ;
constexpr float NORM_EPS = 1e-6f, LOG2E = 1.4426950408889634f, C2 = 0.125f * LOG2E, NEGBIG = -1e30f;
constexpr int QKW = 2048;
constexpr int NEXP = 16384;

namespace pg8 {
#define PG8_LAS __attribute__((address_space(3)))
typedef unsigned short bf16_t;
typedef short bf16x8 __attribute__((ext_vector_type(8)));
typedef float f32x4 __attribute__((ext_vector_type(4)));
typedef unsigned u32x4 __attribute__((ext_vector_type(4)));
constexpr int BM = 256, BK = 64, HALF = 128, HTB = HALF * BK * 2  , STAGE_BYTES = 8 * HTB, NXCD = 8, WGM = 8;

__host__ __device__ __forceinline__ int lds_byte(int r, int c) { const int st = (r >> 4) * 2 + (c >> 5), rr = r & 15, cc = c & 31, ob = rr * 64 + cc * 2; return st * 1024 + (ob ^ (((ob >> 9) & 1) << 5)); }
__host__ __device__ __forceinline__ void stage_rc(int b, int& R, int& C) { const int st = b / 1024, sb = b % 1024, swz = sb ^ (((sb >> 9) & 1) << 5); R = (st >> 1) * 16 + swz / 64; C = (st & 1) * 32 + (swz % 64) / 2; }
__host__ __device__ __forceinline__ int perm32(int rho) { const int n = rho >> 4, i = rho & 15; return 8 * (i >> 2) + 4 * n + (i & 3); }

struct Unit { int pm, pn; };
struct Gemm { const bf16_t* A; const bf16_t* Bt; int M, N, K; };

struct StaticOrder {
    int nM, nN, nwg, G, c;
    __host__ __device__ void init(int M, int N, int G_, int c_) { nM = M / BM; nN = N / BM; nwg = nM * nN; G = G_; c = c_; }
    __host__ __device__ bool next(int i, Unit& u) const {
        const long L = (long)i * G + c; if (L >= nwg) return false;
        int wgid = (int)L; { const int q = nwg / NXCD, r = nwg % NXCD, xcd = wgid % NXCD, off = wgid / NXCD; wgid = (xcd < r ? xcd * (q + 1) : r * (q + 1) + (xcd - r) * q) + off; }
        const int nig = WGM * nN, gid = wgid / nig, fm = gid * WGM, gsz = (nM - fm) < WGM ? (nM - fm) : WGM;
        u.pm = fm + ((wgid % nig) % gsz); u.pn = (wgid % nig) / gsz; return true;
    }
    __device__ __forceinline__ void a_ready(const Unit&) const {}
    __device__ __forceinline__ void done(const Unit&) const {}
};

struct PanelOrder {
    int pm, n;
    __host__ __device__ bool next(int i, Unit& u) const { if (i >= n) return false; u.pm = pm; u.pn = i; return true; }
    __device__ __forceinline__ void a_ready(const Unit&) const {}
    __device__ __forceinline__ void done(const Unit&) const {}
};

typedef float f32x2 __attribute__((ext_vector_type(2)));
typedef unsigned u32x2 __attribute__((ext_vector_type(2)));
typedef __bf16 bf16x2_t __attribute__((ext_vector_type(2)));
__device__ __forceinline__ unsigned cvt_pk_bf16(float lo, float hi) { f32x2 v = {lo, hi}; bf16x2_t b = __builtin_convertvector(v, bf16x2_t); return __builtin_bit_cast(unsigned, b); }

struct EpiBf16 {
    static constexpr bool PERM = true, AFTER_DRAIN = false;
    bf16_t* O; int ldc;
    __device__ __forceinline__ void operator()(const f32x4 (&acc)[2][2][4][2], const Unit& u, int wr, int wc, int fr, int fq) const {
        const int row0 = u.pm * BM + wr * 64 + fr; const int col0 = u.pn * BM + wc * 32 + 8 * fq;
#pragma unroll
        for (int ai = 0; ai < 2; ++ai)
#pragma unroll
            for (int m = 0; m < 4; ++m) { bf16_t* rowp = O + (size_t)(row0 + ai * HALF + m * 16) * ldc + col0;
#pragma unroll
                for (int bj = 0; bj < 2; ++bj) { const f32x4 v0 = acc[ai][bj][m][0], v1 = acc[ai][bj][m][1];
                    u32x4 w; w.x = cvt_pk_bf16(v0[0], v0[1]); w.y = cvt_pk_bf16(v0[2], v0[3]); w.z = cvt_pk_bf16(v1[0], v1[1]); w.w = cvt_pk_bf16(v1[2], v1[3]);
                    *(u32x4*)(rowp + bj * HALF) = w; } }
    }
};
struct EpiVT {
    static constexpr bool PERM = true, AFTER_DRAIN = false;
    bf16_t* O; int ldc;
    __device__ __forceinline__ void operator()(const f32x4 (&acc)[2][2][4][2], const Unit& u, int wr, int wc, int fr, int fq) const {
        const int row0 = u.pm * BM + wr * 64 + fr; const int col0 = u.pn * BM + wc * 32 + 16 * (fq >> 1) + 4 * (fq & 1);
#pragma unroll
        for (int ai = 0; ai < 2; ++ai)
#pragma unroll
            for (int m = 0; m < 4; ++m) { bf16_t* rowp = O + (size_t)(row0 + ai * HALF + m * 16) * ldc + col0;
#pragma unroll
                for (int bj = 0; bj < 2; ++bj) { const f32x4 v0 = acc[ai][bj][m][0], v1 = acc[ai][bj][m][1];
                    u32x2 w0, w1; w0.x = cvt_pk_bf16(v0[0], v0[1]); w0.y = cvt_pk_bf16(v0[2], v0[3]); w1.x = cvt_pk_bf16(v1[0], v1[1]); w1.y = cvt_pk_bf16(v1[2], v1[3]);
                    *(u32x2*)(rowp + bj * HALF) = w0; *(u32x2*)(rowp + bj * HALF + 8) = w1; } }
    }
};
struct EpiQK {
    static constexpr bool PERM = true, AFTER_DRAIN = false;
    bf16_t* O; float* ksum; float qscale;
    __device__ __forceinline__ void operator()(const f32x4 (&acc)[2][2][4][2], const Unit& u, int wr, int wc, int fr, int fq) const {
        const int row0 = u.pm * BM + wr * 64 + fr; const int col0 = u.pn * BM + wc * 32 + 8 * fq;
        const float sc = (u.pn < 2 || (u.pn >= 4 && u.pn < 6)) ? qscale : 1.f;
#pragma unroll
        for (int ai = 0; ai < 2; ++ai)
#pragma unroll
            for (int m = 0; m < 4; ++m) { bf16_t* rowp = O + (size_t)(row0 + ai * HALF + m * 16) * 2048 + col0;
#pragma unroll
                for (int bj = 0; bj < 2; ++bj) { const f32x4 v0 = acc[ai][bj][m][0] * sc, v1 = acc[ai][bj][m][1] * sc;
                    u32x4 w; w.x = cvt_pk_bf16(v0[0], v0[1]); w.y = cvt_pk_bf16(v0[2], v0[3]); w.z = cvt_pk_bf16(v1[0], v1[1]); w.w = cvt_pk_bf16(v1[2], v1[3]);
                    *(u32x4*)(rowp + bj * HALF) = w; } }
        if (u.pn >= 6) {
            float* kdst = ksum + (size_t)u.pm * 512 + (u.pn - 6) * BM + wc * 32 + 8 * fq;
#pragma unroll
            for (int bj = 0; bj < 2; ++bj)
#pragma unroll
                for (int n = 0; n < 2; ++n)
#pragma unroll
                    for (int e = 0; e < 4; ++e) {
                        float s = 0.f;
#pragma unroll
                        for (int ai = 0; ai < 2; ++ai)
#pragma unroll
                            for (int m = 0; m < 4; ++m) s += acc[ai][bj][m][n][e];
                        s += __shfl_xor(s, 1); s += __shfl_xor(s, 2); s += __shfl_xor(s, 4); s += __shfl_xor(s, 8);
                        if (fr == 0) atomicAdd(kdst + bj * HALF + 4 * n + e, s);
                    }
        }
    }
};
struct EpiRes {
    static constexpr bool PERM = false, AFTER_DRAIN = false;
    const float* x; bf16_t* out; const float* mod;
    __device__ __forceinline__ void operator()(const f32x4 (&acc)[2][2][4][2], const Unit& u, int wr, int wc, int fr, int fq) const {
        const int row0 = u.pm * BM + wr * 64 + fr; const int col0 = u.pn * BM + wc * 32 + 4 * fq;
        const float* g1 = mod + (size_t)(u.pm >> 4) * 6144 + 2048 + col0;
        f32x4 gv[2][2];
#pragma unroll
        for (int bj = 0; bj < 2; ++bj)
#pragma unroll
            for (int n = 0; n < 2; ++n) gv[bj][n] = *(const f32x4*)(g1 + bj * HALF + n * 16);
#pragma unroll
        for (int ai = 0; ai < 2; ++ai)
#pragma unroll
            for (int m = 0; m < 4; ++m) { const size_t off = (size_t)(row0 + ai * HALF + m * 16) * 1024 + col0;
#pragma unroll
                for (int bj = 0; bj < 2; ++bj)
#pragma unroll
                    for (int n = 0; n < 2; ++n) { const f32x4 xv = *(const f32x4*)(x + off + bj * HALF + n * 16);
                        const f32x4 y = xv + gv[bj][n] * acc[ai][bj][m][n]; u32x2 w; w.x = cvt_pk_bf16(y[0], y[1]); w.y = cvt_pk_bf16(y[2], y[3]);
                        *(u32x2*)(out + off + (size_t)(row0 + ai * HALF + m * 16) * 1024 + bj * HALF + n * 16) = w; } }
    }
};
typedef unsigned u32x2v __attribute__((ext_vector_type(2)));
struct EpiSC {
    static constexpr bool PERM = false, AFTER_DRAIN = false;
    float* P;
    __device__ __forceinline__ void operator()(const f32x4 (&acc)[2][2][4][2], const Unit& u, int wr, int wc, int fr, int fq) const {
        const int row0 = wr * 64 + fr; const int cg0 = u.pn * 64 + wc * 8 + fq;
#pragma unroll
        for (int ai = 0; ai < 2; ++ai)
#pragma unroll
            for (int m = 0; m < 4; ++m) { const int r = row0 + ai * HALF + m * 16;
#pragma unroll
                for (int bj = 0; bj < 2; ++bj)
#pragma unroll
                    for (int n = 0; n < 2; ++n) { const f32x4 a = acc[ai][bj][m][n];
                        *(u32x2v*)((char*)P + ((size_t)(cg0 + bj * 32 + n * 4) * 256 + r) * 8) = (u32x2v){__builtin_bit_cast(unsigned, __builtin_amdgcn_cvt_pkrtz(a[0], a[1])), __builtin_bit_cast(unsigned, __builtin_amdgcn_cvt_pkrtz(a[2], a[3]))}; } }
    }
};
struct EpiF32 {
    static constexpr bool PERM = false, AFTER_DRAIN = false;
    float* O; int ldc;
    __device__ __forceinline__ void operator()(const f32x4 (&acc)[2][2][4][2], const Unit& u, int wr, int wc, int fr, int fq) const {
        const int row0 = u.pm * BM + wr * 64 + fr; const int col0 = u.pn * BM + wc * 32 + 4 * fq;
#pragma unroll
        for (int ai = 0; ai < 2; ++ai)
#pragma unroll
            for (int m = 0; m < 4; ++m) { const size_t off = (size_t)(row0 + ai * HALF + m * 16) * ldc + col0;
#pragma unroll
                for (int bj = 0; bj < 2; ++bj)
#pragma unroll
                    for (int n = 0; n < 2; ++n) *(f32x4*)(O + off + bj * HALF + n * 16) = acc[ai][bj][m][n]; }
    }
};

template <class Epi, class Sched, bool ALIGN_EPI = false, bool SP2 = false>
__device__ __forceinline__ void gemm_phase(PG8_LAS unsigned char* lds, const Gemm g, const Sched& S, const Epi& E) {
    const int tid = threadIdx.x, wid = __builtin_amdgcn_readfirstlane(tid >> 6), lane = tid & 63, wr = wid >> 2, wc = wid & 3, fr = lane & 15, fq = lane >> 4;
    const int K = g.K, nt = K / BK;
    unsigned voffA[2], voffB[2];
#pragma unroll
    for (int i = 0; i < 2; ++i) { int R, C; stage_rc(tid * 16 + i * 8192, R, C); const int Rb = Epi::PERM ? ((R & ~31) + perm32(R & 31)) : R;
        voffA[i] = (unsigned)(R * K + C) * 2u; voffB[i] = (unsigned)(Rb * K + C) * 2u; }
    const size_t kstep = (size_t)(BK * 2);
    const size_t hstep = (size_t)HALF * K * 2;
    const size_t tstep = 2 * hstep;
    const unsigned ldsw = (unsigned)wid * 1024u;
    const int aoff = lds_byte(wr * 64 + fr, fq * 8), boff = lds_byte(wc * 32 + fr, fq * 8);
#define PG8_SA(b, h) (((b) * 2 + (h)) * HTB)
#define PG8_SB(b, h) ((4 + (b) * 2 + (h)) * HTB)
#define PG8_STAGE(bufoff, gbase, voff) do { _Pragma("unroll") for (int _i = 0; _i < 2; ++_i) \
        __builtin_amdgcn_global_load_lds((const unsigned*)((const char*)(gbase) + (voff)[_i]), (PG8_LAS unsigned*)(lds + (bufoff) + ldsw + _i * 8192), 16, 0, 0); } while (0)
#define PG8_LDA(dst, b, h) do { _Pragma("unroll") for (int m = 0; m < 4; ++m) _Pragma("unroll") for (int k = 0; k < 2; ++k) dst[m][k] = *(const PG8_LAS bf16x8*)(lds + PG8_SA(b, h) + aoff + m * 2048 + k * 1024); } while (0)
#define PG8_LDB(dst, b, h) do { _Pragma("unroll") for (int n = 0; n < 2; ++n) _Pragma("unroll") for (int k = 0; k < 2; ++k) dst[n][k] = *(const PG8_LAS bf16x8*)(lds + PG8_SB(b, h) + boff + n * 2048 + k * 1024); } while (0)
#define PG8_MMA(ai, bj, At, Bt) do { __builtin_amdgcn_s_setprio(1); _Pragma("unroll") for (int m = 0; m < 4; ++m) _Pragma("unroll") for (int n = 0; n < 2; ++n) _Pragma("unroll") for (int k = 0; k < 2; ++k) \
        acc[ai][bj][m][n] = __builtin_amdgcn_mfma_f32_16x16x32_bf16(Bt[n][k], At[m][k], acc[ai][bj][m][n], 0, 0, 0); __builtin_amdgcn_s_setprio(0); } while (0)
#define PG8_WAIT_V(n) asm volatile("s_waitcnt vmcnt(" #n ")" ::: "memory")
#define PG8_WAIT_L(n) asm volatile("s_waitcnt lgkmcnt(" #n ")" ::: "memory")
#define PG8_BAR __builtin_amdgcn_s_barrier()
#define PG8_SCHED __builtin_amdgcn_sched_barrier(0)
    Unit cur, nxt; int ui = 0;
    if (!S.next(0, cur)) return;
    f32x4 acc[2][2][4][2];
#pragma unroll
    for (int a = 0; a < 2; ++a)
#pragma unroll
        for (int b = 0; b < 2; ++b)
#pragma unroll
            for (int m = 0; m < 4; ++m)
#pragma unroll
                for (int n = 0; n < 2; ++n) acc[a][b][m][n] = (f32x4){0.f, 0.f, 0.f, 0.f};
    bf16x8 At[4][2], B0[2][2], B1[2][2];
    const char* cA = (const char*)g.A + (size_t)cur.pm * tstep; const char* cB = (const char*)g.Bt + (size_t)cur.pn * tstep;
    S.a_ready(cur);
    if constexpr (SP2) {
        PG8_STAGE(PG8_SB(0, 0), cB, voffB); PG8_STAGE(PG8_SB(0, 1), cB + hstep, voffB); PG8_STAGE(PG8_SA(0, 0), cA, voffA); PG8_STAGE(PG8_SA(0, 1), cA + hstep, voffA);
        if (wr == 1) PG8_BAR;
        PG8_WAIT_V(2); PG8_BAR;
        PG8_STAGE(PG8_SB(1, 0), cB + kstep, voffB); PG8_STAGE(PG8_SA(1, 0), cA + kstep, voffA); PG8_STAGE(PG8_SB(1, 1), cB + hstep + kstep, voffB);
        PG8_WAIT_V(6); PG8_BAR;
    } else {
        PG8_STAGE(PG8_SB(0, 0), cB, voffB); PG8_STAGE(PG8_SA(0, 0), cA, voffA); PG8_STAGE(PG8_SB(0, 1), cB + hstep, voffB); PG8_STAGE(PG8_SA(0, 1), cA + hstep, voffA);
        if (wr == 1) PG8_BAR;
        PG8_WAIT_V(4); PG8_BAR;
        PG8_STAGE(PG8_SB(1, 0), cB + kstep, voffB); PG8_STAGE(PG8_SA(1, 0), cA + kstep, voffA); PG8_STAGE(PG8_SB(1, 1), cB + hstep + kstep, voffB);
        PG8_WAIT_V(6); PG8_BAR;
    }
    for (;;) {
        const bool has_next = S.next(ui + 1, nxt);
        const char* nA = has_next ? (const char*)g.A + (size_t)nxt.pm * tstep : cA; const char* nB = has_next ? (const char*)g.Bt + (size_t)nxt.pn * tstep : cB;
        for (int t = 0; t < nt; t += 2) {
            const bool last = (t == nt - 2);
            const char* a1 = cA + (size_t)(t + 1) * kstep;
            const char* a2 = last ? nA : cA + (size_t)(t + 2) * kstep; const char* b2 = last ? nB : cB + (size_t)(t + 2) * kstep;
            const char* a3 = a2 + kstep; const char* b3 = b2 + kstep;
            if (last && has_next) S.a_ready(nxt);
            if constexpr (SP2) {
            PG8_LDB(B0, 0, 0); PG8_LDB(B1, 0, 1); PG8_SCHED; PG8_LDA(At, 0, 0); PG8_STAGE(PG8_SA(1, 1), a1 + hstep, voffA);
            PG8_WAIT_V(8); PG8_WAIT_L(0); PG8_BAR; PG8_MMA(0, 0, At, B0); PG8_MMA(0, 1, At, B1); PG8_BAR; PG8_SCHED;
            PG8_LDA(At, 0, 1); PG8_STAGE(PG8_SB(0, 0), b2, voffB); PG8_STAGE(PG8_SB(0, 1), b2 + hstep, voffB); PG8_STAGE(PG8_SA(0, 0), a2, voffA);
            PG8_WAIT_V(8); PG8_WAIT_L(0); PG8_BAR; PG8_MMA(1, 0, At, B0); PG8_MMA(1, 1, At, B1); PG8_BAR; PG8_SCHED;
            PG8_LDB(B0, 1, 0); PG8_LDB(B1, 1, 1); PG8_SCHED; PG8_LDA(At, 1, 0); PG8_STAGE(PG8_SA(0, 1), a2 + hstep, voffA);
            PG8_WAIT_V(8); PG8_WAIT_L(0); PG8_BAR; PG8_MMA(0, 0, At, B0); PG8_MMA(0, 1, At, B1); PG8_BAR; PG8_SCHED;
            PG8_LDA(At, 1, 1); PG8_STAGE(PG8_SB(1, 0), b3, voffB); PG8_STAGE(PG8_SB(1, 1), b3 + hstep, voffB); PG8_STAGE(PG8_SA(1, 0), a3, voffA);
            PG8_WAIT_V(8); PG8_WAIT_L(0); PG8_BAR; PG8_MMA(1, 0, At, B0); PG8_MMA(1, 1, At, B1); PG8_BAR; PG8_SCHED;
            } else {
            PG8_LDB(B0, 0, 0); PG8_SCHED; PG8_LDA(At, 0, 0); PG8_STAGE(PG8_SA(1, 1), a1 + hstep, voffA);
            PG8_WAIT_L(8); PG8_BAR; PG8_WAIT_L(0); PG8_MMA(0, 0, At, B0); PG8_BAR; PG8_SCHED;
            PG8_LDB(B1, 0, 1); PG8_STAGE(PG8_SB(0, 0), b2, voffB);
            PG8_BAR; PG8_WAIT_L(0); PG8_MMA(0, 1, At, B1); PG8_BAR;
            PG8_LDA(At, 0, 1); PG8_STAGE(PG8_SA(0, 0), a2, voffA);
            PG8_BAR; PG8_WAIT_L(0); PG8_MMA(1, 0, At, B0); PG8_BAR; PG8_SCHED;
            PG8_STAGE(PG8_SB(0, 1), b2 + hstep, voffB);
            PG8_WAIT_V(6); PG8_BAR; PG8_MMA(1, 1, At, B1); PG8_BAR;
            PG8_LDB(B0, 1, 0); PG8_SCHED; PG8_LDA(At, 1, 0); PG8_STAGE(PG8_SA(0, 1), a2 + hstep, voffA);
            PG8_WAIT_L(8); PG8_BAR; PG8_WAIT_L(0); PG8_MMA(0, 0, At, B0); PG8_BAR; PG8_SCHED;
            PG8_LDB(B1, 1, 1); PG8_STAGE(PG8_SB(1, 0), b3, voffB);
            PG8_BAR; PG8_WAIT_L(0); PG8_MMA(0, 1, At, B1); PG8_BAR;
            PG8_LDA(At, 1, 1); PG8_STAGE(PG8_SA(1, 0), a3, voffA);
            PG8_BAR; PG8_WAIT_L(0); PG8_MMA(1, 0, At, B0); PG8_BAR; PG8_SCHED;
            PG8_STAGE(PG8_SB(1, 1), b3 + hstep, voffB);
            PG8_WAIT_V(6); PG8_BAR; PG8_MMA(1, 1, At, B1); PG8_BAR;
            }
        }
        if constexpr (ALIGN_EPI) { if (wr == 0) PG8_BAR; }
        if constexpr (!Epi::AFTER_DRAIN) { E(acc, cur, wr, wc, fr, fq); S.done(cur); }
        if (!has_next) break;
#pragma unroll
        for (int a = 0; a < 2; ++a)
#pragma unroll
            for (int b = 0; b < 2; ++b)
#pragma unroll
                for (int m = 0; m < 4; ++m)
#pragma unroll
                    for (int n = 0; n < 2; ++n) acc[a][b][m][n] = (f32x4){0.f, 0.f, 0.f, 0.f};
        cur = nxt; cA = nA; cB = nB; ++ui;
        if constexpr (ALIGN_EPI) { if (wr == 1) PG8_BAR; }
    }
    PG8_WAIT_V(0);
    if constexpr (!ALIGN_EPI) { if (wr == 0) PG8_BAR; }
    PG8_BAR;
    if constexpr (Epi::AFTER_DRAIN) { E.fused(acc, cur, wr, wc, fr, fq, lds, wid, lane); S.done(cur); }
#undef PG8_SA
#undef PG8_SB
#undef PG8_STAGE
#undef PG8_LDA
#undef PG8_LDB
#undef PG8_MMA
#undef PG8_WAIT_V
#undef PG8_WAIT_L
#undef PG8_BAR
#undef PG8_SCHED
}
}

typedef unsigned short bf16_t;
typedef short bf16x8 __attribute__((ext_vector_type(8)));
typedef float f32x4 __attribute__((ext_vector_type(4)));
typedef float f32x16 __attribute__((ext_vector_type(16)));
typedef unsigned u32x4 __attribute__((ext_vector_type(4)));
typedef unsigned u32x2 __attribute__((ext_vector_type(2)));
typedef __bf16 bf16x2v __attribute__((ext_vector_type(2)));
#define LDS_WAIT() asm volatile("s_waitcnt lgkmcnt(0)" ::: "memory")
__device__ __forceinline__ unsigned pk2(float lo, float hi) { return pg8::cvt_pk_bf16(lo, hi); }
__device__ __forceinline__ float bf_lo(unsigned w) { return __uint_as_float(w << 16); }
__device__ __forceinline__ float bf_hi(unsigned w) { return __uint_as_float(w & 0xffff0000u); }
__device__ __forceinline__ float wave_sum(float v) {
#pragma unroll
    for (int o = 1; o < 64; o <<= 1) v += __shfl_xor(v, o);
    return v;
}
__device__ __forceinline__ float swap32_f(float v) {
    auto rr = __builtin_amdgcn_permlane32_swap(__float_as_uint(v), __float_as_uint(v), false, false);
    return (threadIdx.x & 32) ? __uint_as_float(rr[0]) : __uint_as_float(rr[1]);
}
__device__ __forceinline__ float dot2bf(unsigned a, unsigned b, float acc) { return __builtin_amdgcn_fdot2_f32_bf16(__builtin_bit_cast(bf16x2v, a), __builtin_bit_cast(bf16x2v, b), acc, false); }

constexpr size_t MiB = 1u << 20;
constexpr size_t WS_CTL = 0, CTL_ZERO_BYTES = 1 * MiB;
constexpr size_t WS_KSUM = 512 * 1024;
constexpr size_t WS_MOD = 1 * MiB;
constexpr size_t WS_WQK = 2 * MiB;
constexpr size_t WS_WV = 6 * MiB;
constexpr size_t WS_WO = 8 * MiB;
constexpr size_t WS_WC = 10 * MiB;
constexpr size_t WS_U8 = 16 * MiB, WS_V8 = 32 * MiB;
constexpr size_t WS_US = 51 * MiB;
constexpr size_t WS_WB = 52 * MiB;
constexpr size_t WS_VS = 50 * MiB;
constexpr size_t WS_H = 128 * MiB;
constexpr size_t WS_QK = 256 * MiB;
constexpr size_t WS_VT = 512 * MiB;
constexpr size_t WS_AO = 640 * MiB, WS_H8 = 640 * MiB, WS_Y = 640 * MiB;
constexpr size_t WS_SCA = 256 * MiB, WS_SCB = 832 * MiB;
constexpr size_t WS_PART = 256 * MiB;
constexpr size_t WS_PE = 960 * MiB, WS_PG = 976 * MiB;
constexpr size_t WS_END = 1008 * MiB;
constexpr int CW_BAR = 4096;

constexpr int LDS_BYTES = 163840, MISC_OFF = LDS_BYTES - 256;

#define XB_TMO      128
#define XB_XCNT(j)  (256  + 64 * (j))
#define XB_XSUB(j)  (1280 + 64 * (j))
#define XB_XGEN(j)  (2304 + 64 * (j))
#define XB_TOP      3328
#define XB_TOPGEN   3392
#define XCD_BAR_WORDS 3456
#define XB_SPIN_CAP (1u << 18)
__device__ __forceinline__ unsigned xb_ld(unsigned* p)              { return __hip_atomic_load(p, __ATOMIC_RELAXED, __HIP_MEMORY_SCOPE_AGENT); }
__device__ __forceinline__ unsigned xb_add(unsigned* p, unsigned v) { return __hip_atomic_fetch_add(p, v, __ATOMIC_RELAXED, __HIP_MEMORY_SCOPE_AGENT); }
__device__ __forceinline__ unsigned xb_xcc_id() { return (unsigned)__builtin_amdgcn_s_getreg((3 << 11) | 20) & 0xFu; }
#define XB_SPIN(cond, bar) do { unsigned _sp = 0; while (cond) { __builtin_amdgcn_s_sleep(1); \
    if ((++_sp & 255u) == 0u) { if (xb_ld(&(bar)[XB_TMO])) break; if (_sp > XB_SPIN_CAP) { atomicAdd(&(bar)[XB_TMO], 1u); break; } } } } while (0)
struct XcdBarrier { unsigned* bar; unsigned x; volatile LAS unsigned* st; };
__device__ __forceinline__ XcdBarrier xcd_barrier_post(unsigned* bar, volatile LAS unsigned* st) {
    XcdBarrier b; b.bar = bar; b.x = xb_xcc_id(); b.st = st;
    if (threadIdx.x == 0) (void)xb_add(&bar[XB_XCNT(b.x)], 1u);
    return b;
}
__device__ __forceinline__ void xcd_barrier_complete(unsigned* bar, unsigned x, unsigned& nloc, unsigned& nx) {
    const unsigned G = gridDim.x * gridDim.y * gridDim.z;
    unsigned sum, cnt, mine, sp = 0u;
    for (;;) {
        sum = 0u; cnt = 0u; mine = 0u;
#pragma unroll
        for (unsigned j = 0; j < 16; ++j) { const unsigned c = xb_ld(&bar[XB_XCNT(j)]); sum += c; cnt += (c > 0u) ? 1u : 0u; mine = (j == x) ? c : mine; }
        if (sum == G) break;
        __builtin_amdgcn_s_sleep(1);
        if ((++sp & 255u) == 0u) { if (xb_ld(&bar[XB_TMO])) break; if (sp > XB_SPIN_CAP) { atomicAdd(&bar[XB_TMO], 1u); break; } }
    }
    nloc = mine > 0u ? mine : 1u; nx = cnt > 0u ? cnt : 1u;
}
__device__ __forceinline__ void xcd_barrier(const XcdBarrier& b) {
    asm volatile("s_waitcnt vmcnt(0)" ::: "memory");
    __syncthreads();
    if (threadIdx.x == 0) {
        unsigned* bar = b.bar;
        __builtin_amdgcn_s_waitcnt(0);
        unsigned nloc = b.st[0], nx = b.st[1];
        if (nloc == 0u) { xcd_barrier_complete(bar, b.x, nloc, nx); b.st[0] = nloc; b.st[1] = nx; }
        const unsigned old = xb_add(&bar[XB_XSUB(b.x)], 1u);
        const unsigned gen = old / nloc;
        if (old + 1u == (gen + 1u) * nloc) {
            __builtin_amdgcn_fence(__ATOMIC_RELEASE, "agent");
            asm volatile("s_waitcnt vmcnt(0)" ::: "memory");
            const unsigned og = xb_add(&bar[XB_TOP], 1u);
            const unsigned tg = og / nx;
            if (og + 1u == (tg + 1u) * nx) xb_add(&bar[XB_TOPGEN], 1u);
            else XB_SPIN(xb_ld(&bar[XB_TOPGEN]) == tg, bar);
            __builtin_amdgcn_fence(__ATOMIC_ACQUIRE, "agent");
            xb_add(&bar[XB_XGEN(b.x)], 1u);
            asm volatile("s_waitcnt vmcnt(0)" ::: "memory");
        } else {
            XB_SPIN(xb_ld(&bar[XB_XGEN(b.x)]) == gen, bar);
            __builtin_amdgcn_fence(__ATOMIC_ACQUIRE, "agent");
            asm volatile("s_waitcnt vmcnt(0)" ::: "memory");
        }
    }
    __syncthreads();
}

struct Frame {
    LAS unsigned char* lds;
    int tid, lane, wave, vcu, G;
    const float *x, *c, *rel_bias, *w_ada, *b_ada, *norm1_g, *w_in, *diff_lambda, *subln_g, *w_out, *norm2_g, *peer_wq, *peer_keys, *peer_u, *peer_v, *final_g;
    float* out; unsigned char* ws;
};

__device__ __forceinline__ void p0_transpose_item(const float* W, int K, int N, bf16_t* WT, int row_off, LAS float* scr, int item, int lane) {
    const int nblk = N / 32, kb = item / nblk, nb = item % nblk, k0 = 64 * kb, n0 = 32 * nb;
#pragma unroll 8
    for (int i = 0; i < 32; ++i) { const int kk = 2 * i + (lane >> 5); scr[kk * 33 + (lane & 31)] = W[(size_t)(k0 + kk) * N + n0 + (lane & 31)]; }
    LDS_WAIT(); asm volatile("" ::: "memory");
    const int c = lane & 7;
#pragma unroll
    for (int j = 0; j < 4; ++j) { const int n = (lane >> 3) + 8 * j; const LAS float* s = scr + (8 * c) * 33 + n;
        u32x4 o; o.x = pk2(s[0 * 33], s[1 * 33]); o.y = pk2(s[2 * 33], s[3 * 33]); o.z = pk2(s[4 * 33], s[5 * 33]); o.w = pk2(s[6 * 33], s[7 * 33]);
        *(u32x4*)(WT + (size_t)(row_off + n0 + n) * K + k0 + 8 * c) = o; }
    LDS_WAIT(); asm volatile("" ::: "memory");
}
__device__ __forceinline__ void p0_prologue(Frame& F) {
    const int tid = F.tid, lane = F.lane, wave = F.wave;
    float* mod = (float*)(F.ws + WS_MOD);
    for (int it = blockIdx.x; it < 96; it += F.G) {
        LAS float* sc = (LAS float*)F.lds;
        LAS float* red = (LAS float*)(F.lds + 65536);
        for (int idx = tid; idx < 16384; idx += 512) { const int b = idx >> 10, k = idx & 1023; const float v = F.c[idx]; sc[k * 16 + b] = v / (1.f + __expf(-v)); }
        __syncthreads();
        const int n0 = it * 64;
        float acc[16];
#pragma unroll
        for (int b = 0; b < 16; ++b) acc[b] = 0.f;
        const float* wp = F.w_ada + (size_t)(wave * 128) * 6144 + n0 + lane;
#pragma unroll 4
        for (int k = 0; k < 128; ++k) {
            const float wv = wp[(size_t)k * 6144];
            const LAS f32x4* s4 = (const LAS f32x4*)(sc + (wave * 128 + k) * 16);
#pragma unroll
            for (int q = 0; q < 4; ++q) { const f32x4 s = s4[q]; acc[4 * q + 0] += s[0] * wv; acc[4 * q + 1] += s[1] * wv; acc[4 * q + 2] += s[2] * wv; acc[4 * q + 3] += s[3] * wv; }
        }
#pragma unroll
        for (int b = 0; b < 16; ++b) red[(wave * 16 + b) * 64 + lane] = acc[b];
        __syncthreads();
        for (int o = tid; o < 1024; o += 512) { const int b = o >> 6, ln = o & 63; float s = F.b_ada[n0 + ln];
#pragma unroll
            for (int w = 0; w < 8; ++w) s += red[(w * 16 + b) * 64 + ln];
            mod[b * 6144 + n0 + ln] = s; }
        __syncthreads();
    }
    for (int it = blockIdx.x; it < 256; it += F.G) {
        const int g = it >> 4, k0 = (it & 15) * 64;
        LAS float* KK = (LAS float*)F.lds;
        LAS float* AA = (LAS float*)(F.lds + 67584);
#pragma unroll
        for (int i = 0; i < 8; ++i) { const int idx = tid * 4 + 2048 * i, n = idx >> 7, d = idx & 127; *(LAS f32x4*)(KK + n * 132 + d) = *(const f32x4*)(F.peer_keys + (size_t)g * 16384 + idx); }
#pragma unroll
        for (int i = 0; i < 4; ++i) { const int idx = tid * 4 + 2048 * i, r = idx >> 7, d = idx & 127; *(LAS f32x4*)(AA + r * 132 + d) = *(const f32x4*)(F.peer_wq + (size_t)(k0 + r) * 2048 + g * 128 + d); }
        __syncthreads();
        const int kk = tid & 63, nq = wave;
        float acc[16];
#pragma unroll
        for (int j = 0; j < 16; ++j) acc[j] = 0.f;
        for (int d4 = 0; d4 < 32; ++d4) {
            const f32x4 a = *(const LAS f32x4*)(AA + kk * 132 + 4 * d4);
#pragma unroll
            for (int j = 0; j < 16; ++j) { const f32x4 kv = *(const LAS f32x4*)(KK + (nq * 16 + j) * 132 + 4 * d4); acc[j] += a[0] * kv[0] + a[1] * kv[1] + a[2] * kv[2] + a[3] * kv[3]; }
        }
        bf16_t* wc = (bf16_t*)(F.ws + WS_WC);
#pragma unroll
        for (int j = 0; j < 16; ++j) wc[(size_t)(g * 128 + nq * 16 + j) * 1024 + k0 + kk] = (bf16_t)(pk2(acc[j], 0.f) & 0xffffu);
        __syncthreads();
    }
    {
        LAS float* scr = (LAS float*)(F.lds + wave * 8448);
        const int gw = F.vcu * 8 + wave, NGW = F.G * 8;
        bf16_t* wqk = (bf16_t*)(F.ws + WS_WQK); bf16_t* wv = (bf16_t*)(F.ws + WS_WV); bf16_t* wo = (bf16_t*)(F.ws + WS_WO);
        constexpr int I_IN = 16 * 96, I_O = 16 * 32;
        for (int it = gw; it < I_IN + I_O; it += NGW) {
            if (it < I_IN) {
                const int nb = it % 96, n0 = nb * 32;
                if (n0 < 1024) p0_transpose_item(F.w_in, 1024, 3072, wqk, 0, scr, it, lane);
                else if (n0 < 1536) p0_transpose_item(F.w_in, 1024, 3072, wv, -1024, scr, it, lane);
                else if (n0 < 2560) p0_transpose_item(F.w_in, 1024, 3072, wqk, -512, scr, it, lane);
                else p0_transpose_item(F.w_in, 1024, 3072, wv, -2048, scr, it, lane);
            } else p0_transpose_item(F.w_out, 1024, 1024, wo, 0, scr, it - I_IN, lane);
        }
    }
    {
        const int gw = F.vcu * 8 + wave, NGW = F.G * 8;
        float* us = (float*)(F.ws + WS_US);
        for (int e = gw; e < NEXP; e += NGW) {
            const f32x4* src = (const f32x4*)(F.peer_u + (size_t)e * 1024 + lane * 16);
            f32x4 a[4]; float mx = 0.f;
#pragma unroll
            for (int q = 0; q < 4; ++q) { a[q] = src[q]; mx = fmaxf(mx, fmaxf(fmaxf(fabsf(a[q][0]), fabsf(a[q][1])), fmaxf(fabsf(a[q][2]), fabsf(a[q][3])))); }
#pragma unroll
            for (int o = 1; o < 64; o <<= 1) mx = fmaxf(mx, __shfl_xor(mx, o));
            const float sc = mx > 0.f ? mx * (0.9f / 6.f) : 1.f, inv = 1.f / sc;
            if (lane == 0) us[e] = sc;
            unsigned w[2] = {0u, 0u};
#pragma unroll
            for (int q = 0; q < 4; ++q)
#pragma unroll
                for (int k = 0; k < 4; ++k) {
                    const float v = a[q][k], t = fabsf(v) * inv;
                    unsigned code = (t > 0.25f) + (t > 0.75f) + (t > 1.25f) + (t > 1.75f) + (t > 2.5f) + (t > 3.5f) + (t > 5.0f);
                    code |= (v < 0.f) ? 8u : 0u;
                    const int el = q * 4 + k;
                    w[el >> 3] |= code << (4 * (el & 7));
                }
            *(u32x2*)(F.ws + WS_U8 + (size_t)(lane >> 4) * (NEXP * 128) + (size_t)e * 128 + (lane & 15) * 8) = (u32x2){w[0], w[1]};
        }
    }
    {
        const int gw = F.vcu * 8 + wave, NGW = F.G * 8;
        float* vs = (float*)(F.ws + WS_VS);
        for (int e = gw; e < NEXP; e += NGW) {
            const f32x4* src = (const f32x4*)(F.peer_v + (size_t)e * 1024 + lane * 16);
            f32x4 a[4]; float mx = 0.f;
#pragma unroll
            for (int q = 0; q < 4; ++q) { a[q] = src[q]; mx = fmaxf(mx, fmaxf(fmaxf(fabsf(a[q][0]), fabsf(a[q][1])), fmaxf(fabsf(a[q][2]), fabsf(a[q][3])))); }
#pragma unroll
            for (int o = 1; o < 64; o <<= 1) mx = fmaxf(mx, __shfl_xor(mx, o));
            const float sc = mx > 0.f ? mx * (0.9f / 6.f) : 1.f, inv = 1.f / sc;
            if (lane == 0) vs[e] = sc;
            unsigned w[2] = {0u, 0u};
#pragma unroll
            for (int q = 0; q < 4; ++q)
#pragma unroll
                for (int k = 0; k < 4; ++k) {
                    const float v = a[q][k], t = fabsf(v) * inv;
                    unsigned code = (t > 0.25f) + (t > 0.75f) + (t > 1.25f) + (t > 1.75f) + (t > 2.5f) + (t > 3.5f) + (t > 5.0f);
                    code |= (v < 0.f) ? 8u : 0u;
                    const int el = q * 4 + k;
                    w[el >> 3] |= code << (4 * (el & 7));
                }
            unsigned o2[2] = {0u, 0u}; const int nn = lane & 15, gb = lane & 48;
#pragma unroll
            for (int j = 0; j < 16; ++j) { const unsigned w0 = __shfl(w[0], gb + j), w1 = __shfl(w[1], gb + j); const unsigned nib = (((nn < 8) ? w0 : w1) >> (4 * (nn & 7))) & 15u; o2[j >> 3] |= nib << (4 * (j & 7)); }
            *(u32x2*)(F.ws + WS_V8 + (size_t)(lane >> 4) * (NEXP * 128) + (size_t)e * 128 + (lane & 15) * 8) = (u32x2){o2[0], o2[1]};
        }
    }
}

template <bool WITH8> __device__ __forceinline__ void norm_phase(Frame& F, const float* xin, const float* g, int sh_off, int sc_off, bf16_t* H, unsigned char* H8) {
    const float* mod = (const float*)(F.ws + WS_MOD);
    for (int tile = blockIdx.x; tile < MT / 256; tile += F.G) {
        const int b = tile >> 4, r0 = tile * 256 + F.wave * 32;
        f32x4 A[4], Bv[4];
#pragma unroll
        for (int j = 0; j < 4; ++j) { const int cix = 4 * F.lane + 256 * j;
            const f32x4 gg = *(const f32x4*)(g + cix), sc = *(const f32x4*)(mod + b * 6144 + sc_off + cix);
            A[j] = gg * (sc + 1.0f); Bv[j] = *(const f32x4*)(mod + b * 6144 + sh_off + cix); }
#pragma unroll 2
        for (int rr = 0; rr < 32; ++rr) {
            const float* xr = xin + (size_t)(r0 + rr) * 1024 + 4 * F.lane;
            f32x4 v[4]; float s = 0.f;
#pragma unroll
            for (int j = 0; j < 4; ++j) {
                if constexpr (WITH8) { const u32x2 w = *(const u32x2*)((const bf16_t*)xin + (size_t)(r0 + rr) * 2048 + 4 * F.lane + 256 * j); v[j] = (f32x4){bf_lo(w.x), bf_hi(w.x), bf_lo(w.y), bf_hi(w.y)}; }
                else v[j] = *(const f32x4*)(xr + 256 * j);
                s += (v[j][0] * v[j][0] + v[j][1] * v[j][1]) + (v[j][2] * v[j][2] + v[j][3] * v[j][3]); }
            const float rstd = 1.0f / sqrtf(wave_sum(s) * (1.f / 1024.f) + NORM_EPS);
            bf16_t* hr = H + (size_t)(r0 + rr) * 1024 + 4 * F.lane;
#pragma unroll
            for (int j = 0; j < 4; ++j) { const f32x4 y = v[j] * rstd * A[j] + Bv[j]; u32x2 o; o.x = pk2(y[0], y[1]); o.y = pk2(y[2], y[3]); *(u32x2*)(hr + 256 * j) = o;
                if constexpr (WITH8) {
                    int wh = 0; wh = __builtin_amdgcn_cvt_pk_fp8_f32(y[0], y[1], wh, false); wh = __builtin_amdgcn_cvt_pk_fp8_f32(y[2], y[3], wh, true);
                    const auto h01 = __builtin_amdgcn_cvt_pk_f32_fp8(wh, false), h23 = __builtin_amdgcn_cvt_pk_f32_fp8(wh, true);
                    int wl = 0; wl = __builtin_amdgcn_cvt_pk_fp8_f32((y[0] - h01[0]) * 16.f, (y[1] - h01[1]) * 16.f, wl, false); wl = __builtin_amdgcn_cvt_pk_fp8_f32((y[2] - h23[0]) * 16.f, (y[3] - h23[1]) * 16.f, wl, true);
                    unsigned char* h8 = H8 + (size_t)(r0 + rr) * 2048 + 4 * F.lane + 256 * j;
                    *(int*)h8 = wh; *(int*)(h8 + 1024) = wl; } }
        }
    }
}

namespace att {
constexpr int LDS_TAB = 98304;
constexpr int LDS_KM = LDS_TAB + 8192;
constexpr int LDS_SG = LDS_KM + 4096;
constexpr int LDS_LAM = LDS_SG + 512;
constexpr float THR = 8.0f;
__device__ __forceinline__ int crow(int r, int hi) { return (r & 3) + 8 * (r >> 2) + 4 * hi; }
__device__ __forceinline__ float pair_max(float v) { auto rr = __builtin_amdgcn_permlane32_swap(__float_as_uint(v), __float_as_uint(v), false, false); return fmaxf(__uint_as_float(rr[0]), __uint_as_float(rr[1])); }
__device__ __forceinline__ float pair_sum(float v) { auto rr = __builtin_amdgcn_permlane32_swap(__float_as_uint(v), __float_as_uint(v), false, false); return __uint_as_float(rr[0]) + __uint_as_float(rr[1]); }
__device__ __forceinline__ float max3f(float a, float b, float c) { return fmaxf(fmaxf(a, b), c); }

template <bool DIFF>
__device__ __forceinline__ bool unit(LAS unsigned char* lds, const bf16_t* __restrict__ QK, const bf16_t* __restrict__ VT, bf16_t* AO, const float* __restrict__ ksum, int b, int hh, int qt, float& mshift) {
    constexpr int DV = DIFF ? 128 : 64, ND0 = DV / 32;
    constexpr int STG = DIFF ? 32768 : 16384, VOFF = DIFF ? 16384 : 8192;
    const int tid = threadIdx.x, lane = tid & 63, r32 = lane & 31, hi = lane >> 5;
    const int wid = __builtin_amdgcn_readfirstlane(tid >> 6);
    const int map = DIFF ? (wid >> 2) : 0;
    const int qw0 = DIFF ? (qt * 128 + 32 * (wid & 3)) : (qt * 256 + 32 * wid);
    const int qpos = qw0 + r32;
    const size_t tok0 = (size_t)b * SEQ;
    const int srow = wid * 8 + (lane >> 3), sch = (lane & 7) ^ ((srow >> 1) & 7);
    const bf16_t* kg0 = QK + (tok0 + srow) * QKW + (DIFF ? (512 + hh * 128) : (1536 + hh * 64)) + sch * 8;
    const bf16_t* vg0 = VT + (size_t)((DIFF ? hh * 128 : 512 + hh * 64) + srow) * MT + tok0 + sch * 8;
    const int kx = (r32 >> 1) & 7;
    const int kr_base = r32 * 128 + (DIFF ? map * 8192 : 0);
    const int vr_base = VOFF + r32 * 128;
    bf16x8 qf[4];
    {
        const bf16_t* qp = QK + (tok0 + qpos) * QKW + (DIFF ? (hh * 128 + map * 64) : (1024 + hh * 64)) + hi * 8;
#pragma unroll
        for (int s = 0; s < 4; ++s) qf[s] = *(const bf16x8*)(qp + 16 * s);
    }
    const LAS float* tab = (const LAS float*)(lds + LDS_TAB) + (DIFF ? (map * 4 + hh) : (8 + hh)) * 128;
    unsigned selmask = 0u;
    if constexpr (!DIFF) {
        LAS float* km = (LAS float*)(lds + LDS_KM);
        for (int i = tid; i < 1024; i += 512) { const int n = i >> 6, dd = i & 63; km[i] = ksum[(size_t)(b * 16 + n) * 512 + hh * 64 + dd] * (1.f / 256.f); }
        __syncthreads();
        float qv[32];
#pragma unroll
        for (int s = 0; s < 4; ++s)
#pragma unroll
            for (int j = 0; j < 8; ++j) qv[s * 8 + j] = __uint_as_float(((unsigned)(unsigned short)qf[s][j]) << 16);
        float v0 = -INFINITY, v1 = -INFINITY, v2 = -INFINITY; int i0 = -1, i1 = -1, i2 = -1;
        for (int n = 0; n < qt; ++n) {
            float part = 0.f;
#pragma unroll
            for (int s = 0; s < 4; ++s) {
                const f32x4 ka = *(const LAS f32x4*)(km + n * 64 + 16 * s + 8 * hi), kb = *(const LAS f32x4*)(km + n * 64 + 16 * s + 8 * hi + 4);
                part += qv[s * 8 + 0] * ka[0] + qv[s * 8 + 1] * ka[1] + qv[s * 8 + 2] * ka[2] + qv[s * 8 + 3] * ka[3] + qv[s * 8 + 4] * kb[0] + qv[s * 8 + 5] * kb[1] + qv[s * 8 + 6] * kb[2] + qv[s * 8 + 7] * kb[3];
            }
            const float gte = pair_sum(part);
            if (gte > v0) { v2 = v1; i2 = i1; v1 = v0; i1 = i0; v0 = gte; i0 = n; }
            else if (gte > v1) { v2 = v1; i2 = i1; v1 = gte; i1 = n; }
            else if (gte > v2) { v2 = gte; i2 = n; }
        }
        if (i0 >= 0) selmask |= 1u << i0;
        if (i1 >= 0) selmask |= 1u << i1;
        if (i2 >= 0) selmask |= 1u << i2;
    }
    const int NTILE = DIFF ? 2 * (qt + 1) : 4 * (qt + 1);
    auto tile_k0 = [&](int i) -> int { if constexpr (DIFF) return 64 * i; else return (i < 4) ? (qt * 256 + 64 * i) : (((i - 4) >> 2) * 256 + 64 * ((i - 4) & 3)); };
    auto stage_from = [&](const bf16_t* kp, const bf16_t* vp, int buf) {
        LAS unsigned char* sb = lds + buf * STG + wid * 1024;
        __builtin_amdgcn_global_load_lds((const unsigned*)kp, (LAS unsigned*)sb, 16, 0, 0);
        if constexpr (DIFF) {
            __builtin_amdgcn_global_load_lds((const unsigned*)(kp + 64), (LAS unsigned*)(sb + 8192), 16, 0, 0);
            __builtin_amdgcn_global_load_lds((const unsigned*)vp, (LAS unsigned*)(sb + VOFF), 16, 0, 0);
            __builtin_amdgcn_global_load_lds((const unsigned*)(vp + (size_t)64 * MT), (LAS unsigned*)(sb + VOFF + 8192), 16, 0, 0);
        } else {
            __builtin_amdgcn_global_load_lds((const unsigned*)vp, (LAS unsigned*)(sb + VOFF), 16, 0, 0);
        }
    };
    auto stage = [&](int k0, int buf) { stage_from(kg0 + (size_t)k0 * QKW, vg0 + k0, buf); };
    float m_ref = 0.f, l_run = 0.f, smax = 0.f;
    float cblk = 0.f;
    f32x16 o[ND0];
#pragma unroll
    for (int d0 = 0; d0 < ND0; ++d0) o[d0] = f32x16{};
    constexpr int NMF = 4 * ND0, EPM = 32 / NMF;
    u32x4 pkA[4], pkB[4];
    constexpr int VB = DIFF ? 1 : 2;
    bf16x8 vfr[VB][ND0];
    auto qk_tile = [&](int t, int bufi, int bufprev, f32x16& p0, f32x16& p1, auto firstc) {
        constexpr bool FIRST = decltype(firstc)::value;
        const int k0 = tile_k0(t);
        const LAS unsigned char* sb = lds + bufi * STG;
        if constexpr (!DIFF) {
            if (t >= 4 && ((t & 3) == 0)) { const bool msk = ((selmask >> ((t - 4) >> 2)) & 1u) == 0u; cblk = msk ? NEGBIG : -m_ref; }
        }
        bf16x8 kfa[4], kfb[4];
#pragma unroll
        for (int s = 0; s < 4; ++s) { const int co = ((2 * s + hi) ^ kx) << 4; kfa[s] = *(const LAS bf16x8*)(sb + kr_base + co); kfb[s] = *(const LAS bf16x8*)(sb + kr_base + 4096 + co); }
        if constexpr (!FIRST) {
            const LAS unsigned char* sp = lds + bufprev * STG;
#pragma unroll
            for (int ks = 0; ks < VB; ++ks) { const int vo = ((2 * ks + hi) ^ kx) << 4;
#pragma unroll
                for (int d0 = 0; d0 < ND0; ++d0) vfr[ks][d0] = *(const LAS bf16x8*)(sp + vr_base + d0 * 4096 + vo); }
        }
        __builtin_amdgcn_sched_barrier(0);
        if constexpr (FIRST) { p0 = __builtin_amdgcn_mfma_f32_32x32x16_bf16(kfa[0], qf[0], f32x16{}, 0, 0, 0); p1 = __builtin_amdgcn_mfma_f32_32x32x16_bf16(kfb[0], qf[0], f32x16{}, 0, 0, 0); }
        else {
            const float c0 = (!DIFF && t >= 4) ? cblk : -m_ref;
#pragma unroll
            for (int r = 0; r < 16; ++r) { p0[r] = c0; p1[r] = c0; }
            p0 = __builtin_amdgcn_mfma_f32_32x32x16_bf16(kfa[0], qf[0], p0, 0, 0, 0); p1 = __builtin_amdgcn_mfma_f32_32x32x16_bf16(kfb[0], qf[0], p1, 0, 0, 0); }
#pragma unroll
        for (int s = 1; s < 4; ++s) {
            p0 = __builtin_amdgcn_mfma_f32_32x32x16_bf16(kfa[s], qf[s], p0, 0, 0, 0);
            p1 = __builtin_amdgcn_mfma_f32_32x32x16_bf16(kfb[s], qf[s], p1, 0, 0, 0);
        }
        __builtin_amdgcn_sched_barrier(0);
        if (qw0 - (k0 + 63) < 128) {
            int dbase = qpos - k0 - 4 * hi; asm volatile("" : "+v"(dbase));
#pragma unroll
            for (int rq = 0; rq < 4; ++rq) {
#pragma unroll
                for (int r = 4 * rq; r < 4 * rq + 4; ++r) {
                    const int d0_ = dbase - crow(r, 0), d1_ = d0_ - 32;
                    const float b0 = tab[min(max(d0_, 0), 127)], b1 = tab[min(max(d1_, 0), 127)];
                    p0[r] = d0_ < 0 ? NEGBIG : p0[r] + b0; p1[r] = d1_ < 0 ? NEGBIG : p1[r] + b1;
                }
                __builtin_amdgcn_sched_barrier(0);
            }
        }
    };
    auto softmax_only = [&](f32x16& p0, f32x16& p1, u32x4 (&pkn)[4]) {
        float sum = 0.f;
#pragma unroll
        for (int r = 0; r < 16; ++r) { p0[r] = __builtin_amdgcn_exp2f(p0[r]); p1[r] = __builtin_amdgcn_exp2f(p1[r]); sum += p0[r] + p1[r]; }
        l_run += sum; smax = fmaxf(smax, sum);
        pkn[0] = (u32x4){pk2(p0[0], p0[1]), pk2(p0[2], p0[3]), pk2(p0[4], p0[5]), pk2(p0[6], p0[7])};
        pkn[1] = (u32x4){pk2(p0[8], p0[9]), pk2(p0[10], p0[11]), pk2(p0[12], p0[13]), pk2(p0[14], p0[15])};
        pkn[2] = (u32x4){pk2(p1[0], p1[1]), pk2(p1[2], p1[3]), pk2(p1[4], p1[5]), pk2(p1[6], p1[7])};
        pkn[3] = (u32x4){pk2(p1[8], p1[9]), pk2(p1[10], p1[11]), pk2(p1[12], p1[13]), pk2(p1[14], p1[15])};
    };
    auto pv_exp = [&](int bufprev, const u32x4 (&pkp)[4], f32x16& p0, f32x16& p1, u32x4 (&pkn)[4], auto withexp) {
        constexpr bool WE = decltype(withexp)::value;
        const LAS unsigned char* sp = lds + bufprev * STG;
        float sum = 0.f;
#pragma unroll
        for (int i = 0; i < NMF; ++i) {
            const int ks = i / ND0, d0 = i % ND0;
            const bf16x8 pf = __builtin_bit_cast(bf16x8, pkp[ks]);
            o[d0] = __builtin_amdgcn_mfma_f32_32x32x16_bf16(vfr[ks % VB][d0], pf, o[d0], 0, 0, 0);
            if (d0 == ND0 - 1 && ks + VB < 4) { const int vo = ((2 * (ks + VB) + hi) ^ kx) << 4;
#pragma unroll
                for (int dd = 0; dd < ND0; ++dd) vfr[ks % VB][dd] = *(const LAS bf16x8*)(sp + vr_base + dd * 4096 + vo); }
            if constexpr (WE) {
#pragma unroll
                for (int e2 = 0; e2 < EPM; e2 += 2) {
                    const int j = i * EPM + e2;
                    float a = (j < 16) ? p0[j] : p1[j - 16], b2 = (j < 16) ? p0[j + 1] : p1[j - 15];
                    a = __builtin_amdgcn_exp2f(a); b2 = __builtin_amdgcn_exp2f(b2);
                    sum += a; sum += b2;
                    unsigned wv = pk2(a, b2);
                    asm volatile("" : "+v"(wv), "+v"(sum));
                    pkn[j >> 3][(j >> 1) & 3] = wv;
                }
            }
            __builtin_amdgcn_sched_barrier(0);
        }
        l_run += sum; if constexpr (WE) smax = fmaxf(smax, sum);
    };
    if constexpr (DIFF) {
    stage(tile_k0(0), 0);
    __syncthreads();
    {
        f32x16 p0, p1;
        stage(tile_k0(1), 1);
        qk_tile(0, 0, 0, p0, p1, std::true_type{});
        float mx = max3f(p0[0], p0[1], p1[0]);
#pragma unroll
        for (int r = 2; r < 16; r += 2) mx = max3f(mx, p0[r], p0[r + 1]);
#pragma unroll
        for (int r = 1; r < 15; r += 2) mx = max3f(mx, p1[r], p1[r + 1]);
        mx = fmaxf(mx, p1[15]);
        m_ref = pair_max(mx) + mshift;
#pragma unroll
        for (int r = 0; r < 16; ++r) { p0[r] -= m_ref; p1[r] -= m_ref; }
        softmax_only(p0, p1, pkA);
        __syncthreads();
    }
    int bp = 0, bc = 1, bn = 2;
    for (int t = 1; t < NTILE; t += 2) {
        {   f32x16 p0, p1;
            if (t + 1 < NTILE) stage(tile_k0(t + 1), bn);
            qk_tile(t, bc, bp, p0, p1, std::false_type{});
            pv_exp(bp, pkA, p0, p1, pkB, std::true_type{});
            __syncthreads();
            const int tmp = bp; bp = bc; bc = bn; bn = tmp; }
        if (t + 1 < NTILE) {
            f32x16 p0, p1;
            if (t + 2 < NTILE) stage(tile_k0(t + 2), bn);
            qk_tile(t + 1, bc, bp, p0, p1, std::false_type{});
            pv_exp(bp, pkB, p0, p1, pkA, std::true_type{});
            __syncthreads();
            const int tmp = bp; bp = bc; bc = bn; bn = tmp; }
    }
    {
        const LAS unsigned char* sp = lds + bp * STG;
#pragma unroll
        for (int ks = 0; ks < VB; ++ks) { const int vo = ((2 * ks + hi) ^ kx) << 4;
#pragma unroll
            for (int d0 = 0; d0 < ND0; ++d0) vfr[ks][d0] = *(const LAS bf16x8*)(sp + vr_base + d0 * 4096 + vo); }
        f32x16 dz0, dz1;
        pv_exp(bp, pkB, dz0, dz1, pkA, std::false_type{});
        __syncthreads();
    }
    } else
    {
        f32x16 pA0, pA1, pB0, pB1;
        bf16x8 kfa[4], kfb[4];
        auto kread = [&](int tt) { const LAS unsigned char* sk = lds + (tt & 3) * STG;
#pragma unroll
            for (int s_ = 0; s_ < 4; ++s_) { const int co = ((2 * s_ + hi) ^ kx) << 4; kfa[s_] = *(const LAS bf16x8*)(sk + kr_base + co); kfb[s_] = *(const LAS bf16x8*)(sk + kr_base + 4096 + co); } };
        auto vread = [&](int tt) { const LAS unsigned char* sp = lds + (tt & 3) * STG;
#pragma unroll
            for (int ks = 0; ks < VB; ++ks) { const int vo = ((2 * ks + hi) ^ kx) << 4;
#pragma unroll
                for (int d0 = 0; d0 < ND0; ++d0) vfr[ks][d0] = *(const LAS bf16x8*)(sp + vr_base + d0 * 4096 + vo); } };
        auto cinit = [&](int tt, f32x16& q0, f32x16& q1) {
            if (tt >= 4 && ((tt & 3) == 0)) { const bool msk = ((selmask >> ((tt - 4) >> 2)) & 1u) == 0u; cblk = msk ? NEGBIG : -m_ref; }
            const float c0 = (tt >= 4) ? cblk : -m_ref;
#pragma unroll
            for (int r = 0; r < 16; ++r) { q0[r] = c0; q1[r] = c0; } };
        auto nearbias = [&](int tt, f32x16& q0, f32x16& q1) {
            const int k0 = tile_k0(tt);
            if (qw0 - (k0 + 63) < 128) {
                int dbase = qpos - k0 - 4 * hi; asm volatile("" : "+v"(dbase));
#pragma unroll
                for (int rq = 0; rq < 4; ++rq) {
#pragma unroll
                    for (int r = 4 * rq; r < 4 * rq + 4; ++r) {
                        const int d0_ = dbase - crow(r, 0), d1_ = d0_ - 32;
                        const float b0 = tab[min(max(d0_, 0), 127)], b1 = tab[min(max(d1_, 0), 127)];
                        q0[r] = d0_ < 0 ? NEGBIG : q0[r] + b0; q1[r] = d1_ < 0 ? NEGBIG : q1[r] + b1;
                    }
                    __builtin_amdgcn_sched_barrier(0);
                }
            } };
        auto seg = [&](int t, f32x16& c0v, f32x16& c1v, f32x16& n0, f32x16& n1, const u32x4 (&pkp)[4], u32x4 (&pkc)[4], auto hasqk, auto haspv) {
            constexpr bool HASQK = decltype(hasqk)::value, HASPV = decltype(haspv)::value;
            const LAS unsigned char* sp = lds + ((t - 1) & 3) * STG;
            float sum = 0.f;
#pragma unroll
            for (int i = 0; i < 8; ++i) {
                if constexpr (HASQK) { const int s_ = i >> 1;
                    if (i & 1) n1 = __builtin_amdgcn_mfma_f32_32x32x16_bf16(kfb[s_], qf[s_], n1, 0, 0, 0);
                    else       n0 = __builtin_amdgcn_mfma_f32_32x32x16_bf16(kfa[s_], qf[s_], n0, 0, 0, 0); }
                if constexpr (HASPV) { const int ks = i >> 1, d0 = i & 1;
                    o[d0] = __builtin_amdgcn_mfma_f32_32x32x16_bf16(vfr[ks % VB][d0], __builtin_bit_cast(bf16x8, pkp[ks]), o[d0], 0, 0, 0);
                    if (d0 == 1 && ks + VB < 4) { const int vo = ((2 * (ks + VB) + hi) ^ kx) << 4;
#pragma unroll
                        for (int dd = 0; dd < ND0; ++dd) vfr[ks % VB][dd] = *(const LAS bf16x8*)(sp + vr_base + dd * 4096 + vo); } }
#pragma unroll
                for (int e2 = 0; e2 < 4; e2 += 2) {
                    const int j = 4 * i + e2;
                    float a_ = (j < 16) ? c0v[j] : c1v[j - 16], b_ = (j < 16) ? c0v[j + 1] : c1v[j - 15];
                    a_ = __builtin_amdgcn_exp2f(a_); b_ = __builtin_amdgcn_exp2f(b_);
                    sum += a_; sum += b_;
                    unsigned wv = pk2(a_, b_);
                    asm volatile("" : "+v"(wv), "+v"(sum));
                    pkc[j >> 3][(j >> 1) & 3] = wv;
                }
                __builtin_amdgcn_sched_barrier(0);
            }
            l_run += sum; smax = fmaxf(smax, sum);
        };
        stage(tile_k0(0), 0);
        __syncthreads();
        stage(tile_k0(1), 1);
        {
            kread(0);
            __builtin_amdgcn_sched_barrier(0);
            pA0 = __builtin_amdgcn_mfma_f32_32x32x16_bf16(kfa[0], qf[0], f32x16{}, 0, 0, 0); pA1 = __builtin_amdgcn_mfma_f32_32x32x16_bf16(kfb[0], qf[0], f32x16{}, 0, 0, 0);
#pragma unroll
            for (int s_ = 1; s_ < 4; ++s_) { pA0 = __builtin_amdgcn_mfma_f32_32x32x16_bf16(kfa[s_], qf[s_], pA0, 0, 0, 0); pA1 = __builtin_amdgcn_mfma_f32_32x32x16_bf16(kfb[s_], qf[s_], pA1, 0, 0, 0); }
            __builtin_amdgcn_sched_barrier(0);
            nearbias(0, pA0, pA1);
            float mx = max3f(pA0[0], pA0[1], pA1[0]);
#pragma unroll
            for (int r = 2; r < 16; r += 2) mx = max3f(mx, pA0[r], pA0[r + 1]);
#pragma unroll
            for (int r = 1; r < 15; r += 2) mx = max3f(mx, pA1[r], pA1[r + 1]);
            mx = fmaxf(mx, pA1[15]);
            m_ref = pair_max(mx) + mshift;
#pragma unroll
            for (int r = 0; r < 16; ++r) { pA0[r] -= m_ref; pA1[r] -= m_ref; }
        }
        __syncthreads();
        {
            stage(tile_k0(2), 2);
            kread(1); cinit(1, pB0, pB1);
            __builtin_amdgcn_sched_barrier(0);
            seg(0, pA0, pA1, pB0, pB1, pkB, pkA, std::true_type{}, std::false_type{});
            nearbias(1, pB0, pB1);
            __syncthreads();
        }
        for (int t = 1; t + 2 < NTILE; t += 2) {
            {
                if (t + 2 < NTILE) stage(tile_k0(t + 2), (t + 2) & 3);
                kread(t + 1); vread(t - 1); cinit(t + 1, pA0, pA1);
                __builtin_amdgcn_sched_barrier(0);
                seg(t, pB0, pB1, pA0, pA1, pkA, pkB, std::true_type{}, std::true_type{});
                nearbias(t + 1, pA0, pA1);
                __syncthreads(); }
            {
                if (t + 3 < NTILE) stage(tile_k0(t + 3), (t + 3) & 3);
                kread(t + 2); vread(t); cinit(t + 2, pB0, pB1);
                __builtin_amdgcn_sched_barrier(0);
                seg(t + 1, pA0, pA1, pB0, pB1, pkB, pkA, std::true_type{}, std::true_type{});
                nearbias(t + 2, pB0, pB1);
                __syncthreads(); }
        }
        {
            vread(NTILE - 2);
            __builtin_amdgcn_sched_barrier(0);
            seg(NTILE - 1, pB0, pB1, pA0, pA1, pkA, pkB, std::false_type{}, std::true_type{});
            __syncthreads();
        }
        {
            vread(NTILE - 1);
            f32x16 dz0, dz1;
            pv_exp((NTILE - 1) & 3, pkB, dz0, dz1, pkA, std::false_type{});
            __syncthreads();
        }
    }
    {
        const bool badl = !(smax <= 0x1p60f);
        const int badp = __shfl_xor((int)badl, 32);
        const bool badrow = badl || (badp != 0);
        if (badrow) mshift += 64.f;
        LAS unsigned* flag = (LAS unsigned*)(lds + MISC_OFF + 64);
        if (tid == 0) *flag = 0u;
        __syncthreads();
        if (badrow) *flag = 1u;
        __syncthreads();
        const bool redo = *flag != 0u;
        __syncthreads();
        if (redo) return true;
    }
    const float linv = 1.0f / pair_sum(l_run);
    if constexpr (DIFF) {
        LAS float* ex = (LAS float*)lds;
        if (map == 1) {
#pragma unroll
            for (int d0 = 0; d0 < ND0; ++d0)
#pragma unroll
                for (int r = 0; r < 16; ++r) ex[(d0 * 16 + r) * 256 + (wid & 3) * 64 + lane] = o[d0][r] * linv;
        }
        __syncthreads();
        if (map == 0) {
            const float lam = *(const LAS float*)(lds + LDS_LAM);
            const LAS float* sg = (const LAS float*)(lds + LDS_SG);
            float ss = 0.f;
#pragma unroll
            for (int d0 = 0; d0 < ND0; ++d0)
#pragma unroll
                for (int r = 0; r < 16; ++r) { const float v = o[d0][r] * linv - lam * ex[(d0 * 16 + r) * 256 + (wid & 3) * 64 + lane]; o[d0][r] = v; ss += v * v; }
            ss = pair_sum(ss);
            const float rstd = 0.8f / sqrtf(ss * (1.f / 128.f) + NORM_EPS);
            bf16_t* op = AO + (tok0 + qpos) * 1024 + hh * 128 + 4 * hi;
#pragma unroll
            for (int d0 = 0; d0 < ND0; ++d0)
#pragma unroll
                for (int rg = 0; rg < 4; ++rg) {
                    const int dcol = 32 * d0 + 8 * rg + 4 * hi;
                    const f32x4 gg = *(const LAS f32x4*)(sg + dcol);
                    u32x2 w; w.x = pk2(o[d0][4 * rg] * rstd * gg[0], o[d0][4 * rg + 1] * rstd * gg[1]); w.y = pk2(o[d0][4 * rg + 2] * rstd * gg[2], o[d0][4 * rg + 3] * rstd * gg[3]);
                    *(u32x2*)(op + 32 * d0 + 8 * rg) = w;
                }
        }
        __syncthreads();
    } else {
        bf16_t* op = AO + (tok0 + qpos) * 1024 + 512 + hh * 64 + 4 * hi;
#pragma unroll
        for (int d0 = 0; d0 < ND0; ++d0)
#pragma unroll
            for (int rg = 0; rg < 4; ++rg) {
                u32x2 w; w.x = pk2(o[d0][4 * rg] * linv, o[d0][4 * rg + 1] * linv); w.y = pk2(o[d0][4 * rg + 2] * linv, o[d0][4 * rg + 3] * linv);
                *(u32x2*)(op + 32 * d0 + 8 * rg) = w;
            }
    }
    return false;
}
}

__device__ __forceinline__ void attn_phase(Frame& F) {
    const int tid = F.tid;
    {
        LAS float* tabs = (LAS float*)(F.lds + att::LDS_TAB);
        for (int i = tid; i < 2048; i += 512) {
            const int col = i >> 7, n = i & 127;
            int bucket;
            if (n < 16) bucket = n;
            else { const float nf = (float)n; int lg = 16 + (int)(logf(nf / 16.0f) / 2.0794415416798357f * 16.0f); bucket = lg < 31 ? lg : 31; }
            tabs[col * 128 + n] = (F.rel_bias[bucket * 16 + col] - F.rel_bias[31 * 16 + col]) * LOG2E;
        }
        LAS float* sg = (LAS float*)(F.lds + att::LDS_SG);
        if (tid < 128) sg[tid] = F.subln_g[tid];
        if (F.wave == 7) {
            const float a = F.diff_lambda[F.lane] * F.diff_lambda[64 + F.lane], bq = F.diff_lambda[128 + F.lane] * F.diff_lambda[192 + F.lane];
            const float sa = wave_sum(a), sb = wave_sum(bq);
            if (F.lane == 0) *(LAS float*)(F.lds + att::LDS_LAM) = expf(sa) - expf(sb) + 0.2f;
        }
        __syncthreads();
    }
    const bf16_t* QK = (const bf16_t*)(F.ws + WS_QK); const bf16_t* VT = (const bf16_t*)(F.ws + WS_VT); bf16_t* AO = (bf16_t*)(F.ws + WS_AO);
    const float* ksum = (const float*)(F.ws + WS_KSUM);
    if (F.G == 256) {
        { const int bh = F.vcu >> 2, quarter = F.vcu & 3;
          for (int i = 0; i < 8; ++i) { const int s = quarter * 4 + (i >> 1), qt = (i & 1) ? 31 - s : s; const int i2 = i + 1, s2 = quarter * 4 + (i2 >> 1), qt2 = (i2 & 1) ? 31 - s2 : s2;
              (void)qt2; float msh = 0.f; for (int a = 0; a < 8 && att::unit<true>(F.lds, QK, VT, AO, ksum, bh >> 2, bh & 3, qt, msh); ++a) {} } }
        { const int bh = F.vcu >> 1, half = F.vcu & 1;
          for (int i = 0; i < 8; ++i) { const int s = half * 4 + (i >> 1), qt = (i & 1) ? 15 - s : s; const int i2 = i + 1, s2 = half * 4 + (i2 >> 1), qt2 = (i2 & 1) ? 15 - s2 : s2;
              (void)qt2; float msh = 0.f; for (int a = 0; a < 8 && att::unit<false>(F.lds, QK, VT, AO, ksum, bh >> 3, bh & 7, qt, msh); ++a) {} } }
    } else {
        for (int u = blockIdx.x; u < 2048; u += F.G) { const int bh = u >> 5; float msh = 0.f; for (int a = 0; a < 8 && att::unit<true>(F.lds, QK, VT, AO, ksum, bh >> 2, bh & 3, u & 31, msh); ++a) {} }
        for (int u = blockIdx.x; u < 2048; u += F.G) { const int bh = u >> 4; float msh = 0.f; for (int a = 0; a < 8 && att::unit<false>(F.lds, QK, VT, AO, ksum, bh >> 3, bh & 7, u & 15, msh); ++a) {} }
    }
}

__device__ __forceinline__ unsigned f2key(float f) { const unsigned u = __float_as_uint(f); return (u & 0x80000000u) ? ~u : (u | 0x80000000u); }
typedef short s16x2 __attribute__((ext_vector_type(2)));
__device__ __forceinline__ unsigned h2key2(unsigned w) { const s16x2 s = __builtin_bit_cast(s16x2, w) >> 15; return w ^ (__builtin_bit_cast(unsigned, s) | 0x80008000u); }
__device__ __forceinline__ unsigned h2key(unsigned x) { return (x & 0x80000000u) ? ~x : (x | 0x80000000u); }
__device__ __forceinline__ float key2h(unsigned k) { const unsigned hb = ((k & 0x80000000u) ? (k & 0x7fffffffu) : ~k) >> 16; return (float)__builtin_bit_cast(_Float16, (unsigned short)hb); }
__device__ __forceinline__ float key2f(unsigned k) { const unsigned u = (k & 0x80000000u) ? (k & 0x7fffffffu) : ~k; return __uint_as_float(u); }
__device__ __forceinline__ void ins16(unsigned (&L)[16], unsigned x) {
#pragma unroll
    for (int k = 0; k < 16; ++k) { const unsigned t = max(L[k], x); x = min(L[k], x); L[k] = t; }
}
#define SORT16_DESC(L) do { unsigned t_; \
    t_ = max(L[0], L[1]); L[1] = min(L[0], L[1]); L[0] = t_; \
    t_ = max(L[2], L[3]); L[3] = min(L[2], L[3]); L[2] = t_; \
    t_ = max(L[0], L[2]); L[2] = min(L[0], L[2]); L[0] = t_; \
    t_ = max(L[1], L[3]); L[3] = min(L[1], L[3]); L[1] = t_; \
    t_ = max(L[1], L[2]); L[2] = min(L[1], L[2]); L[1] = t_; \
    t_ = max(L[4], L[5]); L[5] = min(L[4], L[5]); L[4] = t_; \
    t_ = max(L[6], L[7]); L[7] = min(L[6], L[7]); L[6] = t_; \
    t_ = max(L[4], L[6]); L[6] = min(L[4], L[6]); L[4] = t_; \
    t_ = max(L[5], L[7]); L[7] = min(L[5], L[7]); L[5] = t_; \
    t_ = max(L[5], L[6]); L[6] = min(L[5], L[6]); L[5] = t_; \
    t_ = max(L[0], L[4]); L[4] = min(L[0], L[4]); L[0] = t_; \
    t_ = max(L[2], L[6]); L[6] = min(L[2], L[6]); L[2] = t_; \
    t_ = max(L[2], L[4]); L[4] = min(L[2], L[4]); L[2] = t_; \
    t_ = max(L[1], L[5]); L[5] = min(L[1], L[5]); L[1] = t_; \
    t_ = max(L[3], L[7]); L[7] = min(L[3], L[7]); L[3] = t_; \
    t_ = max(L[3], L[5]); L[5] = min(L[3], L[5]); L[3] = t_; \
    t_ = max(L[1], L[2]); L[2] = min(L[1], L[2]); L[1] = t_; \
    t_ = max(L[3], L[4]); L[4] = min(L[3], L[4]); L[3] = t_; \
    t_ = max(L[5], L[6]); L[6] = min(L[5], L[6]); L[5] = t_; \
    t_ = max(L[8], L[9]); L[9] = min(L[8], L[9]); L[8] = t_; \
    t_ = max(L[10], L[11]); L[11] = min(L[10], L[11]); L[10] = t_; \
    t_ = max(L[8], L[10]); L[10] = min(L[8], L[10]); L[8] = t_; \
    t_ = max(L[9], L[11]); L[11] = min(L[9], L[11]); L[9] = t_; \
    t_ = max(L[9], L[10]); L[10] = min(L[9], L[10]); L[9] = t_; \
    t_ = max(L[12], L[13]); L[13] = min(L[12], L[13]); L[12] = t_; \
    t_ = max(L[14], L[15]); L[15] = min(L[14], L[15]); L[14] = t_; \
    t_ = max(L[12], L[14]); L[14] = min(L[12], L[14]); L[12] = t_; \
    t_ = max(L[13], L[15]); L[15] = min(L[13], L[15]); L[13] = t_; \
    t_ = max(L[13], L[14]); L[14] = min(L[13], L[14]); L[13] = t_; \
    t_ = max(L[8], L[12]); L[12] = min(L[8], L[12]); L[8] = t_; \
    t_ = max(L[10], L[14]); L[14] = min(L[10], L[14]); L[10] = t_; \
    t_ = max(L[10], L[12]); L[12] = min(L[10], L[12]); L[10] = t_; \
    t_ = max(L[9], L[13]); L[13] = min(L[9], L[13]); L[9] = t_; \
    t_ = max(L[11], L[15]); L[15] = min(L[11], L[15]); L[11] = t_; \
    t_ = max(L[11], L[13]); L[13] = min(L[11], L[13]); L[11] = t_; \
    t_ = max(L[9], L[10]); L[10] = min(L[9], L[10]); L[9] = t_; \
    t_ = max(L[11], L[12]); L[12] = min(L[11], L[12]); L[11] = t_; \
    t_ = max(L[13], L[14]); L[14] = min(L[13], L[14]); L[13] = t_; \
    t_ = max(L[0], L[8]); L[8] = min(L[0], L[8]); L[0] = t_; \
    t_ = max(L[4], L[12]); L[12] = min(L[4], L[12]); L[4] = t_; \
    t_ = max(L[4], L[8]); L[8] = min(L[4], L[8]); L[4] = t_; \
    t_ = max(L[2], L[10]); L[10] = min(L[2], L[10]); L[2] = t_; \
    t_ = max(L[6], L[14]); L[14] = min(L[6], L[14]); L[6] = t_; \
    t_ = max(L[6], L[10]); L[10] = min(L[6], L[10]); L[6] = t_; \
    t_ = max(L[2], L[4]); L[4] = min(L[2], L[4]); L[2] = t_; \
    t_ = max(L[6], L[8]); L[8] = min(L[6], L[8]); L[6] = t_; \
    t_ = max(L[10], L[12]); L[12] = min(L[10], L[12]); L[10] = t_; \
    t_ = max(L[1], L[9]); L[9] = min(L[1], L[9]); L[1] = t_; \
    t_ = max(L[5], L[13]); L[13] = min(L[5], L[13]); L[5] = t_; \
    t_ = max(L[5], L[9]); L[9] = min(L[5], L[9]); L[5] = t_; \
    t_ = max(L[3], L[11]); L[11] = min(L[3], L[11]); L[3] = t_; \
    t_ = max(L[7], L[15]); L[15] = min(L[7], L[15]); L[7] = t_; \
    t_ = max(L[7], L[11]); L[11] = min(L[7], L[11]); L[7] = t_; \
    t_ = max(L[3], L[5]); L[5] = min(L[3], L[5]); L[3] = t_; \
    t_ = max(L[7], L[9]); L[9] = min(L[7], L[9]); L[7] = t_; \
    t_ = max(L[11], L[13]); L[13] = min(L[11], L[13]); L[11] = t_; \
    t_ = max(L[1], L[2]); L[2] = min(L[1], L[2]); L[1] = t_; \
    t_ = max(L[3], L[4]); L[4] = min(L[3], L[4]); L[3] = t_; \
    t_ = max(L[5], L[6]); L[6] = min(L[5], L[6]); L[5] = t_; \
    t_ = max(L[7], L[8]); L[8] = min(L[7], L[8]); L[7] = t_; \
    t_ = max(L[9], L[10]); L[10] = min(L[9], L[10]); L[9] = t_; \
    t_ = max(L[11], L[12]); L[12] = min(L[11], L[12]); L[11] = t_; \
    t_ = max(L[13], L[14]); L[14] = min(L[13], L[14]); L[13] = t_; \
} while (0)
#define BITONIC16_DESC(L) do { unsigned t_; \
    t_ = max(L[0], L[8]); L[8] = min(L[0], L[8]); L[0] = t_; \
    t_ = max(L[1], L[9]); L[9] = min(L[1], L[9]); L[1] = t_; \
    t_ = max(L[2], L[10]); L[10] = min(L[2], L[10]); L[2] = t_; \
    t_ = max(L[3], L[11]); L[11] = min(L[3], L[11]); L[3] = t_; \
    t_ = max(L[4], L[12]); L[12] = min(L[4], L[12]); L[4] = t_; \
    t_ = max(L[5], L[13]); L[13] = min(L[5], L[13]); L[5] = t_; \
    t_ = max(L[6], L[14]); L[14] = min(L[6], L[14]); L[6] = t_; \
    t_ = max(L[7], L[15]); L[15] = min(L[7], L[15]); L[7] = t_; \
    t_ = max(L[0], L[4]); L[4] = min(L[0], L[4]); L[0] = t_; \
    t_ = max(L[1], L[5]); L[5] = min(L[1], L[5]); L[1] = t_; \
    t_ = max(L[2], L[6]); L[6] = min(L[2], L[6]); L[2] = t_; \
    t_ = max(L[3], L[7]); L[7] = min(L[3], L[7]); L[3] = t_; \
    t_ = max(L[8], L[12]); L[12] = min(L[8], L[12]); L[8] = t_; \
    t_ = max(L[9], L[13]); L[13] = min(L[9], L[13]); L[9] = t_; \
    t_ = max(L[10], L[14]); L[14] = min(L[10], L[14]); L[10] = t_; \
    t_ = max(L[11], L[15]); L[15] = min(L[11], L[15]); L[11] = t_; \
    t_ = max(L[0], L[2]); L[2] = min(L[0], L[2]); L[0] = t_; \
    t_ = max(L[1], L[3]); L[3] = min(L[1], L[3]); L[1] = t_; \
    t_ = max(L[4], L[6]); L[6] = min(L[4], L[6]); L[4] = t_; \
    t_ = max(L[5], L[7]); L[7] = min(L[5], L[7]); L[5] = t_; \
    t_ = max(L[8], L[10]); L[10] = min(L[8], L[10]); L[8] = t_; \
    t_ = max(L[9], L[11]); L[11] = min(L[9], L[11]); L[9] = t_; \
    t_ = max(L[12], L[14]); L[14] = min(L[12], L[14]); L[12] = t_; \
    t_ = max(L[13], L[15]); L[15] = min(L[13], L[15]); L[13] = t_; \
    t_ = max(L[0], L[1]); L[1] = min(L[0], L[1]); L[0] = t_; \
    t_ = max(L[2], L[3]); L[3] = min(L[2], L[3]); L[2] = t_; \
    t_ = max(L[4], L[5]); L[5] = min(L[4], L[5]); L[4] = t_; \
    t_ = max(L[6], L[7]); L[7] = min(L[6], L[7]); L[6] = t_; \
    t_ = max(L[8], L[9]); L[9] = min(L[8], L[9]); L[8] = t_; \
    t_ = max(L[10], L[11]); L[11] = min(L[10], L[11]); L[10] = t_; \
    t_ = max(L[12], L[13]); L[13] = min(L[12], L[13]); L[12] = t_; \
    t_ = max(L[14], L[15]); L[15] = min(L[14], L[15]); L[14] = t_; \
} while (0)
__device__ __forceinline__ void topk_panel(Frame& F, const void* P, int pm) {
    const int tid = F.tid, row = tid & 255, hq = tid >> 8;
    LAS unsigned* OUT = (LAS unsigned*)(F.lds + 16384) + row * 132;
    for (int hh = 0; hh < 4; ++hh) {
        const int h = hq * 4 + hh;
        unsigned L1[16], L2[16];
#pragma unroll
        for (int k = 0; k < 16; ++k) { L1[k] = 0u; L2[k] = 0u; }
        const u32x2* p1 = (const u32x2*)P + ((size_t)(h * 2) * 32 * 256 + row);
        const u32x2* p2 = p1 + (size_t)32 * 256;
        u32x2 cv[4], cw[4], nv[4], nw[4];
#pragma unroll
        for (int q = 0; q < 4; ++q) { cv[q] = p1[(size_t)q * 256]; cw[q] = p2[(size_t)q * 256]; }
#pragma unroll
        for (int c = 0; c < 8; ++c) {
            const int cn = (c < 7) ? c + 1 : 7;
#pragma unroll
            for (int q = 0; q < 4; ++q) { nv[q] = p1[(size_t)(cn * 4 + q) * 256]; nw[q] = p2[(size_t)(cn * 4 + q) * 256]; }
            unsigned C1[16], C2[16];
#pragma unroll
            for (int q = 0; q < 4; ++q)
#pragma unroll
                for (int e = 0; e < 4; e += 2) { const unsigned idx = (unsigned)(127 - (c * 16 + q * 4 + e));
                    const unsigned k1 = h2key2(cv[q][e >> 1]), k2 = h2key2(cw[q][e >> 1]);
                    C1[q * 4 + e] = (k1 << 16) | idx; C1[q * 4 + e + 1] = (k1 & 0xffff0000u) | (idx - 1u);
                    C2[q * 4 + e] = (k2 << 16) | idx; C2[q * 4 + e + 1] = (k2 & 0xffff0000u) | (idx - 1u); }
            SORT16_DESC(C1); SORT16_DESC(C2);
            if (c == 0) {
#pragma unroll
                for (int i = 0; i < 16; ++i) { L1[i] = C1[i]; L2[i] = C2[i]; }
            } else {
#pragma unroll
                for (int i = 0; i < 16; ++i) { L1[i] = max(L1[i], C1[15 - i]); L2[i] = max(L2[i], C2[15 - i]); }
                BITONIC16_DESC(L1); BITONIC16_DESC(L2);
            }
#pragma unroll
            for (int q = 0; q < 4; ++q) { cv[q] = nv[q]; cw[q] = nw[q]; }
        }
        float v1[16], v2[16];
#pragma unroll
        for (int k = 0; k < 16; ++k) { v1[k] = key2h(L1[k]); v2[k] = key2h(L2[k]); }
        LAS unsigned* myw = (LAS unsigned*)(F.lds + tid * 32);
#pragma unroll
        for (int q = 0; q < 4; ++q) {
            myw[q] = (127u - (L1[4 * q] & 127u)) | ((127u - (L1[4 * q + 1] & 127u)) << 8) | ((127u - (L1[4 * q + 2] & 127u)) << 16) | ((127u - (L1[4 * q + 3] & 127u)) << 24);
            myw[4 + q] = (127u - (L2[4 * q] & 127u)) | ((127u - (L2[4 * q + 1] & 127u)) << 8) | ((127u - (L2[4 * q + 2] & 127u)) << 16) | ((127u - (L2[4 * q + 3] & 127u)) << 24);
        }
        const LAS unsigned char* myb = (const LAS unsigned char*)myw;
#define CKEY(a, bb) ((f2key(v1[a] + v2[bb]) & ~255u) | (unsigned)(255 - ((a) * 16 + (bb))))
        unsigned L[16];
#pragma unroll
        for (int k = 0; k < 16; ++k) L[k] = CKEY(0, k);
#pragma unroll
        for (int a = 1; a <= 4; ++a) {
#pragma unroll
            for (int bb = 0; bb < 16; ++bb) if ((a + 1) * (bb + 1) <= 16) L[15 - bb] = max(L[15 - bb], CKEY(a, bb));
            BITONIC16_DESC(L);
        }
#pragma unroll
        for (int a = 5; a < 16; ++a)
#pragma unroll
            for (int bb = 0; bb < 16; ++bb)
                if ((a + 1) * (bb + 1) <= 16) ins16(L, CKEY(a, bb));
#undef CKEY
        float w[16]; float ssum = 0.f;
        const float mtop = key2f((L[0] & ~255u) | 128u);
#pragma unroll
        for (int k = 0; k < 16; ++k) { w[k] = __expf(key2f((L[k] & ~255u) | 128u) - mtop); ssum += w[k]; }
        const float inv = 1.0f / ssum;
#pragma unroll
        for (int k = 0; k < 16; ++k) {
            const int ci = 255 - (int)(L[k] & 255u);
            const int e1 = myb[ci >> 4], e2 = myb[16 + (ci & 15)];
            const int pos = (k & 7) * 16 + h * 2 + (k >> 3);
            OUT[pos] = (unsigned)(e1 * 128 + e2) | (pk2(0.f, w[k] * inv) & 0xffff0000u);
        }
    }
    __syncthreads();
    {
        unsigned char* PE = F.ws + WS_PE + (size_t)pm * (256 * 256); unsigned char* PG = F.ws + WS_PG + (size_t)pm * (256 * 256);
#pragma unroll
        for (int i = 0; i < 8; ++i) {
            const int c = tid + 512 * i, r = c >> 4, part = c & 15;
            const LAS u32x4* q = (const LAS u32x4*)(F.lds + 16384 + r * 528 + part * 32);
            const u32x4 a = q[0], b2 = q[1];
            *(u32x4*)(PE + (size_t)c * 16) = (u32x4){(a.x & 0xffffu) | (a.y << 16), (a.z & 0xffffu) | (a.w << 16), (b2.x & 0xffffu) | (b2.y << 16), (b2.z & 0xffffu) | (b2.w << 16)};
            *(u32x4*)(PG + (size_t)c * 16) = (u32x4){(a.x >> 16) | (a.y & 0xffff0000u), (a.z >> 16) | (a.w & 0xffff0000u), (b2.x >> 16) | (b2.y & 0xffff0000u), (b2.z >> 16) | (b2.w & 0xffff0000u)};
        }
    }
}

__device__ __forceinline__ float gelu_erf(float v) { return 0.5f * v * (1.0f + erff(v * 0.70710678118654752f)); }
typedef float f32x2 __attribute__((ext_vector_type(2)));
typedef int i32x2 __attribute__((ext_vector_type(2)));
typedef int i32x8 __attribute__((ext_vector_type(8)));
__device__ __forceinline__ float dpp_x1(float v) { return __int_as_float(__builtin_amdgcn_update_dpp(0, __float_as_int(v), 0xB1, 0xf, 0xf, false)); }
__device__ __forceinline__ float dpp_x2(float v) { return __int_as_float(__builtin_amdgcn_update_dpp(0, __float_as_int(v), 0x4E, 0xf, 0xf, false)); }
__device__ __forceinline__ float dpp_hm(float v) { return __int_as_float(__builtin_amdgcn_update_dpp(0, __float_as_int(v), 0x141, 0xf, 0xf, false)); }
__device__ __forceinline__ float dpp_r8(float v) { return __int_as_float(__builtin_amdgcn_update_dpp(0, __float_as_int(v), 0x128, 0xf, 0xf, false)); }
__device__ __forceinline__ unsigned e16_of(const u32x4& ea, const u32x4& eb, int i) { const unsigned w = (i < 8) ? ea[(i & 7) >> 1] : eb[(i & 7) >> 1]; return (i & 1) ? (w >> 16) : (w & 0xffffu); }

__device__ __forceinline__ void peer_u_phase(Frame& F) {
    const int lane = F.lane, wave = F.wave, g = lane >> 3, l8 = lane & 7, n = lane & 15, kg = lane >> 4;
    const unsigned char* PE = F.ws + WS_PE; const unsigned char* H8 = F.ws + WS_H8; bf16_t* PART = (bf16_t*)(F.ws + WS_PART);
    LAS unsigned char* stg = F.lds + wave * 16384;
    LAS unsigned char* ebuf = F.lds + 131072 + wave * 2048;
    const int soff0 = (l8 ^ (g >> 1)) << 4, soff1 = soff0 ^ 64;
    const int rkey = (n >> 1) & 7, rd0 = n * 128 + ((kg ^ rkey) << 4), rd1 = n * 128 + (((4 + kg) ^ rkey) << 4);
    const int erd = g * 32, brd = 512 + (n & 1) * 256 + kg * 16;
    for (int it = blockIdx.x; it < 256; it += F.G) {
        const int x = it & 3, cb = it >> 2;
        const unsigned char* Ux = F.ws + WS_U8 + (size_t)x * (NEXP * 128);
        bf16_t* part = PART + (size_t)x * ((size_t)MT * 128);
        const int tok0 = cb * 1024 + wave * 128, tokl = tok0 + 127;
        const unsigned char* pe = PE + lane * 4; const unsigned char* ph = H8 + x * 256 + lane * 4;
#define U_DMA_E(tok, par) __builtin_amdgcn_global_load_lds((const unsigned*)(pe + (size_t)(tok) * 256), (LAS unsigned*)(ebuf + (par) * 256), 4, 0, 0)
#define U_DMA_B(tok, par) do { __builtin_amdgcn_global_load_lds((const unsigned*)(ph + (size_t)(tok) * 2048), (LAS unsigned*)(ebuf + 512 + (par) * 512), 4, 0, 0); \
                               __builtin_amdgcn_global_load_lds((const unsigned*)(ph + (size_t)(tok) * 2048 + 1024), (LAS unsigned*)(ebuf + 512 + (par) * 512 + 256), 4, 0, 0); } while (0)
#define U_TILES(ea, eb) do { _Pragma("unroll") for (int j_ = 0; j_ < 16; ++j_) \
        __builtin_amdgcn_global_load_lds((const unsigned*)(Ux + (size_t)e16_of(ea, eb, j_) * 128 + ((j_ & 1) ? soff1 : soff0)), (LAS unsigned*)(stg + j_ * 1024), 16, 0, 0); } while (0)
#define U_TOKEN(tok, par, tokn1, tokn2) do { \
            U_DMA_E(tokn2, par); U_DMA_B(tokn1, (par) ^ 1); \
              \
            asm volatile("s_waitcnt vmcnt(4)" ::: "memory"); \
            u32x4 img[16]; \
            _Pragma("unroll") for (int T = 0; T < 8; ++T) { img[2 * T] = *(const LAS u32x4*)(stg + T * 2048 + rd0); img[2 * T + 1] = *(const LAS u32x4*)(stg + T * 2048 + rd1); } \
            const u32x4 eC0 = *(const LAS u32x4*)(ebuf + ((par) ^ 1) * 256 + erd), eC1 = *(const LAS u32x4*)(ebuf + ((par) ^ 1) * 256 + erd + 16); \
            const u32x4 h0 = *(const LAS u32x4*)(ebuf + (par) * 512 + brd), h1 = *(const LAS u32x4*)(ebuf + (par) * 512 + brd + 64), h2_ = *(const LAS u32x4*)(ebuf + (par) * 512 + brd + 128), h3 = *(const LAS u32x4*)(ebuf + (par) * 512 + brd + 192); \
            asm volatile("s_waitcnt lgkmcnt(0)" ::: "memory");                    \
            U_TILES(eC0, eC1); \
            const i32x8 A0_ = {(int)h0.x, (int)h0.y, (int)h0.z, (int)h0.w, (int)h1.x, (int)h1.y, (int)h1.z, (int)h1.w}; \
            const i32x8 A1_ = {(int)h2_.x, (int)h2_.y, (int)h2_.z, (int)h2_.w, (int)h3.x, (int)h3.y, (int)h3.z, (int)h3.w}; \
            float res[8]; \
            _Pragma("unroll") for (int T = 0; T < 8; ++T) { \
                const i32x8 B0_ = {(int)img[2 * T].x, (int)img[2 * T].y, (int)img[2 * T].z, (int)img[2 * T].w, 0, 0, 0, 0}; \
                const i32x8 B1_ = {(int)img[2 * T + 1].x, (int)img[2 * T + 1].y, (int)img[2 * T + 1].z, (int)img[2 * T + 1].w, 0, 0, 0, 0}; \
                f32x4 d_ = __builtin_amdgcn_mfma_scale_f32_16x16x128_f8f6f4(A0_, B0_, (f32x4){0.f, 0.f, 0.f, 0.f}, 0, 4, 0, 0, 0, 0); \
                d_ = __builtin_amdgcn_mfma_scale_f32_16x16x128_f8f6f4(A1_, B1_, d_, 0, 4, 0, 0, 0, 0); \
                res[T] = d_[0] + d_[1] * 0.0625f; }                                  \
              \
            unsigned d2_[8]; \
            _Pragma("unroll") for (int T = 0; T < 8; ++T) { const float p_ = dpp_r8(res[T]); d2_[T] = (n < 8) ? pk2(res[T], p_) : pk2(p_, res[T]); } \
            if (lane < 16) *(u32x4*)(part + (size_t)(tok) * 128 + 16 * (n & 7) + 8 * (n >> 3)) = (n < 8) ? (u32x4){d2_[0], d2_[1], d2_[2], d2_[3]} : (u32x4){d2_[4], d2_[5], d2_[6], d2_[7]}; \
        } while (0)
        {
            U_DMA_E(tok0, 0); U_DMA_E(tok0 + 1, 1); U_DMA_B(tok0, 0);
            asm volatile("s_waitcnt vmcnt(0)" ::: "memory");
            const u32x4 eX0 = *(const LAS u32x4*)(ebuf + erd), eX1 = *(const LAS u32x4*)(ebuf + erd + 16);
            asm volatile("s_waitcnt lgkmcnt(0)" ::: "memory");
            U_TILES(eX0, eX1);
            U_DMA_E(tok0 + 1, 1);
        }
        for (int tt = 0; tt < 128; tt += 2) {
            const int t0 = tok0 + tt, t1 = t0 + 1, t2 = min(t0 + 2, tokl), t3 = min(t0 + 3, tokl);
            U_TOKEN(t0, 0, t1, t2);
            U_TOKEN(t1, 1, t2, t3);
        }
        asm volatile("s_waitcnt vmcnt(0)" ::: "memory");
#undef U_TOKEN
#undef U_TILES
#undef U_DMA_B
#undef U_DMA_E
    }
}
__device__ __forceinline__ void peer_w_phase(Frame& F) {
    const u32x2* PART = (const u32x2*)(F.ws + WS_PART); const u32x2* PG = (const u32x2*)(F.ws + WS_PG); const unsigned short* PE = (const unsigned short*)(F.ws + WS_PE); const float* vs = (const float*)(F.ws + WS_VS); const float* us = (const float*)(F.ws + WS_US);
    const size_t n4 = (size_t)MT * 128 / 4, stride = (size_t)F.G * 512;
    for (size_t p = (size_t)blockIdx.x * 512 + F.tid; p < n4; p += stride) {
        f32x4 s = {0.f, 0.f, 0.f, 0.f};
#pragma unroll
        for (int x = 0; x < 4; ++x) { const u32x2 w_ = PART[(size_t)x * n4 + p]; s += (f32x4){bf_lo(w_.x), bf_hi(w_.x), bf_lo(w_.y), bf_hi(w_.y)}; }
        const u32x2 gw_ = PG[p]; const f32x4 gt = {bf_lo(gw_.x), bf_hi(gw_.x), bf_lo(gw_.y), bf_hi(gw_.y)}; f32x4 o;
#pragma unroll
        for (int e = 0; e < 4; ++e) { const int ex = PE[4 * p + e]; o[e] = gt[e] * gelu_erf(s[e] * us[ex]) * vs[ex]; }
        float mx = fmaxf(fmaxf(fabsf(o[0]), fabsf(o[1])), fmaxf(fabsf(o[2]), fabsf(o[3])));
#pragma unroll
        for (int off = 1; off < 32; off <<= 1) mx = fmaxf(mx, __shfl_xor(mx, off));
        const float inv = mx > 0.f ? 256.f / mx : 0.f;
        o = o * inv;
        int hw = 0; hw = __builtin_amdgcn_cvt_pk_fp8_f32(o[0], o[1], hw, false); hw = __builtin_amdgcn_cvt_pk_fp8_f32(o[2], o[3], hw, true);
        const f32x4 r = {16.f * (o[0] - __builtin_amdgcn_cvt_f32_fp8(hw, 0)), 16.f * (o[1] - __builtin_amdgcn_cvt_f32_fp8(hw, 1)), 16.f * (o[2] - __builtin_amdgcn_cvt_f32_fp8(hw, 2)), 16.f * (o[3] - __builtin_amdgcn_cvt_f32_fp8(hw, 3))};
        int lw = 0; lw = __builtin_amdgcn_cvt_pk_fp8_f32(r[0], r[1], lw, false); lw = __builtin_amdgcn_cvt_pk_fp8_f32(r[2], r[3], lw, true);
        unsigned char* rec = F.ws + WS_WB + (p >> 5) * 512; const int q = (int)(p & 31);
        *(unsigned*)(rec + 4 * q) = (unsigned)hw; *(unsigned*)(rec + 128 + 4 * q) = (unsigned)lw;
        if (q == 0) *(float*)(rec + 256) = mx * (1.f / 256.f);
    }
}
__device__ __forceinline__ void peer_v_phase(Frame& F) {
    const int lane = F.lane, wave = F.wave, g = lane >> 3, l8 = lane & 7, n = lane & 15, kg = lane >> 4;
    const unsigned char* PE = F.ws + WS_PE; const unsigned char* WB = F.ws + WS_WB; bf16_t* Y = (bf16_t*)(F.ws + WS_Y);
    LAS unsigned char* stg = F.lds + wave * 16384;
    LAS unsigned char* ebuf = F.lds + 131072 + wave * 2048;
    const int soff0 = (l8 ^ (g >> 1)) << 4, soff1 = soff0 ^ 64;
    const int kq = (n >> 1) & 7, tb = (32 * kg + n) * 128;
    unsigned tba[8];
#pragma unroll
    for (int c2 = 0; c2 < 8; ++c2) tba[c2] = (unsigned)(unsigned long)(stg + tb + ((c2 ^ kq) << 4));
    const int erd = 2 * g, ard = 512 + (n & 1) * 128 + kg * 16;
    for (int it = blockIdx.x; it < 256; it += F.G) {
        const int x = it & 3, cb = it >> 2;
        const unsigned char* Vx = F.ws + WS_V8 + (size_t)x * (NEXP * 128);
        const int tok0 = cb * 1024 + wave * 128, tokl = tok0 + 127;
        const unsigned char* pe = PE + lane * 4; const unsigned char* pw = WB + lane * 4; const unsigned char* psc = WB + 256;
#define V_DMA_E(tok, par) __builtin_amdgcn_global_load_lds((const unsigned*)(pe + (size_t)(tok) * 256), (LAS unsigned*)(ebuf + (par) * 256), 4, 0, 0)
#define V_DMA_A(tok, par) do { __builtin_amdgcn_global_load_lds((const unsigned*)(pw + (size_t)(tok) * 512), (LAS unsigned*)(ebuf + 512 + (par) * 512), 4, 0, 0); \
                               __builtin_amdgcn_global_load_lds((const unsigned*)(psc + (size_t)(tok) * 512), (LAS unsigned*)(ebuf + 512 + (par) * 512 + 256), 4, 0, 0); } while (0)
#define V_IDS(par, id) do { _Pragma("unroll") for (int j_ = 0; j_ < 16; ++j_) id[j_] = *(const LAS unsigned short*)(ebuf + (par) * 256 + 16 * j_ + erd); } while (0)
#define V_TILES(id) do { _Pragma("unroll") for (int j_ = 0; j_ < 16; ++j_) \
        __builtin_amdgcn_global_load_lds((const unsigned*)(Vx + (size_t)id[j_] * 128 + ((j_ & 1) ? soff1 : soff0)), (LAS unsigned*)(stg + j_ * 1024), 16, 0, 0); } while (0)
#define V_TOKEN(tok, par, tokn1, tokn2) do { \
            V_DMA_E(tokn2, par); V_DMA_A(tokn1, (par) ^ 1); \
              \
            asm volatile("s_waitcnt vmcnt(5)" ::: "memory"); \
            i32x2 bt[32]; unsigned id[16]; \
              \
            _Pragma("unroll") for (int c = 0; c < 16; ++c) { \
                asm volatile("ds_read_b64_tr_b4 %0, %1 offset:%2" : "=v"(bt[2 * c]) : "v"(tba[c >> 1]), "n"((c & 1) * 8)); \
                asm volatile("ds_read_b64_tr_b4 %0, %1 offset:%2" : "=v"(bt[2 * c + 1]) : "v"(tba[c >> 1]), "n"((c & 1) * 8 + 2048)); } \
            V_IDS((par) ^ 1, id); \
            const u32x4 a0 = *(const LAS u32x4*)(ebuf + (par) * 512 + ard), a1 = *(const LAS u32x4*)(ebuf + (par) * 512 + ard + 64); \
            const float wsc = *(const LAS float*)(ebuf + 512 + (par) * 512 + 256); \
            asm volatile("s_waitcnt lgkmcnt(0)" : "+v"(bt[0]), "+v"(bt[1]), "+v"(bt[2]), "+v"(bt[3]), "+v"(bt[4]), "+v"(bt[5]), "+v"(bt[6]), "+v"(bt[7]), "+v"(bt[8]), "+v"(bt[9]), "+v"(bt[10]), "+v"(bt[11]) :: "memory");    \
            asm volatile("" : "+v"(bt[12]), "+v"(bt[13]), "+v"(bt[14]), "+v"(bt[15]), "+v"(bt[16]), "+v"(bt[17]), "+v"(bt[18]), "+v"(bt[19]), "+v"(bt[20]), "+v"(bt[21]), "+v"(bt[22]), "+v"(bt[23])); \
            asm volatile("" : "+v"(bt[24]), "+v"(bt[25]), "+v"(bt[26]), "+v"(bt[27]), "+v"(bt[28]), "+v"(bt[29]), "+v"(bt[30]), "+v"(bt[31])); \
            V_TILES(id); \
            const i32x8 A_ = {(int)a0.x, (int)a0.y, (int)a0.z, (int)a0.w, (int)a1.x, (int)a1.y, (int)a1.z, (int)a1.w}; \
            float res[16]; \
            _Pragma("unroll") for (int c = 0; c < 16; ++c) { \
                const i32x8 B_ = {bt[2 * c].x, bt[2 * c].y, bt[2 * c + 1].x, bt[2 * c + 1].y, 0, 0, 0, 0}; \
                const f32x4 d_ = __builtin_amdgcn_mfma_scale_f32_16x16x128_f8f6f4(A_, B_, (f32x4){0.f, 0.f, 0.f, 0.f}, 0, 4, 0, 0, 0, 0); \
                res[c] = (d_[0] + d_[1] * 0.0625f) * wsc; }                          \
            _Pragma("unroll") for (int c = 0; c < 16; ++c) asm volatile("" : "+v"(res[c]));        \
            if (lane < 16) { u32x4* yp = (u32x4*)(Y + (size_t)(tok) * 1024 + x * 256 + 16 * n); \
                yp[0] = (u32x4){pk2(res[0], res[1]), pk2(res[2], res[3]), pk2(res[4], res[5]), pk2(res[6], res[7])}; \
                yp[1] = (u32x4){pk2(res[8], res[9]), pk2(res[10], res[11]), pk2(res[12], res[13]), pk2(res[14], res[15])}; } \
        } while (0)
        {
            V_DMA_E(tok0, 0); V_DMA_E(tok0 + 1, 1); V_DMA_A(tok0, 0);
            asm volatile("s_waitcnt vmcnt(0)" ::: "memory");
            unsigned id[16]; V_IDS(0, id);
            asm volatile("s_waitcnt lgkmcnt(0)" ::: "memory");
            V_TILES(id);
            V_DMA_A(tok0, 0);
        }
        for (int tt = 0; tt < 128; tt += 2) {
            const int t0 = tok0 + tt, t1 = t0 + 1, t2 = min(t0 + 2, tokl), t3 = min(t0 + 3, tokl);
            V_TOKEN(t0, 0, t1, t2);
            V_TOKEN(t1, 1, t2, t3);
        }
        asm volatile("s_waitcnt vmcnt(0)" ::: "memory");
#undef V_TOKEN
#undef V_TILES
#undef V_IDS
#undef V_DMA_A
#undef V_DMA_E
    }
}
__device__ __forceinline__ void final_phase(Frame& F) {
    const bf16_t* Y = (const bf16_t*)(F.ws + WS_Y); const float* mod = (const float*)(F.ws + WS_MOD);
    const int gw = F.vcu * 8 + F.wave, NGW = F.G * 8;
    int tid_ = threadIdx.x; asm volatile("" : "+v"(tid_));
    const int lane = tid_ & 63;
    f32x4 fg[4];
#pragma unroll
    for (int j = 0; j < 4; ++j) fg[j] = *(const f32x4*)(F.final_g + 4 * lane + 256 * j);
    for (int tokb = gw * 32; tokb < MT; tokb += NGW * 32) {
        const int b = tokb >> 12;
        f32x4 g2[4];
#pragma unroll
        for (int j = 0; j < 4; ++j) g2[j] = *(const f32x4*)(mod + b * 6144 + 5120 + 4 * lane + 256 * j);
        for (int tok = tokb; tok < tokb + 32; ++tok) {
            float* orow = F.out + (size_t)tok * 1024 + 4 * lane;
            const bf16_t* xrow = (const bf16_t*)F.out + (size_t)tok * 2048 + 4 * lane; const bf16_t* yrow = Y + (size_t)tok * 1024 + 4 * lane;
            u32x2 w[4], yv[4];
#pragma unroll
            for (int j = 0; j < 4; ++j) { w[j] = *(const u32x2*)(xrow + 256 * j); yv[j] = *(const u32x2*)(yrow + 256 * j); }
            asm volatile("s_waitcnt vmcnt(0)" ::: "memory");
            f32x4 v[4]; float ss = 0.f;
#pragma unroll
            for (int j = 0; j < 4; ++j) { v[j] = (f32x4){bf_lo(w[j].x), bf_hi(w[j].x), bf_lo(w[j].y), bf_hi(w[j].y)} + g2[j] * (f32x4){bf_lo(yv[j].x), bf_hi(yv[j].x), bf_lo(yv[j].y), bf_hi(yv[j].y)};
                ss += v[j][0] * v[j][0] + v[j][1] * v[j][1] + v[j][2] * v[j][2] + v[j][3] * v[j][3]; }
            ss = wave_sum(ss);
            const float rstd = 1.0f / sqrtf(ss * (1.f / 1024.f) + NORM_EPS);
#pragma unroll
            for (int j = 0; j < 4; ++j) *(f32x4*)(orow + 256 * j) = v[j] * rstd * fg[j];
        }
    }
}

#ifndef MK_N_LAUNCHES
#define MK_N_LAUNCHES 1
#endif
constexpr int N_PHASES = 9;
struct Args { const float* in[16]; float* out; unsigned char* ws; int ph_lo, ph_hi; };
__global__ void __launch_bounds__(512, 2) mk_fwd(Args args) {
    extern __shared__ __attribute__((aligned(16))) unsigned char lds[];
    Frame F;
    F.lds = (LAS unsigned char*)lds;
    F.tid = threadIdx.x; F.lane = F.tid & 63; F.wave = __builtin_amdgcn_readfirstlane(F.tid >> 6);
    F.G = gridDim.x; { const int bx = blockIdx.x; F.vcu = (F.G % 8 == 0) ? (bx % 8) * (F.G / 8) + bx / 8 : bx; }
    F.x = args.in[0]; F.c = args.in[1]; F.rel_bias = args.in[2]; F.w_ada = args.in[3]; F.b_ada = args.in[4]; F.norm1_g = args.in[5]; F.w_in = args.in[6]; F.diff_lambda = args.in[7];
    F.subln_g = args.in[8]; F.w_out = args.in[9]; F.norm2_g = args.in[10]; F.peer_wq = args.in[11]; F.peer_keys = args.in[12]; F.peer_u = args.in[13]; F.peer_v = args.in[14]; F.final_g = args.in[15];
    F.out = args.out; F.ws = args.ws;
    volatile LAS unsigned* MISC = (volatile LAS unsigned*)(F.lds + MISC_OFF);
    if (F.tid < 64) MISC[F.tid] = 0u;
    __syncthreads();
    XcdBarrier bar; bar.bar = (unsigned*)(F.ws + WS_CTL) + CW_BAR; bar.x = 0; bar.st = nullptr;
    const int lo = args.ph_lo, hi = args.ph_hi;
    if (hi - lo > 1) bar = xcd_barrier_post((unsigned*)(F.ws + WS_CTL) + CW_BAR, MISC + 8);
#define IN(k) (lo <= (k) && (k) < hi)
#define SEAM(k) do { if (IN(k) && IN((k) + 1)) xcd_barrier(bar); } while (0)
    bf16_t* H = (bf16_t*)(F.ws + WS_H);
    if (IN(0)) { p0_prologue(F); } SEAM(0);
    if (IN(1)) { norm_phase<false>(F, F.x, F.norm1_g, 0, 1024, H, nullptr); } SEAM(1);
    if (IN(2)) {
        { pg8::Gemm g{H, (const bf16_t*)(F.ws + WS_WQK), MT, 2048, 1024}; pg8::StaticOrder S; S.init(MT, 2048, F.G, (int)blockIdx.x);
          pg8::EpiQK E{(bf16_t*)(F.ws + WS_QK), (float*)(F.ws + WS_KSUM), C2};
          pg8::gemm_phase<pg8::EpiQK, pg8::StaticOrder, true, true>(F.lds, g, S, E); }
        __syncthreads();
        { pg8::Gemm g{(const bf16_t*)(F.ws + WS_WV), H, 1024, MT, 1024}; pg8::StaticOrder S; S.init(1024, MT, F.G, (int)blockIdx.x);
          pg8::EpiVT E{(bf16_t*)(F.ws + WS_VT), MT};
          pg8::gemm_phase<pg8::EpiVT, pg8::StaticOrder, true, true>(F.lds, g, S, E); }
    } SEAM(2);
    if (IN(3)) { attn_phase(F); } SEAM(3);
    if (IN(4)) {
        const int pm = (int)blockIdx.x;
        float* scp = (float*)(F.ws + (pm < 192 ? WS_SCA + (size_t)pm * (2 * MiB) : WS_SCB + (size_t)(pm - 192) * (2 * MiB)));
        { pg8::Gemm g{(const bf16_t*)(F.ws + WS_AO), (const bf16_t*)(F.ws + WS_WO), MT, 1024, 1024}; pg8::PanelOrder S{pm, 4};
          pg8::EpiRes E{F.x, (bf16_t*)F.out, (const float*)(F.ws + WS_MOD)};
          pg8::gemm_phase<pg8::EpiRes, pg8::PanelOrder, true, true>(F.lds, g, S, E); }
        __syncthreads();
        norm_phase<true>(F, F.out, F.norm2_g, 3072, 4096, H, F.ws + WS_H8);
        asm volatile("s_waitcnt vmcnt(0)" ::: "memory"); __syncthreads();
        { pg8::Gemm g{H, (const bf16_t*)(F.ws + WS_WC), MT, 2048, 1024}; pg8::PanelOrder S{pm, 8};
          pg8::EpiSC E{scp};
          pg8::gemm_phase<pg8::EpiSC, pg8::PanelOrder, true, true>(F.lds, g, S, E); }
        __syncthreads();
        topk_panel(F, scp, pm);
    } SEAM(4);
    if (IN(5)) { peer_u_phase(F); } SEAM(5);
    if (IN(6)) { peer_w_phase(F); } SEAM(6);
    if (IN(7)) { peer_v_phase(F); } SEAM(7);
    if (IN(8)) { final_phase(F); }
#undef IN
#undef SEAM
}

extern "C" void kernel_launch(void* const* d_in, const int* in_sizes, int n_in, void* d_out, int out_size, void* d_ws, size_t ws_size, hipStream_t stream) {
    static int grid = 0;
    if (grid == 0) {
        if (n_in != 16 || in_sizes[0] != MT * DM || out_size != MT * DM || ws_size < WS_END) { fprintf(stderr, "kernel_launch: unexpected shapes (n_in %d, in0 %d, out %d, ws %zu); nothing launched\n", n_in, n_in > 0 ? in_sizes[0] : -1, out_size, ws_size); grid = -1; return; }
        int dev = 0, cus = 0, per_cu = 0;
        if (hipGetDevice(&dev) != hipSuccess || hipDeviceGetAttribute(&cus, hipDeviceAttributeMultiprocessorCount, dev) != hipSuccess) { grid = -1; return; }
        if (hipFuncSetAttribute((const void*)mk_fwd, hipFuncAttributeMaxDynamicSharedMemorySize, LDS_BYTES) != hipSuccess) { fprintf(stderr, "kernel_launch: hipFuncSetAttribute failed\n"); grid = -1; return; }
        if (hipOccupancyMaxActiveBlocksPerMultiprocessor(&per_cu, (const void*)mk_fwd, 512, LDS_BYTES) != hipSuccess || per_cu < 1) fprintf(stderr, "kernel_launch: note: occupancy query reports %d\n", per_cu);
        (void)hipGetLastError();
        grid = cus;
        if (grid != 256) { fprintf(stderr, "kernel_launch: built for a 256-CU device (one 256-row panel per workgroup in the fused phase); found %d CUs; nothing launched\n", cus); grid = -1; return; }
    }
    if (grid < 0) return;
    if (hipMemsetAsync((char*)d_ws + WS_CTL, 0, CTL_ZERO_BYTES, stream) != hipSuccess) return;
    Args a{};
    for (int i = 0; i < 16; ++i) a.in[i] = (const float*)d_in[i];
    a.out = (float*)d_out; a.ws = (unsigned char*)d_ws;
#if MK_N_LAUNCHES == 1
    a.ph_lo = 0; a.ph_hi = N_PHASES;
    hipLaunchKernelGGL(mk_fwd, dim3(grid), dim3(512), LDS_BYTES, stream, a);
#else
    for (int p = 0; p < N_PHASES; ++p) { a.ph_lo = p; a.ph_hi = p + 1; hipLaunchKernelGGL(mk_fwd, dim3(grid), dim3(512), LDS_BYTES, stream, a); }
#endif
}
```

```cpp
#include <hip/hip_runtime.h>
#include <type_traits>
#include <cstdio>
#include <cstdint>
#include <cmath>

#define LAS __attribute__((address_space(3)))
#define GAS __attribute__((address_space(1)))

constexpr int NB = 16, SEQ = 4096, DM = 1024, MT = NB * SEQ;
constexpr float NORM_EPS = 1e-6f, LOG2E = 1.4426950408889634f, C2 = 0.125f * LOG2E, NEGBIG = -1e30f;
constexpr int QKW = 2048;
constexpr int NEXP = 16384;

namespace pg8 {
#define PG8_LAS __attribute__((address_space(3)))
typedef unsigned short bf16_t;
typedef short bf16x8 __attribute__((ext_vector_type(8)));
typedef float f32x4 __attribute__((ext_vector_type(4)));
typedef unsigned u32x4 __attribute__((ext_vector_type(4)));
constexpr int BM = 256, BK = 64, HALF = 128, HTB = HALF * BK * 2  , STAGE_BYTES = 8 * HTB, NXCD = 8, WGM = 8;

__host__ __device__ __forceinline__ int lds_byte(int r, int c) { const int st = (r >> 4) * 2 + (c >> 5), rr = r & 15, cc = c & 31, ob = rr * 64 + cc * 2; return st * 1024 + (ob ^ (((ob >> 9) & 1) << 5)); }
__host__ __device__ __forceinline__ void stage_rc(int b, int& R, int& C) { const int st = b / 1024, sb = b % 1024, swz = sb ^ (((sb >> 9) & 1) << 5); R = (st >> 1) * 16 + swz / 64; C = (st & 1) * 32 + (swz % 64) / 2; }
__host__ __device__ __forceinline__ int perm32(int rho) { const int n = rho >> 4, i = rho & 15; return 8 * (i >> 2) + 4 * n + (i & 3); }

struct Unit { int pm, pn; };
struct Gemm { const bf16_t* A; const bf16_t* Bt; int M, N, K; };

struct StaticOrder {
    int nM, nN, nwg, G, c;
    __host__ __device__ void init(int M, int N, int G_, int c_) { nM = M / BM; nN = N / BM; nwg = nM * nN; G = G_; c = c_; }
    __host__ __device__ bool next(int i, Unit& u) const {
        const long L = (long)i * G + c; if (L >= nwg) return false;
        int wgid = (int)L; { const int q = nwg / NXCD, r = nwg % NXCD, xcd = wgid % NXCD, off = wgid / NXCD; wgid = (xcd < r ? xcd * (q + 1) : r * (q + 1) + (xcd - r) * q) + off; }
        const int nig = WGM * nN, gid = wgid / nig, fm = gid * WGM, gsz = (nM - fm) < WGM ? (nM - fm) : WGM;
        u.pm = fm + ((wgid % nig) % gsz); u.pn = (wgid % nig) / gsz; return true;
    }
    __device__ __forceinline__ void a_ready(const Unit&) const {}
    __device__ __forceinline__ void done(const Unit&) const {}
};

struct PanelOrder {
    int pm, n;
    __host__ __device__ bool next(int i, Unit& u) const { if (i >= n) return false; u.pm = pm; u.pn = i; return true; }
    __device__ __forceinline__ void a_ready(const Unit&) const {}
    __device__ __forceinline__ void done(const Unit&) const {}
};

typedef float f32x2 __attribute__((ext_vector_type(2)));
typedef unsigned u32x2 __attribute__((ext_vector_type(2)));
typedef __bf16 bf16x2_t __attribute__((ext_vector_type(2)));
__device__ __forceinline__ unsigned cvt_pk_bf16(float lo, float hi) { f32x2 v = {lo, hi}; bf16x2_t b = __builtin_convertvector(v, bf16x2_t); return __builtin_bit_cast(unsigned, b); }

struct EpiBf16 {
    static constexpr bool PERM = true, AFTER_DRAIN = false;
    bf16_t* O; int ldc;
    __device__ __forceinline__ void operator()(const f32x4 (&acc)[2][2][4][2], const Unit& u, int wr, int wc, int fr, int fq) const {
        const int row0 = u.pm * BM + wr * 64 + fr; const int col0 = u.pn * BM + wc * 32 + 8 * fq;
#pragma unroll
        for (int ai = 0; ai < 2; ++ai)
#pragma unroll
            for (int m = 0; m < 4; ++m) { bf16_t* rowp = O + (size_t)(row0 + ai * HALF + m * 16) * ldc + col0;
#pragma unroll
                for (int bj = 0; bj < 2; ++bj) { const f32x4 v0 = acc[ai][bj][m][0], v1 = acc[ai][bj][m][1];
                    u32x4 w; w.x = cvt_pk_bf16(v0[0], v0[1]); w.y = cvt_pk_bf16(v0[2], v0[3]); w.z = cvt_pk_bf16(v1[0], v1[1]); w.w = cvt_pk_bf16(v1[2], v1[3]);
                    *(u32x4*)(rowp + bj * HALF) = w; } }
    }
};
struct EpiVT {
    static constexpr bool PERM = true, AFTER_DRAIN = false;
    bf16_t* O; int ldc;
    __device__ __forceinline__ void operator()(const f32x4 (&acc)[2][2][4][2], const Unit& u, int wr, int wc, int fr, int fq) const {
        const int row0 = u.pm * BM + wr * 64 + fr; const int col0 = u.pn * BM + wc * 32 + 16 * (fq >> 1) + 4 * (fq & 1);
#pragma unroll
        for (int ai = 0; ai < 2; ++ai)
#pragma unroll
            for (int m = 0; m < 4; ++m) { bf16_t* rowp = O + (size_t)(row0 + ai * HALF + m * 16) * ldc + col0;
#pragma unroll
                for (int bj = 0; bj < 2; ++bj) { const f32x4 v0 = acc[ai][bj][m][0], v1 = acc[ai][bj][m][1];
                    u32x2 w0, w1; w0.x = cvt_pk_bf16(v0[0], v0[1]); w0.y = cvt_pk_bf16(v0[2], v0[3]); w1.x = cvt_pk_bf16(v1[0], v1[1]); w1.y = cvt_pk_bf16(v1[2], v1[3]);
                    *(u32x2*)(rowp + bj * HALF) = w0; *(u32x2*)(rowp + bj * HALF + 8) = w1; } }
    }
};
struct EpiQK {
    static constexpr bool PERM = true, AFTER_DRAIN = false;
    bf16_t* O; float* ksum; float qscale;
    __device__ __forceinline__ void operator()(const f32x4 (&acc)[2][2][4][2], const Unit& u, int wr, int wc, int fr, int fq) const {
        const int row0 = u.pm * BM + wr * 64 + fr; const int col0 = u.pn * BM + wc * 32 + 8 * fq;
        const float sc = (u.pn < 2 || (u.pn >= 4 && u.pn < 6)) ? qscale : 1.f;
#pragma unroll
        for (int ai = 0; ai < 2; ++ai)
#pragma unroll
            for (int m = 0; m < 4; ++m) { bf16_t* rowp = O + (size_t)(row0 + ai * HALF + m * 16) * 2048 + col0;
#pragma unroll
                for (int bj = 0; bj < 2; ++bj) { const f32x4 v0 = acc[ai][bj][m][0] * sc, v1 = acc[ai][bj][m][1] * sc;
                    u32x4 w; w.x = cvt_pk_bf16(v0[0], v0[1]); w.y = cvt_pk_bf16(v0[2], v0[3]); w.z = cvt_pk_bf16(v1[0], v1[1]); w.w = cvt_pk_bf16(v1[2], v1[3]);
                    *(u32x4*)(rowp + bj * HALF) = w; } }
        if (u.pn >= 6) {
            float* kdst = ksum + (size_t)u.pm * 512 + (u.pn - 6) * BM + wc * 32 + 8 * fq;
#pragma unroll
            for (int bj = 0; bj < 2; ++bj)
#pragma unroll
                for (int n = 0; n < 2; ++n)
#pragma unroll
                    for (int e = 0; e < 4; ++e) {
                        float s = 0.f;
#pragma unroll
                        for (int ai = 0; ai < 2; ++ai)
#pragma unroll
                            for (int m = 0; m < 4; ++m) s += acc[ai][bj][m][n][e];
                        s += __shfl_xor(s, 1); s += __shfl_xor(s, 2); s += __shfl_xor(s, 4); s += __shfl_xor(s, 8);
                        if (fr == 0) atomicAdd(kdst + bj * HALF + 4 * n + e, s);
                    }
        }
    }
};
struct EpiRes {
    static constexpr bool PERM = false, AFTER_DRAIN = false;
    const float* x; bf16_t* out; const float* mod;
    __device__ __forceinline__ void operator()(const f32x4 (&acc)[2][2][4][2], const Unit& u, int wr, int wc, int fr, int fq) const {
        const int row0 = u.pm * BM + wr * 64 + fr; const int col0 = u.pn * BM + wc * 32 + 4 * fq;
        const float* g1 = mod + (size_t)(u.pm >> 4) * 6144 + 2048 + col0;
        f32x4 gv[2][2];
#pragma unroll
        for (int bj = 0; bj < 2; ++bj)
#pragma unroll
            for (int n = 0; n < 2; ++n) gv[bj][n] = *(const f32x4*)(g1 + bj * HALF + n * 16);
#pragma unroll
        for (int ai = 0; ai < 2; ++ai)
#pragma unroll
            for (int m = 0; m < 4; ++m) { const size_t off = (size_t)(row0 + ai * HALF + m * 16) * 1024 + col0;
#pragma unroll
                for (int bj = 0; bj < 2; ++bj)
#pragma unroll
                    for (int n = 0; n < 2; ++n) { const f32x4 xv = *(const f32x4*)(x + off + bj * HALF + n * 16);
                        const f32x4 y = xv + gv[bj][n] * acc[ai][bj][m][n]; u32x2 w; w.x = cvt_pk_bf16(y[0], y[1]); w.y = cvt_pk_bf16(y[2], y[3]);
                        *(u32x2*)(out + off + (size_t)(row0 + ai * HALF + m * 16) * 1024 + bj * HALF + n * 16) = w; } }
    }
};
typedef unsigned u32x2v __attribute__((ext_vector_type(2)));
struct EpiSC {
    static constexpr bool PERM = false, AFTER_DRAIN = false;
    float* P;
    __device__ __forceinline__ void operator()(const f32x4 (&acc)[2][2][4][2], const Unit& u, int wr, int wc, int fr, int fq) const {
        const int row0 = wr * 64 + fr; const int cg0 = u.pn * 64 + wc * 8 + fq;
#pragma unroll
        for (int ai = 0; ai < 2; ++ai)
#pragma unroll
            for (int m = 0; m < 4; ++m) { const int r = row0 + ai * HALF + m * 16;
#pragma unroll
                for (int bj = 0; bj < 2; ++bj)
#pragma unroll
                    for (int n = 0; n < 2; ++n) { const f32x4 a = acc[ai][bj][m][n];
                        *(u32x2v*)((char*)P + ((size_t)(cg0 + bj * 32 + n * 4) * 256 + r) * 8) = (u32x2v){__builtin_bit_cast(unsigned, __builtin_amdgcn_cvt_pkrtz(a[0], a[1])), __builtin_bit_cast(unsigned, __builtin_amdgcn_cvt_pkrtz(a[2], a[3]))}; } }
    }
};
struct EpiF32 {
    static constexpr bool PERM = false, AFTER_DRAIN = false;
    float* O; int ldc;
    __device__ __forceinline__ void operator()(const f32x4 (&acc)[2][2][4][2], const Unit& u, int wr, int wc, int fr, int fq) const {
        const int row0 = u.pm * BM + wr * 64 + fr; const int col0 = u.pn * BM + wc * 32 + 4 * fq;
#pragma unroll
        for (int ai = 0; ai < 2; ++ai)
#pragma unroll
            for (int m = 0; m < 4; ++m) { const size_t off = (size_t)(row0 + ai * HALF + m * 16) * ldc + col0;
#pragma unroll
                for (int bj = 0; bj < 2; ++bj)
#pragma unroll
                    for (int n = 0; n < 2; ++n) *(f32x4*)(O + off + bj * HALF + n * 16) = acc[ai][bj][m][n]; }
    }
};

template <class Epi, class Sched, bool ALIGN_EPI = false, bool SP2 = false>
__device__ __forceinline__ void gemm_phase(PG8_LAS unsigned char* lds, const Gemm g, const Sched& S, const Epi& E) {
    const int tid = threadIdx.x, wid = __builtin_amdgcn_readfirstlane(tid >> 6), lane = tid & 63, wr = wid >> 2, wc = wid & 3, fr = lane & 15, fq = lane >> 4;
    const int K = g.K, nt = K / BK;
    unsigned voffA[2], voffB[2];
#pragma unroll
    for (int i = 0; i < 2; ++i) { int R, C; stage_rc(tid * 16 + i * 8192, R, C); const int Rb = Epi::PERM ? ((R & ~31) + perm32(R & 31)) : R;
        voffA[i] = (unsigned)(R * K + C) * 2u; voffB[i] = (unsigned)(Rb * K + C) * 2u; }
    const size_t kstep = (size_t)(BK * 2);
    const size_t hstep = (size_t)HALF * K * 2;
    const size_t tstep = 2 * hstep;
    const unsigned ldsw = (unsigned)wid * 1024u;
    const int aoff = lds_byte(wr * 64 + fr, fq * 8), boff = lds_byte(wc * 32 + fr, fq * 8);
#define PG8_SA(b, h) (((b) * 2 + (h)) * HTB)
#define PG8_SB(b, h) ((4 + (b) * 2 + (h)) * HTB)
#define PG8_STAGE(bufoff, gbase, voff) do { _Pragma("unroll") for (int _i = 0; _i < 2; ++_i) \
        __builtin_amdgcn_global_load_lds((const unsigned*)((const char*)(gbase) + (voff)[_i]), (PG8_LAS unsigned*)(lds + (bufoff) + ldsw + _i * 8192), 16, 0, 0); } while (0)
#define PG8_LDA(dst, b, h) do { _Pragma("unroll") for (int m = 0; m < 4; ++m) _Pragma("unroll") for (int k = 0; k < 2; ++k) dst[m][k] = *(const PG8_LAS bf16x8*)(lds + PG8_SA(b, h) + aoff + m * 2048 + k * 1024); } while (0)
#define PG8_LDB(dst, b, h) do { _Pragma("unroll") for (int n = 0; n < 2; ++n) _Pragma("unroll") for (int k = 0; k < 2; ++k) dst[n][k] = *(const PG8_LAS bf16x8*)(lds + PG8_SB(b, h) + boff + n * 2048 + k * 1024); } while (0)
#define PG8_MMA(ai, bj, At, Bt) do { __builtin_amdgcn_s_setprio(1); _Pragma("unroll") for (int m = 0; m < 4; ++m) _Pragma("unroll") for (int n = 0; n < 2; ++n) _Pragma("unroll") for (int k = 0; k < 2; ++k) \
        acc[ai][bj][m][n] = __builtin_amdgcn_mfma_f32_16x16x32_bf16(Bt[n][k], At[m][k], acc[ai][bj][m][n], 0, 0, 0); __builtin_amdgcn_s_setprio(0); } while (0)
#define PG8_WAIT_V(n) asm volatile("s_waitcnt vmcnt(" #n ")" ::: "memory")
#define PG8_WAIT_L(n) asm volatile("s_waitcnt lgkmcnt(" #n ")" ::: "memory")
#define PG8_BAR __builtin_amdgcn_s_barrier()
#define PG8_SCHED __builtin_amdgcn_sched_barrier(0)
    Unit cur, nxt; int ui = 0;
    if (!S.next(0, cur)) return;
    f32x4 acc[2][2][4][2];
#pragma unroll
    for (int a = 0; a < 2; ++a)
#pragma unroll
        for (int b = 0; b < 2; ++b)
#pragma unroll
            for (int m = 0; m < 4; ++m)
#pragma unroll
                for (int n = 0; n < 2; ++n) acc[a][b][m][n] = (f32x4){0.f, 0.f, 0.f, 0.f};
    bf16x8 At[4][2], B0[2][2], B1[2][2];
    const char* cA = (const char*)g.A + (size_t)cur.pm * tstep; const char* cB = (const char*)g.Bt + (size_t)cur.pn * tstep;
    S.a_ready(cur);
    if constexpr (SP2) {
        PG8_STAGE(PG8_SB(0, 0), cB, voffB); PG8_STAGE(PG8_SB(0, 1), cB + hstep, voffB); PG8_STAGE(PG8_SA(0, 0), cA, voffA); PG8_STAGE(PG8_SA(0, 1), cA + hstep, voffA);
        if (wr == 1) PG8_BAR;
        PG8_WAIT_V(2); PG8_BAR;
        PG8_STAGE(PG8_SB(1, 0), cB + kstep, voffB); PG8_STAGE(PG8_SA(1, 0), cA + kstep, voffA); PG8_STAGE(PG8_SB(1, 1), cB + hstep + kstep, voffB);
        PG8_WAIT_V(6); PG8_BAR;
    } else {
        PG8_STAGE(PG8_SB(0, 0), cB, voffB); PG8_STAGE(PG8_SA(0, 0), cA, voffA); PG8_STAGE(PG8_SB(0, 1), cB + hstep, voffB); PG8_STAGE(PG8_SA(0, 1), cA + hstep, voffA);
        if (wr == 1) PG8_BAR;
        PG8_WAIT_V(4); PG8_BAR;
        PG8_STAGE(PG8_SB(1, 0), cB + kstep, voffB); PG8_STAGE(PG8_SA(1, 0), cA + kstep, voffA); PG8_STAGE(PG8_SB(1, 1), cB + hstep + kstep, voffB);
        PG8_WAIT_V(6); PG8_BAR;
    }
    for (;;) {
        const bool has_next = S.next(ui + 1, nxt);
        const char* nA = has_next ? (const char*)g.A + (size_t)nxt.pm * tstep : cA; const char* nB = has_next ? (const char*)g.Bt + (size_t)nxt.pn * tstep : cB;
        for (int t = 0; t < nt; t += 2) {
            const bool last = (t == nt - 2);
            const char* a1 = cA + (size_t)(t + 1) * kstep;
            const char* a2 = last ? nA : cA + (size_t)(t + 2) * kstep; const char* b2 = last ? nB : cB + (size_t)(t + 2) * kstep;
            const char* a3 = a2 + kstep; const char* b3 = b2 + kstep;
            if (last && has_next) S.a_ready(nxt);
            if constexpr (SP2) {
            PG8_LDB(B0, 0, 0); PG8_LDB(B1, 0, 1); PG8_SCHED; PG8_LDA(At, 0, 0); PG8_STAGE(PG8_SA(1, 1), a1 + hstep, voffA);
            PG8_WAIT_V(8); PG8_WAIT_L(0); PG8_BAR; PG8_MMA(0, 0, At, B0); PG8_MMA(0, 1, At, B1); PG8_BAR; PG8_SCHED;
            PG8_LDA(At, 0, 1); PG8_STAGE(PG8_SB(0, 0), b2, voffB); PG8_STAGE(PG8_SB(0, 1), b2 + hstep, voffB); PG8_STAGE(PG8_SA(0, 0), a2, voffA);
            PG8_WAIT_V(8); PG8_WAIT_L(0); PG8_BAR; PG8_MMA(1, 0, At, B0); PG8_MMA(1, 1, At, B1); PG8_BAR; PG8_SCHED;
            PG8_LDB(B0, 1, 0); PG8_LDB(B1, 1, 1); PG8_SCHED; PG8_LDA(At, 1, 0); PG8_STAGE(PG8_SA(0, 1), a2 + hstep, voffA);
            PG8_WAIT_V(8); PG8_WAIT_L(0); PG8_BAR; PG8_MMA(0, 0, At, B0); PG8_MMA(0, 1, At, B1); PG8_BAR; PG8_SCHED;
            PG8_LDA(At, 1, 1); PG8_STAGE(PG8_SB(1, 0), b3, voffB); PG8_STAGE(PG8_SB(1, 1), b3 + hstep, voffB); PG8_STAGE(PG8_SA(1, 0), a3, voffA);
            PG8_WAIT_V(8); PG8_WAIT_L(0); PG8_BAR; PG8_MMA(1, 0, At, B0); PG8_MMA(1, 1, At, B1); PG8_BAR; PG8_SCHED;
            } else {
            PG8_LDB(B0, 0, 0); PG8_SCHED; PG8_LDA(At, 0, 0); PG8_STAGE(PG8_SA(1, 1), a1 + hstep, voffA);
            PG8_WAIT_L(8); PG8_BAR; PG8_WAIT_L(0); PG8_MMA(0, 0, At, B0); PG8_BAR; PG8_SCHED;
            PG8_LDB(B1, 0, 1); PG8_STAGE(PG8_SB(0, 0), b2, voffB);
            PG8_BAR; PG8_WAIT_L(0); PG8_MMA(0, 1, At, B1); PG8_BAR;
            PG8_LDA(At, 0, 1); PG8_STAGE(PG8_SA(0, 0), a2, voffA);
            PG8_BAR; PG8_WAIT_L(0); PG8_MMA(1, 0, At, B0); PG8_BAR; PG8_SCHED;
            PG8_STAGE(PG8_SB(0, 1), b2 + hstep, voffB);
            PG8_WAIT_V(6); PG8_BAR; PG8_MMA(1, 1, At, B1); PG8_BAR;
            PG8_LDB(B0, 1, 0); PG8_SCHED; PG8_LDA(At, 1, 0); PG8_STAGE(PG8_SA(0, 1), a2 + hstep, voffA);
            PG8_WAIT_L(8); PG8_BAR; PG8_WAIT_L(0); PG8_MMA(0, 0, At, B0); PG8_BAR; PG8_SCHED;
            PG8_LDB(B1, 1, 1); PG8_STAGE(PG8_SB(1, 0), b3, voffB);
            PG8_BAR; PG8_WAIT_L(0); PG8_MMA(0, 1, At, B1); PG8_BAR;
            PG8_LDA(At, 1, 1); PG8_STAGE(PG8_SA(1, 0), a3, voffA);
            PG8_BAR; PG8_WAIT_L(0); PG8_MMA(1, 0, At, B0); PG8_BAR; PG8_SCHED;
            PG8_STAGE(PG8_SB(1, 1), b3 + hstep, voffB);
            PG8_WAIT_V(6); PG8_BAR; PG8_MMA(1, 1, At, B1); PG8_BAR;
            }
        }
        if constexpr (ALIGN_EPI) { if (wr == 0) PG8_BAR; }
        if constexpr (!Epi::AFTER_DRAIN) { E(acc, cur, wr, wc, fr, fq); S.done(cur); }
        if (!has_next) break;
#pragma unroll
        for (int a = 0; a < 2; ++a)
#pragma unroll
            for (int b = 0; b < 2; ++b)
#pragma unroll
                for (int m = 0; m < 4; ++m)
#pragma unroll
                    for (int n = 0; n < 2; ++n) acc[a][b][m][n] = (f32x4){0.f, 0.f, 0.f, 0.f};
        cur = nxt; cA = nA; cB = nB; ++ui;
        if constexpr (ALIGN_EPI) { if (wr == 1) PG8_BAR; }
    }
    PG8_WAIT_V(0);
    if constexpr (!ALIGN_EPI) { if (wr == 0) PG8_BAR; }
    PG8_BAR;
    if constexpr (Epi::AFTER_DRAIN) { E.fused(acc, cur, wr, wc, fr, fq, lds, wid, lane); S.done(cur); }
#undef PG8_SA
#undef PG8_SB
#undef PG8_STAGE
#undef PG8_LDA
#undef PG8_LDB
#undef PG8_MMA
#undef PG8_WAIT_V
#undef PG8_WAIT_L
#undef PG8_BAR
#undef PG8_SCHED
}
}

typedef unsigned short bf16_t;
typedef short bf16x8 __attribute__((ext_vector_type(8)));
typedef float f32x4 __attribute__((ext_vector_type(4)));
typedef float f32x16 __attribute__((ext_vector_type(16)));
typedef unsigned u32x4 __attribute__((ext_vector_type(4)));
typedef unsigned u32x2 __attribute__((ext_vector_type(2)));
typedef __bf16 bf16x2v __attribute__((ext_vector_type(2)));
#define LDS_WAIT() asm volatile("s_waitcnt lgkmcnt(0)" ::: "memory")
__device__ __forceinline__ unsigned pk2(float lo, float hi) { return pg8::cvt_pk_bf16(lo, hi); }
__device__ __forceinline__ float bf_lo(unsigned w) { return __uint_as_float(w << 16); }
__device__ __forceinline__ float bf_hi(unsigned w) { return __uint_as_float(w & 0xffff0000u); }
__device__ __forceinline__ float wave_sum(float v) {
#pragma unroll
    for (int o = 1; o < 64; o <<= 1) v += __shfl_xor(v, o);
    return v;
}
__device__ __forceinline__ float swap32_f(float v) {
    auto rr = __builtin_amdgcn_permlane32_swap(__float_as_uint(v), __float_as_uint(v), false, false);
    return (threadIdx.x & 32) ? __uint_as_float(rr[0]) : __uint_as_float(rr[1]);
}
__device__ __forceinline__ float dot2bf(unsigned a, unsigned b, float acc) { return __builtin_amdgcn_fdot2_f32_bf16(__builtin_bit_cast(bf16x2v, a), __builtin_bit_cast(bf16x2v, b), acc, false); }

constexpr size_t MiB = 1u << 20;
constexpr size_t WS_CTL = 0, CTL_ZERO_BYTES = 1 * MiB;
constexpr size_t WS_KSUM = 512 * 1024;
constexpr size_t WS_MOD = 1 * MiB;
constexpr size_t WS_WQK = 2 * MiB;
constexpr size_t WS_WV = 6 * MiB;
constexpr size_t WS_WO = 8 * MiB;
constexpr size_t WS_WC = 10 * MiB;
constexpr size_t WS_U8 = 16 * MiB, WS_V8 = 32 * MiB;
constexpr size_t WS_US = 51 * MiB;
constexpr size_t WS_WB = 52 * MiB;
constexpr size_t WS_VS = 50 * MiB;
constexpr size_t WS_H = 128 * MiB;
constexpr size_t WS_QK = 256 * MiB;
constexpr size_t WS_VT = 512 * MiB;
constexpr size_t WS_AO = 640 * MiB, WS_H8 = 640 * MiB, WS_Y = 640 * MiB;
constexpr size_t WS_SCA = 256 * MiB, WS_SCB = 832 * MiB;
constexpr size_t WS_PART = 256 * MiB;
constexpr size_t WS_PE = 960 * MiB, WS_PG = 976 * MiB;
constexpr size_t WS_END = 1008 * MiB;
constexpr int CW_BAR = 4096;

constexpr int LDS_BYTES = 163840, MISC_OFF = LDS_BYTES - 256;

#define XB_TMO      128
#define XB_XCNT(j)  (256  + 64 * (j))
#define XB_XSUB(j)  (1280 + 64 * (j))
#define XB_XGEN(j)  (2304 + 64 * (j))
#define XB_TOP      3328
#define XB_TOPGEN   3392
#define XCD_BAR_WORDS 3456
#define XB_SPIN_CAP (1u << 18)
__device__ __forceinline__ unsigned xb_ld(unsigned* p)              { return __hip_atomic_load(p, __ATOMIC_RELAXED, __HIP_MEMORY_SCOPE_AGENT); }
__device__ __forceinline__ unsigned xb_add(unsigned* p, unsigned v) { return __hip_atomic_fetch_add(p, v, __ATOMIC_RELAXED, __HIP_MEMORY_SCOPE_AGENT); }
__device__ __forceinline__ unsigned xb_xcc_id() { return (unsigned)__builtin_amdgcn_s_getreg((3 << 11) | 20) & 0xFu; }
#define XB_SPIN(cond, bar) do { unsigned _sp = 0; while (cond) { __builtin_amdgcn_s_sleep(1); \
    if ((++_sp & 255u) == 0u) { if (xb_ld(&(bar)[XB_TMO])) break; if (_sp > XB_SPIN_CAP) { atomicAdd(&(bar)[XB_TMO], 1u); break; } } } } while (0)
struct XcdBarrier { unsigned* bar; unsigned x; volatile LAS unsigned* st; };
__device__ __forceinline__ XcdBarrier xcd_barrier_post(unsigned* bar, volatile LAS unsigned* st) {
    XcdBarrier b; b.bar = bar; b.x = xb_xcc_id(); b.st = st;
    if (threadIdx.x == 0) (void)xb_add(&bar[XB_XCNT(b.x)], 1u);
    return b;
}
__device__ __forceinline__ void xcd_barrier_complete(unsigned* bar, unsigned x, unsigned& nloc, unsigned& nx) {
    const unsigned G = gridDim.x * gridDim.y * gridDim.z;
    unsigned sum, cnt, mine, sp = 0u;
    for (;;) {
        sum = 0u; cnt = 0u; mine = 0u;
#pragma unroll
        for (unsigned j = 0; j < 16; ++j) { const unsigned c = xb_ld(&bar[XB_XCNT(j)]); sum += c; cnt += (c > 0u) ? 1u : 0u; mine = (j == x) ? c : mine; }
        if (sum == G) break;
        __builtin_amdgcn_s_sleep(1);
        if ((++sp & 255u) == 0u) { if (xb_ld(&bar[XB_TMO])) break; if (sp > XB_SPIN_CAP) { atomicAdd(&bar[XB_TMO], 1u); break; } }
    }
    nloc = mine > 0u ? mine : 1u; nx = cnt > 0u ? cnt : 1u;
}
__device__ __forceinline__ void xcd_barrier(const XcdBarrier& b) {
    asm volatile("s_waitcnt vmcnt(0)" ::: "memory");
    __syncthreads();
    if (threadIdx.x == 0) {
        unsigned* bar = b.bar;
        __builtin_amdgcn_s_waitcnt(0);
        unsigned nloc = b.st[0], nx = b.st[1];
        if (nloc == 0u) { xcd_barrier_complete(bar, b.x, nloc, nx); b.st[0] = nloc; b.st[1] = nx; }
        const unsigned old = xb_add(&bar[XB_XSUB(b.x)], 1u);
        const unsigned gen = old / nloc;
        if (old + 1u == (gen + 1u) * nloc) {
            __builtin_amdgcn_fence(__ATOMIC_RELEASE, "agent");
            asm volatile("s_waitcnt vmcnt(0)" ::: "memory");
            const unsigned og = xb_add(&bar[XB_TOP], 1u);
            const unsigned tg = og / nx;
            if (og + 1u == (tg + 1u) * nx) xb_add(&bar[XB_TOPGEN], 1u);
            else XB_SPIN(xb_ld(&bar[XB_TOPGEN]) == tg, bar);
            __builtin_amdgcn_fence(__ATOMIC_ACQUIRE, "agent");
            xb_add(&bar[XB_XGEN(b.x)], 1u);
            asm volatile("s_waitcnt vmcnt(0)" ::: "memory");
        } else {
            XB_SPIN(xb_ld(&bar[XB_XGEN(b.x)]) == gen, bar);
            __builtin_amdgcn_fence(__ATOMIC_ACQUIRE, "agent");
            asm volatile("s_waitcnt vmcnt(0)" ::: "memory");
        }
    }
    __syncthreads();
}

struct Frame {
    LAS unsigned char* lds;
    int tid, lane, wave, vcu, G;
    const float *x, *c, *rel_bias, *w_ada, *b_ada, *norm1_g, *w_in, *diff_lambda, *subln_g, *w_out, *norm2_g, *peer_wq, *peer_keys, *peer_u, *peer_v, *final_g;
    float* out; unsigned char* ws;
};

__device__ __forceinline__ void p0_transpose_item(const float* W, int K, int N, bf16_t* WT, int row_off, LAS float* scr, int item, int lane) {
    const int nblk = N / 32, kb = item / nblk, nb = item % nblk, k0 = 64 * kb, n0 = 32 * nb;
#pragma unroll 8
    for (int i = 0; i < 32; ++i) { const int kk = 2 * i + (lane >> 5); scr[kk * 33 + (lane & 31)] = W[(size_t)(k0 + kk) * N + n0 + (lane & 31)]; }
    LDS_WAIT(); asm volatile("" ::: "memory");
    const int c = lane & 7;
#pragma unroll
    for (int j = 0; j < 4; ++j) { const int n = (lane >> 3) + 8 * j; const LAS float* s = scr + (8 * c) * 33 + n;
        u32x4 o; o.x = pk2(s[0 * 33], s[1 * 33]); o.y = pk2(s[2 * 33], s[3 * 33]); o.z = pk2(s[4 * 33], s[5 * 33]); o.w = pk2(s[6 * 33], s[7 * 33]);
        *(u32x4*)(WT + (size_t)(row_off + n0 + n) * K + k0 + 8 * c) = o; }
    LDS_WAIT(); asm volatile("" ::: "memory");
}
__device__ __forceinline__ void p0_prologue(Frame& F) {
    const int tid = F.tid, lane = F.lane, wave = F.wave;
    float* mod = (float*)(F.ws + WS_MOD);
    for (int it = blockIdx.x; it < 96; it += F.G) {
        LAS float* sc = (LAS float*)F.lds;
        LAS float* red = (LAS float*)(F.lds + 65536);
        for (int idx = tid; idx < 16384; idx += 512) { const int b = idx >> 10, k = idx & 1023; const float v = F.c[idx]; sc[k * 16 + b] = v / (1.f + __expf(-v)); }
        __syncthreads();
        const int n0 = it * 64;
        float acc[16];
#pragma unroll
        for (int b = 0; b < 16; ++b) acc[b] = 0.f;
        const float* wp = F.w_ada + (size_t)(wave * 128) * 6144 + n0 + lane;
#pragma unroll 4
        for (int k = 0; k < 128; ++k) {
            const float wv = wp[(size_t)k * 6144];
            const LAS f32x4* s4 = (const LAS f32x4*)(sc + (wave * 128 + k) * 16);
#pragma unroll
            for (int q = 0; q < 4; ++q) { const f32x4 s = s4[q]; acc[4 * q + 0] += s[0] * wv; acc[4 * q + 1] += s[1] * wv; acc[4 * q + 2] += s[2] * wv; acc[4 * q + 3] += s[3] * wv; }
        }
#pragma unroll
        for (int b = 0; b < 16; ++b) red[(wave * 16 + b) * 64 + lane] = acc[b];
        __syncthreads();
        for (int o = tid; o < 1024; o += 512) { const int b = o >> 6, ln = o & 63; float s = F.b_ada[n0 + ln];
#pragma unroll
            for (int w = 0; w < 8; ++w) s += red[(w * 16 + b) * 64 + ln];
            mod[b * 6144 + n0 + ln] = s; }
        __syncthreads();
    }
    for (int it = blockIdx.x; it < 256; it += F.G) {
        const int g = it >> 4, k0 = (it & 15) * 64;
        LAS float* KK = (LAS float*)F.lds;
        LAS float* AA = (LAS float*)(F.lds + 67584);
#pragma unroll
        for (int i = 0; i < 8; ++i) { const int idx = tid * 4 + 2048 * i, n = idx >> 7, d = idx & 127; *(LAS f32x4*)(KK + n * 132 + d) = *(const f32x4*)(F.peer_keys + (size_t)g * 16384 + idx); }
#pragma unroll
        for (int i = 0; i < 4; ++i) { const int idx = tid * 4 + 2048 * i, r = idx >> 7, d = idx & 127; *(LAS f32x4*)(AA + r * 132 + d) = *(const f32x4*)(F.peer_wq + (size_t)(k0 + r) * 2048 + g * 128 + d); }
        __syncthreads();
        const int kk = tid & 63, nq = wave;
        float acc[16];
#pragma unroll
        for (int j = 0; j < 16; ++j) acc[j] = 0.f;
        for (int d4 = 0; d4 < 32; ++d4) {
            const f32x4 a = *(const LAS f32x4*)(AA + kk * 132 + 4 * d4);
#pragma unroll
            for (int j = 0; j < 16; ++j) { const f32x4 kv = *(const LAS f32x4*)(KK + (nq * 16 + j) * 132 + 4 * d4); acc[j] += a[0] * kv[0] + a[1] * kv[1] + a[2] * kv[2] + a[3] * kv[3]; }
        }
        bf16_t* wc = (bf16_t*)(F.ws + WS_WC);
#pragma unroll
        for (int j = 0; j < 16; ++j) wc[(size_t)(g * 128 + nq * 16 + j) * 1024 + k0 + kk] = (bf16_t)(pk2(acc[j], 0.f) & 0xffffu);
        __syncthreads();
    }
    {
        LAS float* scr = (LAS float*)(F.lds + wave * 8448);
        const int gw = F.vcu * 8 + wave, NGW = F.G * 8;
        bf16_t* wqk = (bf16_t*)(F.ws + WS_WQK); bf16_t* wv = (bf16_t*)(F.ws + WS_WV); bf16_t* wo = (bf16_t*)(F.ws + WS_WO);
        constexpr int I_IN = 16 * 96, I_O = 16 * 32;
        for (int it = gw; it < I_IN + I_O; it += NGW) {
            if (it < I_IN) {
                const int nb = it % 96, n0 = nb * 32;
                if (n0 < 1024) p0_transpose_item(F.w_in, 1024, 3072, wqk, 0, scr, it, lane);
                else if (n0 < 1536) p0_transpose_item(F.w_in, 1024, 3072, wv, -1024, scr, it, lane);
                else if (n0 < 2560) p0_transpose_item(F.w_in, 1024, 3072, wqk, -512, scr, it, lane);
                else p0_transpose_item(F.w_in, 1024, 3072, wv, -2048, scr, it, lane);
            } else p0_transpose_item(F.w_out, 1024, 1024, wo, 0, scr, it - I_IN, lane);
        }
    }
    {
        const int gw = F.vcu * 8 + wave, NGW = F.G * 8;
        float* us = (float*)(F.ws + WS_US);
        for (int e = gw; e < NEXP; e += NGW) {
            const f32x4* src = (const f32x4*)(F.peer_u + (size_t)e * 1024 + lane * 16);
            f32x4 a[4]; float mx = 0.f;
#pragma unroll
            for (int q = 0; q < 4; ++q) { a[q] = src[q]; mx = fmaxf(mx, fmaxf(fmaxf(fabsf(a[q][0]), fabsf(a[q][1])), fmaxf(fabsf(a[q][2]), fabsf(a[q][3])))); }
#pragma unroll
            for (int o = 1; o < 64; o <<= 1) mx = fmaxf(mx, __shfl_xor(mx, o));
            const float sc = mx > 0.f ? mx * (0.9f / 6.f) : 1.f, inv = 1.f / sc;
            if (lane == 0) us[e] = sc;
            unsigned w[2] = {0u, 0u};
#pragma unroll
            for (int q = 0; q < 4; ++q)
#pragma unroll
                for (int k = 0; k < 4; ++k) {
                    const float v = a[q][k], t = fabsf(v) * inv;
                    unsigned code = (t > 0.25f) + (t > 0.75f) + (t > 1.25f) + (t > 1.75f) + (t > 2.5f) + (t > 3.5f) + (t > 5.0f);
                    code |= (v < 0.f) ? 8u : 0u;
                    const int el = q * 4 + k;
                    w[el >> 3] |= code << (4 * (el & 7));
                }
            *(u32x2*)(F.ws + WS_U8 + (size_t)(lane >> 4) * (NEXP * 128) + (size_t)e * 128 + (lane & 15) * 8) = (u32x2){w[0], w[1]};
        }
    }
    {
        const int gw = F.vcu * 8 + wave, NGW = F.G * 8;
        float* vs = (float*)(F.ws + WS_VS);
        for (int e = gw; e < NEXP; e += NGW) {
            const f32x4* src = (const f32x4*)(F.peer_v + (size_t)e * 1024 + lane * 16);
            f32x4 a[4]; float mx = 0.f;
#pragma unroll
            for (int q = 0; q < 4; ++q) { a[q] = src[q]; mx = fmaxf(mx, fmaxf(fmaxf(fabsf(a[q][0]), fabsf(a[q][1])), fmaxf(fabsf(a[q][2]), fabsf(a[q][3])))); }
#pragma unroll
            for (int o = 1; o < 64; o <<= 1) mx = fmaxf(mx, __shfl_xor(mx, o));
            const float sc = mx > 0.f ? mx * (0.9f / 6.f) : 1.f, inv = 1.f / sc;
            if (lane == 0) vs[e] = sc;
            unsigned w[2] = {0u, 0u};
#pragma unroll
            for (int q = 0; q < 4; ++q)
#pragma unroll
                for (int k = 0; k < 4; ++k) {
                    const float v = a[q][k], t = fabsf(v) * inv;
                    unsigned code = (t > 0.25f) + (t > 0.75f) + (t > 1.25f) + (t > 1.75f) + (t > 2.5f) + (t > 3.5f) + (t > 5.0f);
                    code |= (v < 0.f) ? 8u : 0u;
                    const int el = q * 4 + k;
                    w[el >> 3] |= code << (4 * (el & 7));
                }
            unsigned o2[2] = {0u, 0u}; const int nn = lane & 15, gb = lane & 48;
#pragma unroll
            for (int j = 0; j < 16; ++j) { const unsigned w0 = __shfl(w[0], gb + j), w1 = __shfl(w[1], gb + j); const unsigned nib = (((nn < 8) ? w0 : w1) >> (4 * (nn & 7))) & 15u; o2[j >> 3] |= nib << (4 * (j & 7)); }
            *(u32x2*)(F.ws + WS_V8 + (size_t)(lane >> 4) * (NEXP * 128) + (size_t)e * 128 + (lane & 15) * 8) = (u32x2){o2[0], o2[1]};
        }
    }
}

template <bool WITH8> __device__ __forceinline__ void norm_phase(Frame& F, const float* xin, const float* g, int sh_off, int sc_off, bf16_t* H, unsigned char* H8) {
    const float* mod = (const float*)(F.ws + WS_MOD);
    for (int tile = blockIdx.x; tile < MT / 256; tile += F.G) {
        const int b = tile >> 4, r0 = tile * 256 + F.wave * 32;
        f32x4 A[4], Bv[4];
#pragma unroll
        for (int j = 0; j < 4; ++j) { const int cix = 4 * F.lane + 256 * j;
            const f32x4 gg = *(const f32x4*)(g + cix), sc = *(const f32x4*)(mod + b * 6144 + sc_off + cix);
            A[j] = gg * (sc + 1.0f); Bv[j] = *(const f32x4*)(mod + b * 6144 + sh_off + cix); }
#pragma unroll 2
        for (int rr = 0; rr < 32; ++rr) {
            const float* xr = xin + (size_t)(r0 + rr) * 1024 + 4 * F.lane;
            f32x4 v[4]; float s = 0.f;
#pragma unroll
            for (int j = 0; j < 4; ++j) {
                if constexpr (WITH8) { const u32x2 w = *(const u32x2*)((const bf16_t*)xin + (size_t)(r0 + rr) * 2048 + 4 * F.lane + 256 * j); v[j] = (f32x4){bf_lo(w.x), bf_hi(w.x), bf_lo(w.y), bf_hi(w.y)}; }
                else v[j] = *(const f32x4*)(xr + 256 * j);
                s += (v[j][0] * v[j][0] + v[j][1] * v[j][1]) + (v[j][2] * v[j][2] + v[j][3] * v[j][3]); }
            const float rstd = 1.0f / sqrtf(wave_sum(s) * (1.f / 1024.f) + NORM_EPS);
            bf16_t* hr = H + (size_t)(r0 + rr) * 1024 + 4 * F.lane;
#pragma unroll
            for (int j = 0; j < 4; ++j) { const f32x4 y = v[j] * rstd * A[j] + Bv[j]; u32x2 o; o.x = pk2(y[0], y[1]); o.y = pk2(y[2], y[3]); *(u32x2*)(hr + 256 * j) = o;
                if constexpr (WITH8) {
                    int wh = 0; wh = __builtin_amdgcn_cvt_pk_fp8_f32(y[0], y[1], wh, false); wh = __builtin_amdgcn_cvt_pk_fp8_f32(y[2], y[3], wh, true);
                    const auto h01 = __builtin_amdgcn_cvt_pk_f32_fp8(wh, false), h23 = __builtin_amdgcn_cvt_pk_f32_fp8(wh, true);
                    int wl = 0; wl = __builtin_amdgcn_cvt_pk_fp8_f32((y[0] - h01[0]) * 16.f, (y[1] - h01[1]) * 16.f, wl, false); wl = __builtin_amdgcn_cvt_pk_fp8_f32((y[2] - h23[0]) * 16.f, (y[3] - h23[1]) * 16.f, wl, true);
                    unsigned char* h8 = H8 + (size_t)(r0 + rr) * 2048 + 4 * F.lane + 256 * j;
                    *(int*)h8 = wh; *(int*)(h8 + 1024) = wl; } }
        }
    }
}

namespace att {
constexpr int LDS_TAB = 98304;
constexpr int LDS_KM = LDS_TAB + 8192;
constexpr int LDS_SG = LDS_KM + 4096;
constexpr int LDS_LAM = LDS_SG + 512;
constexpr float THR = 8.0f;
__device__ __forceinline__ int crow(int r, int hi) { return (r & 3) + 8 * (r >> 2) + 4 * hi; }
__device__ __forceinline__ float pair_max(float v) { auto rr = __builtin_amdgcn_permlane32_swap(__float_as_uint(v), __float_as_uint(v), false, false); return fmaxf(__uint_as_float(rr[0]), __uint_as_float(rr[1])); }
__device__ __forceinline__ float pair_sum(float v) { auto rr = __builtin_amdgcn_permlane32_swap(__float_as_uint(v), __float_as_uint(v), false, false); return __uint_as_float(rr[0]) + __uint_as_float(rr[1]); }
__device__ __forceinline__ float max3f(float a, float b, float c) { return fmaxf(fmaxf(a, b), c); }

template <bool DIFF>
__device__ __forceinline__ bool unit(LAS unsigned char* lds, const bf16_t* __restrict__ QK, const bf16_t* __restrict__ VT, bf16_t* AO, const float* __restrict__ ksum, int b, int hh, int qt, float& mshift) {
    constexpr int DV = DIFF ? 128 : 64, ND0 = DV / 32;
    constexpr int STG = DIFF ? 32768 : 16384, VOFF = DIFF ? 16384 : 8192;
    const int tid = threadIdx.x, lane = tid & 63, r32 = lane & 31, hi = lane >> 5;
    const int wid = __builtin_amdgcn_readfirstlane(tid >> 6);
    const int map = DIFF ? (wid >> 2) : 0;
    const int qw0 = DIFF ? (qt * 128 + 32 * (wid & 3)) : (qt * 256 + 32 * wid);
    const int qpos = qw0 + r32;
    const size_t tok0 = (size_t)b * SEQ;
    const int srow = wid * 8 + (lane >> 3), sch = (lane & 7) ^ ((srow >> 1) & 7);
    const bf16_t* kg0 = QK + (tok0 + srow) * QKW + (DIFF ? (512 + hh * 128) : (1536 + hh * 64)) + sch * 8;
    const bf16_t* vg0 = VT + (size_t)((DIFF ? hh * 128 : 512 + hh * 64) + srow) * MT + tok0 + sch * 8;
    const int kx = (r32 >> 1) & 7;
    const int kr_base = r32 * 128 + (DIFF ? map * 8192 : 0);
    const int vr_base = VOFF + r32 * 128;
    bf16x8 qf[4];
    {
        const bf16_t* qp = QK + (tok0 + qpos) * QKW + (DIFF ? (hh * 128 + map * 64) : (1024 + hh * 64)) + hi * 8;
#pragma unroll
        for (int s = 0; s < 4; ++s) qf[s] = *(const bf16x8*)(qp + 16 * s);
    }
    const LAS float* tab = (const LAS float*)(lds + LDS_TAB) + (DIFF ? (map * 4 + hh) : (8 + hh)) * 128;
    unsigned selmask = 0u;
    if constexpr (!DIFF) {
        LAS float* km = (LAS float*)(lds + LDS_KM);
        for (int i = tid; i < 1024; i += 512) { const int n = i >> 6, dd = i & 63; km[i] = ksum[(size_t)(b * 16 + n) * 512 + hh * 64 + dd] * (1.f / 256.f); }
        __syncthreads();
        float qv[32];
#pragma unroll
        for (int s = 0; s < 4; ++s)
#pragma unroll
            for (int j = 0; j < 8; ++j) qv[s * 8 + j] = __uint_as_float(((unsigned)(unsigned short)qf[s][j]) << 16);
        float v0 = -INFINITY, v1 = -INFINITY, v2 = -INFINITY; int i0 = -1, i1 = -1, i2 = -1;
        for (int n = 0; n < qt; ++n) {
            float part = 0.f;
#pragma unroll
            for (int s = 0; s < 4; ++s) {
                const f32x4 ka = *(const LAS f32x4*)(km + n * 64 + 16 * s + 8 * hi), kb = *(const LAS f32x4*)(km + n * 64 + 16 * s + 8 * hi + 4);
                part += qv[s * 8 + 0] * ka[0] + qv[s * 8 + 1] * ka[1] + qv[s * 8 + 2] * ka[2] + qv[s * 8 + 3] * ka[3] + qv[s * 8 + 4] * kb[0] + qv[s * 8 + 5] * kb[1] + qv[s * 8 + 6] * kb[2] + qv[s * 8 + 7] * kb[3];
            }
            const float gte = pair_sum(part);
            if (gte > v0) { v2 = v1; i2 = i1; v1 = v0; i1 = i0; v0 = gte; i0 = n; }
            else if (gte > v1) { v2 = v1; i2 = i1; v1 = gte; i1 = n; }
            else if (gte > v2) { v2 = gte; i2 = n; }
        }
        if (i0 >= 0) selmask |= 1u << i0;
        if (i1 >= 0) selmask |= 1u << i1;
        if (i2 >= 0) selmask |= 1u << i2;
    }
    const int NTILE = DIFF ? 2 * (qt + 1) : 4 * (qt + 1);
    auto tile_k0 = [&](int i) -> int { if constexpr (DIFF) return 64 * i; else return (i < 4) ? (qt * 256 + 64 * i) : (((i - 4) >> 2) * 256 + 64 * ((i - 4) & 3)); };
    auto stage_from = [&](const bf16_t* kp, const bf16_t* vp, int buf) {
        LAS unsigned char* sb = lds + buf * STG + wid * 1024;
        __builtin_amdgcn_global_load_lds((const unsigned*)kp, (LAS unsigned*)sb, 16, 0, 0);
        if constexpr (DIFF) {
            __builtin_amdgcn_global_load_lds((const unsigned*)(kp + 64), (LAS unsigned*)(sb + 8192), 16, 0, 0);
            __builtin_amdgcn_global_load_lds((const unsigned*)vp, (LAS unsigned*)(sb + VOFF), 16, 0, 0);
            __builtin_amdgcn_global_load_lds((const unsigned*)(vp + (size_t)64 * MT), (LAS unsigned*)(sb + VOFF + 8192), 16, 0, 0);
        } else {
            __builtin_amdgcn_global_load_lds((const unsigned*)vp, (LAS unsigned*)(sb + VOFF), 16, 0, 0);
        }
    };
    auto stage = [&](int k0, int buf) { stage_from(kg0 + (size_t)k0 * QKW, vg0 + k0, buf); };
    float m_ref = 0.f, l_run = 0.f, smax = 0.f;
    float cblk = 0.f;
    f32x16 o[ND0];
#pragma unroll
    for (int d0 = 0; d0 < ND0; ++d0) o[d0] = f32x16{};
    constexpr int NMF = 4 * ND0, EPM = 32 / NMF;
    u32x4 pkA[4], pkB[4];
    constexpr int VB = 2;
    bf16x8 vfr[VB][ND0];
    auto qk_tile = [&](int t, int bufi, int bufprev, f32x16& p0, f32x16& p1, auto firstc) {
        constexpr bool FIRST = decltype(firstc)::value;
        const int k0 = tile_k0(t);
        const LAS unsigned char* sb = lds + bufi * STG;
        if constexpr (!DIFF) {
            if (t >= 4 && ((t & 3) == 0)) { const bool msk = ((selmask >> ((t - 4) >> 2)) & 1u) == 0u; cblk = msk ? NEGBIG : -m_ref; }
        }
        bf16x8 kfa[4], kfb[4];
#pragma unroll
        for (int s = 0; s < 4; ++s) { const int co = ((2 * s + hi) ^ kx) << 4; kfa[s] = *(const LAS bf16x8*)(sb + kr_base + co); kfb[s] = *(const LAS bf16x8*)(sb + kr_base + 4096 + co); }
        if constexpr (!FIRST) {
            const LAS unsigned char* sp = lds + bufprev * STG;
#pragma unroll
            for (int ks = 0; ks < VB; ++ks) { const int vo = ((2 * ks + hi) ^ kx) << 4;
#pragma unroll
                for (int d0 = 0; d0 < ND0; ++d0) vfr[ks][d0] = *(const LAS bf16x8*)(sp + vr_base + d0 * 4096 + vo); }
        }
        __builtin_amdgcn_sched_barrier(0);
        if constexpr (FIRST) { p0 = __builtin_amdgcn_mfma_f32_32x32x16_bf16(kfa[0], qf[0], f32x16{}, 0, 0, 0); p1 = __builtin_amdgcn_mfma_f32_32x32x16_bf16(kfb[0], qf[0], f32x16{}, 0, 0, 0); }
        else {
            const float c0 = (!DIFF && t >= 4) ? cblk : -m_ref;
#pragma unroll
            for (int r = 0; r < 16; ++r) { p0[r] = c0; p1[r] = c0; }
            p0 = __builtin_amdgcn_mfma_f32_32x32x16_bf16(kfa[0], qf[0], p0, 0, 0, 0); p1 = __builtin_amdgcn_mfma_f32_32x32x16_bf16(kfb[0], qf[0], p1, 0, 0, 0); }
#pragma unroll
        for (int s = 1; s < 4; ++s) {
            p0 = __builtin_amdgcn_mfma_f32_32x32x16_bf16(kfa[s], qf[s], p0, 0, 0, 0);
            p1 = __builtin_amdgcn_mfma_f32_32x32x16_bf16(kfb[s], qf[s], p1, 0, 0, 0);
        }
        __builtin_amdgcn_sched_barrier(0);
        if (qw0 - (k0 + 63) < 128) {
            int dbase = qpos - k0 - 4 * hi; asm volatile("" : "+v"(dbase));
#pragma unroll
            for (int rq = 0; rq < 4; ++rq) {
#pragma unroll
                for (int r = 4 * rq; r < 4 * rq + 4; ++r) {
                    const int d0_ = dbase - crow(r, 0), d1_ = d0_ - 32;
                    const float b0 = tab[min(max(d0_, 0), 127)], b1 = tab[min(max(d1_, 0), 127)];
                    p0[r] = d0_ < 0 ? NEGBIG : p0[r] + b0; p1[r] = d1_ < 0 ? NEGBIG : p1[r] + b1;
                }
                __builtin_amdgcn_sched_barrier(0);
            }
        }
    };
    auto softmax_only = [&](f32x16& p0, f32x16& p1, u32x4 (&pkn)[4]) {
        float sum = 0.f;
#pragma unroll
        for (int r = 0; r < 16; ++r) { p0[r] = __builtin_amdgcn_exp2f(p0[r]); p1[r] = __builtin_amdgcn_exp2f(p1[r]); sum += p0[r] + p1[r]; }
        l_run += sum; smax = fmaxf(smax, sum);
        pkn[0] = (u32x4){pk2(p0[0], p0[1]), pk2(p0[2], p0[3]), pk2(p0[4], p0[5]), pk2(p0[6], p0[7])};
        pkn[1] = (u32x4){pk2(p0[8], p0[9]), pk2(p0[10], p0[11]), pk2(p0[12], p0[13]), pk2(p0[14], p0[15])};
        pkn[2] = (u32x4){pk2(p1[0], p1[1]), pk2(p1[2], p1[3]), pk2(p1[4], p1[5]), pk2(p1[6], p1[7])};
        pkn[3] = (u32x4){pk2(p1[8], p1[9]), pk2(p1[10], p1[11]), pk2(p1[12], p1[13]), pk2(p1[14], p1[15])};
    };
    auto pv_exp = [&](int bufprev, const u32x4 (&pkp)[4], f32x16& p0, f32x16& p1, u32x4 (&pkn)[4], auto withexp) {
        constexpr bool WE = decltype(withexp)::value;
        const LAS unsigned char* sp = lds + bufprev * STG;
        float sum = 0.f;
#pragma unroll
        for (int i = 0; i < NMF; ++i) {
            const int ks = i / ND0, d0 = i % ND0;
            const bf16x8 pf = __builtin_bit_cast(bf16x8, pkp[ks]);
            o[d0] = __builtin_amdgcn_mfma_f32_32x32x16_bf16(vfr[ks % VB][d0], pf, o[d0], 0, 0, 0);
            if (d0 == ND0 - 1 && ks + VB < 4) { const int vo = ((2 * (ks + VB) + hi) ^ kx) << 4;
#pragma unroll
                for (int dd = 0; dd < ND0; ++dd) vfr[ks % VB][dd] = *(const LAS bf16x8*)(sp + vr_base + dd * 4096 + vo); }
            if constexpr (WE) {
#pragma unroll
                for (int e2 = 0; e2 < EPM; e2 += 2) {
                    const int j = i * EPM + e2;
                    float a = (j < 16) ? p0[j] : p1[j - 16], b2 = (j < 16) ? p0[j + 1] : p1[j - 15];
                    a = __builtin_amdgcn_exp2f(a); b2 = __builtin_amdgcn_exp2f(b2);
                    sum += a; sum += b2;
                    unsigned wv = pk2(a, b2);
                    asm volatile("" : "+v"(wv), "+v"(sum));
                    pkn[j >> 3][(j >> 1) & 3] = wv;
                }
            }
            __builtin_amdgcn_sched_barrier(0);
        }
        l_run += sum; if constexpr (WE) smax = fmaxf(smax, sum);
    };
    if constexpr (DIFF) {
    stage(tile_k0(0), 0);
    __syncthreads();
    {
        f32x16 p0, p1;
        stage(tile_k0(1), 1);
        qk_tile(0, 0, 0, p0, p1, std::true_type{});
        float mx = max3f(p0[0], p0[1], p1[0]);
#pragma unroll
        for (int r = 2; r < 16; r += 2) mx = max3f(mx, p0[r], p0[r + 1]);
#pragma unroll
        for (int r = 1; r < 15; r += 2) mx = max3f(mx, p1[r], p1[r + 1]);
        mx = fmaxf(mx, p1[15]);
        m_ref = pair_max(mx) + mshift;
#pragma unroll
        for (int r = 0; r < 16; ++r) { p0[r] -= m_ref; p1[r] -= m_ref; }
        softmax_only(p0, p1, pkA);
        __syncthreads();
    }
    int bp = 0, bc = 1, bn = 2;
    for (int t = 1; t < NTILE; t += 2) {
        {   f32x16 p0, p1;
            if (t + 1 < NTILE) stage(tile_k0(t + 1), bn);
            qk_tile(t, bc, bp, p0, p1, std::false_type{});
            pv_exp(bp, pkA, p0, p1, pkB, std::true_type{});
            __syncthreads();
            const int tmp = bp; bp = bc; bc = bn; bn = tmp; }
        if (t + 1 < NTILE) {
            f32x16 p0, p1;
            if (t + 2 < NTILE) stage(tile_k0(t + 2), bn);
            qk_tile(t + 1, bc, bp, p0, p1, std::false_type{});
            pv_exp(bp, pkB, p0, p1, pkA, std::true_type{});
            __syncthreads();
            const int tmp = bp; bp = bc; bc = bn; bn = tmp; }
    }
    {
        const LAS unsigned char* sp = lds + bp * STG;
#pragma unroll
        for (int ks = 0; ks < VB; ++ks) { const int vo = ((2 * ks + hi) ^ kx) << 4;
#pragma unroll
            for (int d0 = 0; d0 < ND0; ++d0) vfr[ks][d0] = *(const LAS bf16x8*)(sp + vr_base + d0 * 4096 + vo); }
        f32x16 dz0, dz1;
        pv_exp(bp, pkB, dz0, dz1, pkA, std::false_type{});
        __syncthreads();
    }
    } else
    {
        f32x16 pA0, pA1, pB0, pB1;
        bf16x8 kfa[4], kfb[4];
        auto kread = [&](int tt) { const LAS unsigned char* sk = lds + (tt & 3) * STG;
#pragma unroll
            for (int s_ = 0; s_ < 4; ++s_) { const int co = ((2 * s_ + hi) ^ kx) << 4; kfa[s_] = *(const LAS bf16x8*)(sk + kr_base + co); kfb[s_] = *(const LAS bf16x8*)(sk + kr_base + 4096 + co); } };
        auto vread = [&](int tt) { const LAS unsigned char* sp = lds + (tt & 3) * STG;
#pragma unroll
            for (int ks = 0; ks < VB; ++ks) { const int vo = ((2 * ks + hi) ^ kx) << 4;
#pragma unroll
                for (int d0 = 0; d0 < ND0; ++d0) vfr[ks][d0] = *(const LAS bf16x8*)(sp + vr_base + d0 * 4096 + vo); } };
        auto cinit = [&](int tt, f32x16& q0, f32x16& q1) {
            if (tt >= 4 && ((tt & 3) == 0)) { const bool msk = ((selmask >> ((tt - 4) >> 2)) & 1u) == 0u; cblk = msk ? NEGBIG : -m_ref; }
            const float c0 = (tt >= 4) ? cblk : -m_ref;
#pragma unroll
            for (int r = 0; r < 16; ++r) { q0[r] = c0; q1[r] = c0; } };
        auto nearbias = [&](int tt, f32x16& q0, f32x16& q1) {
            const int k0 = tile_k0(tt);
            if (qw0 - (k0 + 63) < 128) {
                int dbase = qpos - k0 - 4 * hi; asm volatile("" : "+v"(dbase));
#pragma unroll
                for (int rq = 0; rq < 4; ++rq) {
#pragma unroll
                    for (int r = 4 * rq; r < 4 * rq + 4; ++r) {
                        const int d0_ = dbase - crow(r, 0), d1_ = d0_ - 32;
                        const float b0 = tab[min(max(d0_, 0), 127)], b1 = tab[min(max(d1_, 0), 127)];
                        q0[r] = d0_ < 0 ? NEGBIG : q0[r] + b0; q1[r] = d1_ < 0 ? NEGBIG : q1[r] + b1;
                    }
                    __builtin_amdgcn_sched_barrier(0);
                }
            } };
        auto seg = [&](int t, f32x16& c0v, f32x16& c1v, f32x16& n0, f32x16& n1, const u32x4 (&pkp)[4], u32x4 (&pkc)[4], auto hasqk, auto haspv) {
            constexpr bool HASQK = decltype(hasqk)::value, HASPV = decltype(haspv)::value;
            const LAS unsigned char* sp = lds + ((t - 1) & 3) * STG;
            float sum = 0.f;
#pragma unroll
            for (int i = 0; i < 8; ++i) {
                if constexpr (HASQK) { const int s_ = i >> 1;
                    if (i & 1) n1 = __builtin_amdgcn_mfma_f32_32x32x16_bf16(kfb[s_], qf[s_], n1, 0, 0, 0);
                    else       n0 = __builtin_amdgcn_mfma_f32_32x32x16_bf16(kfa[s_], qf[s_], n0, 0, 0, 0); }
                if constexpr (HASPV) { const int ks = i >> 1, d0 = i & 1;
                    o[d0] = __builtin_amdgcn_mfma_f32_32x32x16_bf16(vfr[ks % VB][d0], __builtin_bit_cast(bf16x8, pkp[ks]), o[d0], 0, 0, 0);
                    if (d0 == 1 && ks + VB < 4) { const int vo = ((2 * (ks + VB) + hi) ^ kx) << 4;
#pragma unroll
                        for (int dd = 0; dd < ND0; ++dd) vfr[ks % VB][dd] = *(const LAS bf16x8*)(sp + vr_base + dd * 4096 + vo); } }
#pragma unroll
                for (int e2 = 0; e2 < 4; e2 += 2) {
                    const int j = 4 * i + e2;
                    float a_ = (j < 16) ? c0v[j] : c1v[j - 16], b_ = (j < 16) ? c0v[j + 1] : c1v[j - 15];
                    a_ = __builtin_amdgcn_exp2f(a_); b_ = __builtin_amdgcn_exp2f(b_);
                    sum += a_; sum += b_;
                    unsigned wv = pk2(a_, b_);
                    asm volatile("" : "+v"(wv), "+v"(sum));
                    pkc[j >> 3][(j >> 1) & 3] = wv;
                }
                __builtin_amdgcn_sched_barrier(0);
            }
            l_run += sum; smax = fmaxf(smax, sum);
        };
        stage(tile_k0(0), 0);
        __syncthreads();
        stage(tile_k0(1), 1);
        {
            kread(0);
            __builtin_amdgcn_sched_barrier(0);
            pA0 = __builtin_amdgcn_mfma_f32_32x32x16_bf16(kfa[0], qf[0], f32x16{}, 0, 0, 0); pA1 = __builtin_amdgcn_mfma_f32_32x32x16_bf16(kfb[0], qf[0], f32x16{}, 0, 0, 0);
#pragma unroll
            for (int s_ = 1; s_ < 4; ++s_) { pA0 = __builtin_amdgcn_mfma_f32_32x32x16_bf16(kfa[s_], qf[s_], pA0, 0, 0, 0); pA1 = __builtin_amdgcn_mfma_f32_32x32x16_bf16(kfb[s_], qf[s_], pA1, 0, 0, 0); }
            __builtin_amdgcn_sched_barrier(0);
            nearbias(0, pA0, pA1);
            float mx = max3f(pA0[0], pA0[1], pA1[0]);
#pragma unroll
            for (int r = 2; r < 16; r += 2) mx = max3f(mx, pA0[r], pA0[r + 1]);
#pragma unroll
            for (int r = 1; r < 15; r += 2) mx = max3f(mx, pA1[r], pA1[r + 1]);
            mx = fmaxf(mx, pA1[15]);
            m_ref = pair_max(mx) + mshift;
#pragma unroll
            for (int r = 0; r < 16; ++r) { pA0[r] -= m_ref; pA1[r] -= m_ref; }
        }
        __syncthreads();
        {
            stage(tile_k0(2), 2);
            kread(1); cinit(1, pB0, pB1);
            __builtin_amdgcn_sched_barrier(0);
            seg(0, pA0, pA1, pB0, pB1, pkB, pkA, std::true_type{}, std::false_type{});
            nearbias(1, pB0, pB1);
            __syncthreads();
        }
        for (int t = 1; t + 2 < NTILE; t += 2) {
            {
                if (t + 2 < NTILE) stage(tile_k0(t + 2), (t + 2) & 3);
                kread(t + 1); vread(t - 1); cinit(t + 1, pA0, pA1);
                __builtin_amdgcn_sched_barrier(0);
                seg(t, pB0, pB1, pA0, pA1, pkA, pkB, std::true_type{}, std::true_type{});
                nearbias(t + 1, pA0, pA1);
                __syncthreads(); }
            {
                if (t + 3 < NTILE) stage(tile_k0(t + 3), (t + 3) & 3);
                kread(t + 2); vread(t); cinit(t + 2, pB0, pB1);
                __builtin_amdgcn_sched_barrier(0);
                seg(t + 1, pA0, pA1, pB0, pB1, pkB, pkA, std::true_type{}, std::true_type{});
                nearbias(t + 2, pB0, pB1);
                __syncthreads(); }
        }
        {
            vread(NTILE - 2);
            __builtin_amdgcn_sched_barrier(0);
            seg(NTILE - 1, pB0, pB1, pA0, pA1, pkA, pkB, std::false_type{}, std::true_type{});
            __syncthreads();
        }
        {
            vread(NTILE - 1);
            f32x16 dz0, dz1;
            pv_exp((NTILE - 1) & 3, pkB, dz0, dz1, pkA, std::false_type{});
            __syncthreads();
        }
    }
    {
        const bool badl = !(smax <= 0x1p60f);
        const int badp = __shfl_xor((int)badl, 32);
        const bool badrow = badl || (badp != 0);
        if (badrow) mshift += 64.f;
        LAS unsigned* flag = (LAS unsigned*)(lds + MISC_OFF + 64);
        if (tid == 0) *flag = 0u;
        __syncthreads();
        if (badrow) *flag = 1u;
        __syncthreads();
        const bool redo = *flag != 0u;
        __syncthreads();
        if (redo) return true;
    }
    const float linv = 1.0f / pair_sum(l_run);
    if constexpr (DIFF) {
        LAS float* ex = (LAS float*)lds;
        if (map == 1) {
#pragma unroll
            for (int d0 = 0; d0 < ND0; ++d0)
#pragma unroll
                for (int r = 0; r < 16; ++r) ex[(d0 * 16 + r) * 256 + (wid & 3) * 64 + lane] = o[d0][r] * linv;
        }
        __syncthreads();
        if (map == 0) {
            const float lam = *(const LAS float*)(lds + LDS_LAM);
            const LAS float* sg = (const LAS float*)(lds + LDS_SG);
            float ss = 0.f;
#pragma unroll
            for (int d0 = 0; d0 < ND0; ++d0)
#pragma unroll
                for (int r = 0; r < 16; ++r) { const float v = o[d0][r] * linv - lam * ex[(d0 * 16 + r) * 256 + (wid & 3) * 64 + lane]; o[d0][r] = v; ss += v * v; }
            ss = pair_sum(ss);
            const float rstd = 0.8f / sqrtf(ss * (1.f / 128.f) + NORM_EPS);
            bf16_t* op = AO + (tok0 + qpos) * 1024 + hh * 128 + 4 * hi;
#pragma unroll
            for (int d0 = 0; d0 < ND0; ++d0)
#pragma unroll
                for (int rg = 0; rg < 4; ++rg) {
                    const int dcol = 32 * d0 + 8 * rg + 4 * hi;
                    const f32x4 gg = *(const LAS f32x4*)(sg + dcol);
                    u32x2 w; w.x = pk2(o[d0][4 * rg] * rstd * gg[0], o[d0][4 * rg + 1] * rstd * gg[1]); w.y = pk2(o[d0][4 * rg + 2] * rstd * gg[2], o[d0][4 * rg + 3] * rstd * gg[3]);
                    *(u32x2*)(op + 32 * d0 + 8 * rg) = w;
                }
        }
        __syncthreads();
    } else {
        bf16_t* op = AO + (tok0 + qpos) * 1024 + 512 + hh * 64 + 4 * hi;
#pragma unroll
        for (int d0 = 0; d0 < ND0; ++d0)
#pragma unroll
            for (int rg = 0; rg < 4; ++rg) {
                u32x2 w; w.x = pk2(o[d0][4 * rg] * linv, o[d0][4 * rg + 1] * linv); w.y = pk2(o[d0][4 * rg + 2] * linv, o[d0][4 * rg + 3] * linv);
                *(u32x2*)(op + 32 * d0 + 8 * rg) = w;
            }
    }
    return false;
}
}

__device__ __forceinline__ void attn_phase(Frame& F) {
    const int tid = F.tid;
    {
        LAS float* tabs = (LAS float*)(F.lds + att::LDS_TAB);
        for (int i = tid; i < 2048; i += 512) {
            const int col = i >> 7, n = i & 127;
            int bucket;
            if (n < 16) bucket = n;
            else { const float nf = (float)n; int lg = 16 + (int)(logf(nf / 16.0f) / 2.0794415416798357f * 16.0f); bucket = lg < 31 ? lg : 31; }
            tabs[col * 128 + n] = (F.rel_bias[bucket * 16 + col] - F.rel_bias[31 * 16 + col]) * LOG2E;
        }
        LAS float* sg = (LAS float*)(F.lds + att::LDS_SG);
        if (tid < 128) sg[tid] = F.subln_g[tid];
        if (F.wave == 7) {
            const float a = F.diff_lambda[F.lane] * F.diff_lambda[64 + F.lane], bq = F.diff_lambda[128 + F.lane] * F.diff_lambda[192 + F.lane];
            const float sa = wave_sum(a), sb = wave_sum(bq);
            if (F.lane == 0) *(LAS float*)(F.lds + att::LDS_LAM) = expf(sa) - expf(sb) + 0.2f;
        }
        __syncthreads();
    }
    const bf16_t* QK = (const bf16_t*)(F.ws + WS_QK); const bf16_t* VT = (const bf16_t*)(F.ws + WS_VT); bf16_t* AO = (bf16_t*)(F.ws + WS_AO);
    const float* ksum = (const float*)(F.ws + WS_KSUM);
    if (F.G == 256) {
        { const int bh = F.vcu >> 2, quarter = F.vcu & 3;
          for (int i = 0; i < 8; ++i) { const int s = quarter * 4 + (i >> 1), qt = (i & 1) ? 31 - s : s; const int i2 = i + 1, s2 = quarter * 4 + (i2 >> 1), qt2 = (i2 & 1) ? 31 - s2 : s2;
              (void)qt2; float msh = 0.f; for (int a = 0; a < 8 && att::unit<true>(F.lds, QK, VT, AO, ksum, bh >> 2, bh & 3, qt, msh); ++a) {} } }
        { const int bh = F.vcu >> 1, half = F.vcu & 1;
          for (int i = 0; i < 8; ++i) { const int s = half * 4 + (i >> 1), qt = (i & 1) ? 15 - s : s; const int i2 = i + 1, s2 = half * 4 + (i2 >> 1), qt2 = (i2 & 1) ? 15 - s2 : s2;
              (void)qt2; float msh = 0.f; for (int a = 0; a < 8 && att::unit<false>(F.lds, QK, VT, AO, ksum, bh >> 3, bh & 7, qt, msh); ++a) {} } }
    } else {
        for (int u = blockIdx.x; u < 2048; u += F.G) { const int bh = u >> 5; float msh = 0.f; for (int a = 0; a < 8 && att::unit<true>(F.lds, QK, VT, AO, ksum, bh >> 2, bh & 3, u & 31, msh); ++a) {} }
        for (int u = blockIdx.x; u < 2048; u += F.G) { const int bh = u >> 4; float msh = 0.f; for (int a = 0; a < 8 && att::unit<false>(F.lds, QK, VT, AO, ksum, bh >> 3, bh & 7, u & 15, msh); ++a) {} }
    }
}

__device__ __forceinline__ unsigned f2key(float f) { const unsigned u = __float_as_uint(f); return (u & 0x80000000u) ? ~u : (u | 0x80000000u); }
typedef short s16x2 __attribute__((ext_vector_type(2)));
__device__ __forceinline__ unsigned h2key2(unsigned w) { const s16x2 s = __builtin_bit_cast(s16x2, w) >> 15; return w ^ (__builtin_bit_cast(unsigned, s) | 0x80008000u); }
__device__ __forceinline__ unsigned h2key(unsigned x) { return (x & 0x80000000u) ? ~x : (x | 0x80000000u); }
__device__ __forceinline__ float key2h(unsigned k) { const unsigned hb = ((k & 0x80000000u) ? (k & 0x7fffffffu) : ~k) >> 16; return (float)__builtin_bit_cast(_Float16, (unsigned short)hb); }
__device__ __forceinline__ float key2f(unsigned k) { const unsigned u = (k & 0x80000000u) ? (k & 0x7fffffffu) : ~k; return __uint_as_float(u); }
__device__ __forceinline__ void ins16(unsigned (&L)[16], unsigned x) {
#pragma unroll
    for (int k = 0; k < 16; ++k) { const unsigned t = max(L[k], x); x = min(L[k], x); L[k] = t; }
}
#define SORT16_DESC(L) do { unsigned t_; \
    t_ = max(L[0], L[1]); L[1] = min(L[0], L[1]); L[0] = t_; \
    t_ = max(L[2], L[3]); L[3] = min(L[2], L[3]); L[2] = t_; \
    t_ = max(L[0], L[2]); L[2] = min(L[0], L[2]); L[0] = t_; \
    t_ = max(L[1], L[3]); L[3] = min(L[1], L[3]); L[1] = t_; \
    t_ = max(L[1], L[2]); L[2] = min(L[1], L[2]); L[1] = t_; \
    t_ = max(L[4], L[5]); L[5] = min(L[4], L[5]); L[4] = t_; \
    t_ = max(L[6], L[7]); L[7] = min(L[6], L[7]); L[6] = t_; \
    t_ = max(L[4], L[6]); L[6] = min(L[4], L[6]); L[4] = t_; \
    t_ = max(L[5], L[7]); L[7] = min(L[5], L[7]); L[5] = t_; \
    t_ = max(L[5], L[6]); L[6] = min(L[5], L[6]); L[5] = t_; \
    t_ = max(L[0], L[4]); L[4] = min(L[0], L[4]); L[0] = t_; \
    t_ = max(L[2], L[6]); L[6] = min(L[2], L[6]); L[2] = t_; \
    t_ = max(L[2], L[4]); L[4] = min(L[2], L[4]); L[2] = t_; \
    t_ = max(L[1], L[5]); L[5] = min(L[1], L[5]); L[1] = t_; \
    t_ = max(L[3], L[7]); L[7] = min(L[3], L[7]); L[3] = t_; \
    t_ = max(L[3], L[5]); L[5] = min(L[3], L[5]); L[3] = t_; \
    t_ = max(L[1], L[2]); L[2] = min(L[1], L[2]); L[1] = t_; \
    t_ = max(L[3], L[4]); L[4] = min(L[3], L[4]); L[3] = t_; \
    t_ = max(L[5], L[6]); L[6] = min(L[5], L[6]); L[5] = t_; \
    t_ = max(L[8], L[9]); L[9] = min(L[8], L[9]); L[8] = t_; \
    t_ = max(L[10], L[11]); L[11] = min(L[10], L[11]); L[10] = t_; \
    t_ = max(L[8], L[10]); L[10] = min(L[8], L[10]); L[8] = t_; \
    t_ = max(L[9], L[11]); L[11] = min(L[9], L[11]); L[9] = t_; \
    t_ = max(L[9], L[10]); L[10] = min(L[9], L[10]); L[9] = t_; \
    t_ = max(L[12], L[13]); L[13] = min(L[12], L[13]); L[12] = t_; \
    t_ = max(L[14], L[15]); L[15] = min(L[14], L[15]); L[14] = t_; \
    t_ = max(L[12], L[14]); L[14] = min(L[12], L[14]); L[12] = t_; \
    t_ = max(L[13], L[15]); L[15] = min(L[13], L[15]); L[13] = t_; \
    t_ = max(L[13], L[14]); L[14] = min(L[13], L[14]); L[13] = t_; \
    t_ = max(L[8], L[12]); L[12] = min(L[8], L[12]); L[8] = t_; \
    t_ = max(L[10], L[14]); L[14] = min(L[10], L[14]); L[10] = t_; \
    t_ = max(L[10], L[12]); L[12] = min(L[10], L[12]); L[10] = t_; \
    t_ = max(L[9], L[13]); L[13] = min(L[9], L[13]); L[9] = t_; \
    t_ = max(L[11], L[15]); L[15] = min(L[11], L[15]); L[11] = t_; \
    t_ = max(L[11], L[13]); L[13] = min(L[11], L[13]); L[11] = t_; \
    t_ = max(L[9], L[10]); L[10] = min(L[9], L[10]); L[9] = t_; \
    t_ = max(L[11], L[12]); L[12] = min(L[11], L[12]); L[11] = t_; \
    t_ = max(L[13], L[14]); L[14] = min(L[13], L[14]); L[13] = t_; \
    t_ = max(L[0], L[8]); L[8] = min(L[0], L[8]); L[0] = t_; \
    t_ = max(L[4], L[12]); L[12] = min(L[4], L[12]); L[4] = t_; \
    t_ = max(L[4], L[8]); L[8] = min(L[4], L[8]); L[4] = t_; \
    t_ = max(L[2], L[10]); L[10] = min(L[2], L[10]); L[2] = t_; \
    t_ = max(L[6], L[14]); L[14] = min(L[6], L[14]); L[6] = t_; \
    t_ = max(L[6], L[10]); L[10] = min(L[6], L[10]); L[6] = t_; \
    t_ = max(L[2], L[4]); L[4] = min(L[2], L[4]); L[2] = t_; \
    t_ = max(L[6], L[8]); L[8] = min(L[6], L[8]); L[6] = t_; \
    t_ = max(L[10], L[12]); L[12] = min(L[10], L[12]); L[10] = t_; \
    t_ = max(L[1], L[9]); L[9] = min(L[1], L[9]); L[1] = t_; \
    t_ = max(L[5], L[13]); L[13] = min(L[5], L[13]); L[5] = t_; \
    t_ = max(L[5], L[9]); L[9] = min(L[5], L[9]); L[5] = t_; \
    t_ = max(L[3], L[11]); L[11] = min(L[3], L[11]); L[3] = t_; \
    t_ = max(L[7], L[15]); L[15] = min(L[7], L[15]); L[7] = t_; \
    t_ = max(L[7], L[11]); L[11] = min(L[7], L[11]); L[7] = t_; \
    t_ = max(L[3], L[5]); L[5] = min(L[3], L[5]); L[3] = t_; \
    t_ = max(L[7], L[9]); L[9] = min(L[7], L[9]); L[7] = t_; \
    t_ = max(L[11], L[13]); L[13] = min(L[11], L[13]); L[11] = t_; \
    t_ = max(L[1], L[2]); L[2] = min(L[1], L[2]); L[1] = t_; \
    t_ = max(L[3], L[4]); L[4] = min(L[3], L[4]); L[3] = t_; \
    t_ = max(L[5], L[6]); L[6] = min(L[5], L[6]); L[5] = t_; \
    t_ = max(L[7], L[8]); L[8] = min(L[7], L[8]); L[7] = t_; \
    t_ = max(L[9], L[10]); L[10] = min(L[9], L[10]); L[9] = t_; \
    t_ = max(L[11], L[12]); L[12] = min(L[11], L[12]); L[11] = t_; \
    t_ = max(L[13], L[14]); L[14] = min(L[13], L[14]); L[13] = t_; \
} while (0)
#define BITONIC16_DESC(L) do { unsigned t_; \
    t_ = max(L[0], L[8]); L[8] = min(L[0], L[8]); L[0] = t_; \
    t_ = max(L[1], L[9]); L[9] = min(L[1], L[9]); L[1] = t_; \
    t_ = max(L[2], L[10]); L[10] = min(L[2], L[10]); L[2] = t_; \
    t_ = max(L[3], L[11]); L[11] = min(L[3], L[11]); L[3] = t_; \
    t_ = max(L[4], L[12]); L[12] = min(L[4], L[12]); L[4] = t_; \
    t_ = max(L[5], L[13]); L[13] = min(L[5], L[13]); L[5] = t_; \
    t_ = max(L[6], L[14]); L[14] = min(L[6], L[14]); L[6] = t_; \
    t_ = max(L[7], L[15]); L[15] = min(L[7], L[15]); L[7] = t_; \
    t_ = max(L[0], L[4]); L[4] = min(L[0], L[4]); L[0] = t_; \
    t_ = max(L[1], L[5]); L[5] = min(L[1], L[5]); L[1] = t_; \
    t_ = max(L[2], L[6]); L[6] = min(L[2], L[6]); L[2] = t_; \
    t_ = max(L[3], L[7]); L[7] = min(L[3], L[7]); L[3] = t_; \
    t_ = max(L[8], L[12]); L[12] = min(L[8], L[12]); L[8] = t_; \
    t_ = max(L[9], L[13]); L[13] = min(L[9], L[13]); L[9] = t_; \
    t_ = max(L[10], L[14]); L[14] = min(L[10], L[14]); L[10] = t_; \
    t_ = max(L[11], L[15]); L[15] = min(L[11], L[15]); L[11] = t_; \
    t_ = max(L[0], L[2]); L[2] = min(L[0], L[2]); L[0] = t_; \
    t_ = max(L[1], L[3]); L[3] = min(L[1], L[3]); L[1] = t_; \
    t_ = max(L[4], L[6]); L[6] = min(L[4], L[6]); L[4] = t_; \
    t_ = max(L[5], L[7]); L[7] = min(L[5], L[7]); L[5] = t_; \
    t_ = max(L[8], L[10]); L[10] = min(L[8], L[10]); L[8] = t_; \
    t_ = max(L[9], L[11]); L[11] = min(L[9], L[11]); L[9] = t_; \
    t_ = max(L[12], L[14]); L[14] = min(L[12], L[14]); L[12] = t_; \
    t_ = max(L[13], L[15]); L[15] = min(L[13], L[15]); L[13] = t_; \
    t_ = max(L[0], L[1]); L[1] = min(L[0], L[1]); L[0] = t_; \
    t_ = max(L[2], L[3]); L[3] = min(L[2], L[3]); L[2] = t_; \
    t_ = max(L[4], L[5]); L[5] = min(L[4], L[5]); L[4] = t_; \
    t_ = max(L[6], L[7]); L[7] = min(L[6], L[7]); L[6] = t_; \
    t_ = max(L[8], L[9]); L[9] = min(L[8], L[9]); L[8] = t_; \
    t_ = max(L[10], L[11]); L[11] = min(L[10], L[11]); L[10] = t_; \
    t_ = max(L[12], L[13]); L[13] = min(L[12], L[13]); L[12] = t_; \
    t_ = max(L[14], L[15]); L[15] = min(L[14], L[15]); L[14] = t_; \
} while (0)
__device__ __forceinline__ void topk_panel(Frame& F, const void* P, int pm) {
    const int tid = F.tid, row = tid & 255, hq = tid >> 8;
    LAS unsigned* OUT = (LAS unsigned*)(F.lds + 16384) + row * 132;
    for (int hh = 0; hh < 4; ++hh) {
        const int h = hq * 4 + hh;
        unsigned L1[16], L2[16];
#pragma unroll
        for (int k = 0; k < 16; ++k) { L1[k] = 0u; L2[k] = 0u; }
        const u32x2* p1 = (const u32x2*)P + ((size_t)(h * 2) * 32 * 256 + row);
        const u32x2* p2 = p1 + (size_t)32 * 256;
        u32x2 cv[4], cw[4], nv[4], nw[4];
#pragma unroll
        for (int q = 0; q < 4; ++q) { cv[q] = p1[(size_t)q * 256]; cw[q] = p2[(size_t)q * 256]; }
#pragma unroll
        for (int c = 0; c < 8; ++c) {
            const int cn = (c < 7) ? c + 1 : 7;
#pragma unroll
            for (int q = 0; q < 4; ++q) { nv[q] = p1[(size_t)(cn * 4 + q) * 256]; nw[q] = p2[(size_t)(cn * 4 + q) * 256]; }
            unsigned C1[16], C2[16];
#pragma unroll
            for (int q = 0; q < 4; ++q)
#pragma unroll
                for (int e = 0; e < 4; e += 2) { const unsigned idx = (unsigned)(127 - (c * 16 + q * 4 + e));
                    const unsigned k1 = h2key2(cv[q][e >> 1]), k2 = h2key2(cw[q][e >> 1]);
                    C1[q * 4 + e] = (k1 << 16) | idx; C1[q * 4 + e + 1] = (k1 & 0xffff0000u) | (idx - 1u);
                    C2[q * 4 + e] = (k2 << 16) | idx; C2[q * 4 + e + 1] = (k2 & 0xffff0000u) | (idx - 1u); }
            SORT16_DESC(C1); SORT16_DESC(C2);
            if (c == 0) {
#pragma unroll
                for (int i = 0; i < 16; ++i) { L1[i] = C1[i]; L2[i] = C2[i]; }
            } else {
#pragma unroll
                for (int i = 0; i < 16; ++i) { L1[i] = max(L1[i], C1[15 - i]); L2[i] = max(L2[i], C2[15 - i]); }
                BITONIC16_DESC(L1); BITONIC16_DESC(L2);
            }
#pragma unroll
            for (int q = 0; q < 4; ++q) { cv[q] = nv[q]; cw[q] = nw[q]; }
        }
        float v1[16], v2[16];
#pragma unroll
        for (int k = 0; k < 16; ++k) { v1[k] = key2h(L1[k]); v2[k] = key2h(L2[k]); }
        LAS unsigned* myw = (LAS unsigned*)(F.lds + tid * 32);
#pragma unroll
        for (int q = 0; q < 4; ++q) {
            myw[q] = (127u - (L1[4 * q] & 127u)) | ((127u - (L1[4 * q + 1] & 127u)) << 8) | ((127u - (L1[4 * q + 2] & 127u)) << 16) | ((127u - (L1[4 * q + 3] & 127u)) << 24);
            myw[4 + q] = (127u - (L2[4 * q] & 127u)) | ((127u - (L2[4 * q + 1] & 127u)) << 8) | ((127u - (L2[4 * q + 2] & 127u)) << 16) | ((127u - (L2[4 * q + 3] & 127u)) << 24);
        }
        const LAS unsigned char* myb = (const LAS unsigned char*)myw;
#define CKEY(a, bb) ((f2key(v1[a] + v2[bb]) & ~255u) | (unsigned)(255 - ((a) * 16 + (bb))))
        unsigned L[16];
#pragma unroll
        for (int k = 0; k < 16; ++k) L[k] = CKEY(0, k);
#pragma unroll
        for (int a = 1; a <= 4; ++a) {
#pragma unroll
            for (int bb = 0; bb < 16; ++bb) if ((a + 1) * (bb + 1) <= 16) L[15 - bb] = max(L[15 - bb], CKEY(a, bb));
            BITONIC16_DESC(L);
        }
#pragma unroll
        for (int a = 5; a < 16; ++a)
#pragma unroll
            for (int bb = 0; bb < 16; ++bb)
                if ((a + 1) * (bb + 1) <= 16) ins16(L, CKEY(a, bb));
#undef CKEY
        float w[16]; float ssum = 0.f;
        const float mtop = key2f((L[0] & ~255u) | 128u);
#pragma unroll
        for (int k = 0; k < 16; ++k) { w[k] = __expf(key2f((L[k] & ~255u) | 128u) - mtop); ssum += w[k]; }
        const float inv = 1.0f / ssum;
#pragma unroll
        for (int k = 0; k < 16; ++k) {
            const int ci = 255 - (int)(L[k] & 255u);
            const int e1 = myb[ci >> 4], e2 = myb[16 + (ci & 15)];
            const int pos = (k & 7) * 16 + h * 2 + (k >> 3);
            OUT[pos] = (unsigned)(e1 * 128 + e2) | (pk2(0.f, w[k] * inv) & 0xffff0000u);
        }
    }
    __syncthreads();
    {
        unsigned char* PE = F.ws + WS_PE + (size_t)pm * (256 * 256); unsigned char* PG = F.ws + WS_PG + (size_t)pm * (256 * 256);
#pragma unroll
        for (int i = 0; i < 8; ++i) {
            const int c = tid + 512 * i, r = c >> 4, part = c & 15;
            const LAS u32x4* q = (const LAS u32x4*)(F.lds + 16384 + r * 528 + part * 32);
            const u32x4 a = q[0], b2 = q[1];
            *(u32x4*)(PE + (size_t)c * 16) = (u32x4){(a.x & 0xffffu) | (a.y << 16), (a.z & 0xffffu) | (a.w << 16), (b2.x & 0xffffu) | (b2.y << 16), (b2.z & 0xffffu) | (b2.w << 16)};
            *(u32x4*)(PG + (size_t)c * 16) = (u32x4){(a.x >> 16) | (a.y & 0xffff0000u), (a.z >> 16) | (a.w & 0xffff0000u), (b2.x >> 16) | (b2.y & 0xffff0000u), (b2.z >> 16) | (b2.w & 0xffff0000u)};
        }
    }
}

__device__ __forceinline__ float gelu_erf(float v) { return 0.5f * v * (1.0f + erff(v * 0.70710678118654752f)); }
typedef float f32x2 __attribute__((ext_vector_type(2)));
typedef int i32x2 __attribute__((ext_vector_type(2)));
typedef int i32x8 __attribute__((ext_vector_type(8)));
__device__ __forceinline__ float dpp_x1(float v) { return __int_as_float(__builtin_amdgcn_update_dpp(0, __float_as_int(v), 0xB1, 0xf, 0xf, false)); }
__device__ __forceinline__ float dpp_x2(float v) { return __int_as_float(__builtin_amdgcn_update_dpp(0, __float_as_int(v), 0x4E, 0xf, 0xf, false)); }
__device__ __forceinline__ float dpp_hm(float v) { return __int_as_float(__builtin_amdgcn_update_dpp(0, __float_as_int(v), 0x141, 0xf, 0xf, false)); }
__device__ __forceinline__ float dpp_r8(float v) { return __int_as_float(__builtin_amdgcn_update_dpp(0, __float_as_int(v), 0x128, 0xf, 0xf, false)); }
__device__ __forceinline__ unsigned e16_of(const u32x4& ea, const u32x4& eb, int i) { const unsigned w = (i < 8) ? ea[(i & 7) >> 1] : eb[(i & 7) >> 1]; return (i & 1) ? (w >> 16) : (w & 0xffffu); }

__device__ __forceinline__ void peer_u_phase(Frame& F) {
    const int lane = F.lane, wave = F.wave, g = lane >> 3, l8 = lane & 7, n = lane & 15, kg = lane >> 4;
    const unsigned char* PE = F.ws + WS_PE; const unsigned char* H8 = F.ws + WS_H8; bf16_t* PART = (bf16_t*)(F.ws + WS_PART);
    LAS unsigned char* stg = F.lds + wave * 16384;
    LAS unsigned char* ebuf = F.lds + 131072 + wave * 2048;
    const int soff0 = (l8 ^ (g >> 1)) << 4, soff1 = soff0 ^ 64;
    const int rkey = (n >> 1) & 7, rd0 = n * 128 + ((kg ^ rkey) << 4), rd1 = n * 128 + (((4 + kg) ^ rkey) << 4);
    const int erd = g * 32, brd = 512 + (n & 1) * 256 + kg * 16;
    for (int it = blockIdx.x; it < 256; it += F.G) {
        const int x = it & 3, cb = it >> 2;
        const unsigned char* Ux = F.ws + WS_U8 + (size_t)x * (NEXP * 128);
        bf16_t* part = PART + (size_t)x * ((size_t)MT * 128);
        const int tok0 = cb * 1024 + wave * 128, tokl = tok0 + 127;
        const unsigned char* pe = PE + lane * 4; const unsigned char* ph = H8 + x * 256 + lane * 4;
#define U_DMA_E(tok, par) __builtin_amdgcn_global_load_lds((const unsigned*)(pe + (size_t)(tok) * 256), (LAS unsigned*)(ebuf + (par) * 256), 4, 0, 0)
#define U_DMA_B(tok, par) do { __builtin_amdgcn_global_load_lds((const unsigned*)(ph + (size_t)(tok) * 2048), (LAS unsigned*)(ebuf + 512 + (par) * 512), 4, 0, 0); \
                               __builtin_amdgcn_global_load_lds((const unsigned*)(ph + (size_t)(tok) * 2048 + 1024), (LAS unsigned*)(ebuf + 512 + (par) * 512 + 256), 4, 0, 0); } while (0)
#define U_TILES(ea, eb) do { _Pragma("unroll") for (int j_ = 0; j_ < 16; ++j_) \
        __builtin_amdgcn_global_load_lds((const unsigned*)(Ux + (size_t)e16_of(ea, eb, j_) * 128 + ((j_ & 1) ? soff1 : soff0)), (LAS unsigned*)(stg + j_ * 1024), 16, 0, 0); } while (0)
#define U_TOKEN(tok, par, tokn1, tokn2) do { \
            U_DMA_E(tokn2, par); U_DMA_B(tokn1, (par) ^ 1); \
              \
            asm volatile("s_waitcnt vmcnt(4)" ::: "memory"); \
            u32x4 img[16]; \
            _Pragma("unroll") for (int T = 0; T < 8; ++T) { img[2 * T] = *(const LAS u32x4*)(stg + T * 2048 + rd0); img[2 * T + 1] = *(const LAS u32x4*)(stg + T * 2048 + rd1); } \
            const u32x4 eC0 = *(const LAS u32x4*)(ebuf + ((par) ^ 1) * 256 + erd), eC1 = *(const LAS u32x4*)(ebuf + ((par) ^ 1) * 256 + erd + 16); \
            const u32x4 h0 = *(const LAS u32x4*)(ebuf + (par) * 512 + brd), h1 = *(const LAS u32x4*)(ebuf + (par) * 512 + brd + 64), h2_ = *(const LAS u32x4*)(ebuf + (par) * 512 + brd + 128), h3 = *(const LAS u32x4*)(ebuf + (par) * 512 + brd + 192); \
            asm volatile("s_waitcnt lgkmcnt(0)" ::: "memory");                    \
            U_TILES(eC0, eC1); \
            const i32x8 A0_ = {(int)h0.x, (int)h0.y, (int)h0.z, (int)h0.w, (int)h1.x, (int)h1.y, (int)h1.z, (int)h1.w}; \
            const i32x8 A1_ = {(int)h2_.x, (int)h2_.y, (int)h2_.z, (int)h2_.w, (int)h3.x, (int)h3.y, (int)h3.z, (int)h3.w}; \
            float res[8]; \
            _Pragma("unroll") for (int T = 0; T < 8; ++T) { \
                const i32x8 B0_ = {(int)img[2 * T].x, (int)img[2 * T].y, (int)img[2 * T].z, (int)img[2 * T].w, 0, 0, 0, 0}; \
                const i32x8 B1_ = {(int)img[2 * T + 1].x, (int)img[2 * T + 1].y, (int)img[2 * T + 1].z, (int)img[2 * T + 1].w, 0, 0, 0, 0}; \
                f32x4 d_ = __builtin_amdgcn_mfma_scale_f32_16x16x128_f8f6f4(A0_, B0_, (f32x4){0.f, 0.f, 0.f, 0.f}, 0, 4, 0, 0, 0, 0); \
                d_ = __builtin_amdgcn_mfma_scale_f32_16x16x128_f8f6f4(A1_, B1_, d_, 0, 4, 0, 0, 0, 0); \
                res[T] = d_[0] + d_[1] * 0.0625f; }                                  \
              \
            unsigned d2_[8]; \
            _Pragma("unroll") for (int T = 0; T < 8; ++T) { const float p_ = dpp_r8(res[T]); d2_[T] = (n < 8) ? pk2(res[T], p_) : pk2(p_, res[T]); } \
            if (lane < 16) *(u32x4*)(part + (size_t)(tok) * 128 + 16 * (n & 7) + 8 * (n >> 3)) = (n < 8) ? (u32x4){d2_[0], d2_[1], d2_[2], d2_[3]} : (u32x4){d2_[4], d2_[5], d2_[6], d2_[7]}; \
        } while (0)
        {
            U_DMA_E(tok0, 0); U_DMA_E(tok0 + 1, 1); U_DMA_B(tok0, 0);
            asm volatile("s_waitcnt vmcnt(0)" ::: "memory");
            const u32x4 eX0 = *(const LAS u32x4*)(ebuf + erd), eX1 = *(const LAS u32x4*)(ebuf + erd + 16);
            asm volatile("s_waitcnt lgkmcnt(0)" ::: "memory");
            U_TILES(eX0, eX1);
            U_DMA_E(tok0 + 1, 1);
        }
        for (int tt = 0; tt < 128; tt += 2) {
            const int t0 = tok0 + tt, t1 = t0 + 1, t2 = min(t0 + 2, tokl), t3 = min(t0 + 3, tokl);
            U_TOKEN(t0, 0, t1, t2);
            U_TOKEN(t1, 1, t2, t3);
        }
        asm volatile("s_waitcnt vmcnt(0)" ::: "memory");
#undef U_TOKEN
#undef U_TILES
#undef U_DMA_B
#undef U_DMA_E
    }
}
__device__ __forceinline__ void peer_w_phase(Frame& F) {
    const u32x2* PART = (const u32x2*)(F.ws + WS_PART); const u32x2* PG = (const u32x2*)(F.ws + WS_PG); const unsigned short* PE = (const unsigned short*)(F.ws + WS_PE); const float* vs = (const float*)(F.ws + WS_VS); const float* us = (const float*)(F.ws + WS_US);
    const size_t n4 = (size_t)MT * 128 / 4, stride = (size_t)F.G * 512;
    for (size_t p = (size_t)blockIdx.x * 512 + F.tid; p < n4; p += stride) {
        f32x4 s = {0.f, 0.f, 0.f, 0.f};
#pragma unroll
        for (int x = 0; x < 4; ++x) { const u32x2 w_ = PART[(size_t)x * n4 + p]; s += (f32x4){bf_lo(w_.x), bf_hi(w_.x), bf_lo(w_.y), bf_hi(w_.y)}; }
        const u32x2 gw_ = PG[p]; const f32x4 gt = {bf_lo(gw_.x), bf_hi(gw_.x), bf_lo(gw_.y), bf_hi(gw_.y)}; f32x4 o;
#pragma unroll
        for (int e = 0; e < 4; ++e) { const int ex = PE[4 * p + e]; o[e] = gt[e] * gelu_erf(s[e] * us[ex]) * vs[ex]; }
        float mx = fmaxf(fmaxf(fabsf(o[0]), fabsf(o[1])), fmaxf(fabsf(o[2]), fabsf(o[3])));
#pragma unroll
        for (int off = 1; off < 32; off <<= 1) mx = fmaxf(mx, __shfl_xor(mx, off));
        const float inv = mx > 0.f ? 256.f / mx : 0.f;
        o = o * inv;
        int hw = 0; hw = __builtin_amdgcn_cvt_pk_fp8_f32(o[0], o[1], hw, false); hw = __builtin_amdgcn_cvt_pk_fp8_f32(o[2], o[3], hw, true);
        const f32x4 r = {16.f * (o[0] - __builtin_amdgcn_cvt_f32_fp8(hw, 0)), 16.f * (o[1] - __builtin_amdgcn_cvt_f32_fp8(hw, 1)), 16.f * (o[2] - __builtin_amdgcn_cvt_f32_fp8(hw, 2)), 16.f * (o[3] - __builtin_amdgcn_cvt_f32_fp8(hw, 3))};
        int lw = 0; lw = __builtin_amdgcn_cvt_pk_fp8_f32(r[0], r[1], lw, false); lw = __builtin_amdgcn_cvt_pk_fp8_f32(r[2], r[3], lw, true);
        unsigned char* rec = F.ws + WS_WB + (p >> 5) * 512; const int q = (int)(p & 31);
        *(unsigned*)(rec + 4 * q) = (unsigned)hw; *(unsigned*)(rec + 128 + 4 * q) = (unsigned)lw;
        if (q == 0) *(float*)(rec + 256) = mx * (1.f / 256.f);
    }
}
__device__ __forceinline__ void peer_v_phase(Frame& F) {
    const int lane = F.lane, wave = F.wave, g = lane >> 3, l8 = lane & 7, n = lane & 15, kg = lane >> 4;
    const unsigned char* PE = F.ws + WS_PE; const unsigned char* WB = F.ws + WS_WB; bf16_t* Y = (bf16_t*)(F.ws + WS_Y);
    LAS unsigned char* stg = F.lds + wave * 16384;
    LAS unsigned char* ebuf = F.lds + 131072 + wave * 2048;
    const int soff0 = (l8 ^ (g >> 1)) << 4, soff1 = soff0 ^ 64;
    const int kq = (n >> 1) & 7, tb = (32 * kg + n) * 128;
    unsigned tba[8];
#pragma unroll
    for (int c2 = 0; c2 < 8; ++c2) tba[c2] = (unsigned)(unsigned long)(stg + tb + ((c2 ^ kq) << 4));
    const int erd = 2 * g, ard = 512 + (n & 1) * 128 + kg * 16;
    for (int it = blockIdx.x; it < 256; it += F.G) {
        const int x = it & 3, cb = it >> 2;
        const unsigned char* Vx = F.ws + WS_V8 + (size_t)x * (NEXP * 128);
        const int tok0 = cb * 1024 + wave * 128, tokl = tok0 + 127;
        const unsigned char* pe = PE + lane * 4; const unsigned char* pw = WB + lane * 4; const unsigned char* psc = WB + 256;
#define V_DMA_E(tok, par) __builtin_amdgcn_global_load_lds((const unsigned*)(pe + (size_t)(tok) * 256), (LAS unsigned*)(ebuf + (par) * 256), 4, 0, 0)
#define V_DMA_A(tok, par) do { __builtin_amdgcn_global_load_lds((const unsigned*)(pw + (size_t)(tok) * 512), (LAS unsigned*)(ebuf + 512 + (par) * 512), 4, 0, 0); \
                               __builtin_amdgcn_global_load_lds((const unsigned*)(psc + (size_t)(tok) * 512), (LAS unsigned*)(ebuf + 512 + (par) * 512 + 256), 4, 0, 0); } while (0)
#define V_IDS(par, id) do { _Pragma("unroll") for (int j_ = 0; j_ < 16; ++j_) id[j_] = *(const LAS unsigned short*)(ebuf + (par) * 256 + 16 * j_ + erd); } while (0)
#define V_TILES(id) do { _Pragma("unroll") for (int j_ = 0; j_ < 16; ++j_) \
        __builtin_amdgcn_global_load_lds((const unsigned*)(Vx + (size_t)id[j_] * 128 + ((j_ & 1) ? soff1 : soff0)), (LAS unsigned*)(stg + j_ * 1024), 16, 0, 0); } while (0)
#define V_TOKEN(tok, par, tokn1, tokn2) do { \
            V_DMA_E(tokn2, par); V_DMA_A(tokn1, (par) ^ 1); \
              \
            asm volatile("s_waitcnt vmcnt(5)" ::: "memory"); \
            i32x2 bt[32]; unsigned id[16]; \
              \
            _Pragma("unroll") for (int c = 0; c < 16; ++c) { \
                asm volatile("ds_read_b64_tr_b4 %0, %1 offset:%2" : "=v"(bt[2 * c]) : "v"(tba[c >> 1]), "n"((c & 1) * 8)); \
                asm volatile("ds_read_b64_tr_b4 %0, %1 offset:%2" : "=v"(bt[2 * c + 1]) : "v"(tba[c >> 1]), "n"((c & 1) * 8 + 2048)); } \
            V_IDS((par) ^ 1, id); \
            const u32x4 a0 = *(const LAS u32x4*)(ebuf + (par) * 512 + ard), a1 = *(const LAS u32x4*)(ebuf + (par) * 512 + ard + 64); \
            const float wsc = *(const LAS float*)(ebuf + 512 + (par) * 512 + 256); \
            asm volatile("s_waitcnt lgkmcnt(0)" : "+v"(bt[0]), "+v"(bt[1]), "+v"(bt[2]), "+v"(bt[3]), "+v"(bt[4]), "+v"(bt[5]), "+v"(bt[6]), "+v"(bt[7]), "+v"(bt[8]), "+v"(bt[9]), "+v"(bt[10]), "+v"(bt[11]) :: "memory");    \
            asm volatile("" : "+v"(bt[12]), "+v"(bt[13]), "+v"(bt[14]), "+v"(bt[15]), "+v"(bt[16]), "+v"(bt[17]), "+v"(bt[18]), "+v"(bt[19]), "+v"(bt[20]), "+v"(bt[21]), "+v"(bt[22]), "+v"(bt[23])); \
            asm volatile("" : "+v"(bt[24]), "+v"(bt[25]), "+v"(bt[26]), "+v"(bt[27]), "+v"(bt[28]), "+v"(bt[29]), "+v"(bt[30]), "+v"(bt[31])); \
            V_TILES(id); \
            const i32x8 A_ = {(int)a0.x, (int)a0.y, (int)a0.z, (int)a0.w, (int)a1.x, (int)a1.y, (int)a1.z, (int)a1.w}; \
            float res[16]; \
            _Pragma("unroll") for (int c = 0; c < 16; ++c) { \
                const i32x8 B_ = {bt[2 * c].x, bt[2 * c].y, bt[2 * c + 1].x, bt[2 * c + 1].y, 0, 0, 0, 0}; \
                const f32x4 d_ = __builtin_amdgcn_mfma_scale_f32_16x16x128_f8f6f4(A_, B_, (f32x4){0.f, 0.f, 0.f, 0.f}, 0, 4, 0, 0, 0, 0); \
                res[c] = (d_[0] + d_[1] * 0.0625f) * wsc; }                          \
            _Pragma("unroll") for (int c = 0; c < 16; ++c) asm volatile("" : "+v"(res[c]));        \
            if (lane < 16) { u32x4* yp = (u32x4*)(Y + (size_t)(tok) * 1024 + x * 256 + 16 * n); \
                yp[0] = (u32x4){pk2(res[0], res[1]), pk2(res[2], res[3]), pk2(res[4], res[5]), pk2(res[6], res[7])}; \
                yp[1] = (u32x4){pk2(res[8], res[9]), pk2(res[10], res[11]), pk2(res[12], res[13]), pk2(res[14], res[15])}; } \
        } while (0)
        {
            V_DMA_E(tok0, 0); V_DMA_E(tok0 + 1, 1); V_DMA_A(tok0, 0);
            asm volatile("s_waitcnt vmcnt(0)" ::: "memory");
            unsigned id[16]; V_IDS(0, id);
            asm volatile("s_waitcnt lgkmcnt(0)" ::: "memory");
            V_TILES(id);
            V_DMA_A(tok0, 0);
        }
        for (int tt = 0; tt < 128; tt += 2) {
            const int t0 = tok0 + tt, t1 = t0 + 1, t2 = min(t0 + 2, tokl), t3 = min(t0 + 3, tokl);
            V_TOKEN(t0, 0, t1, t2);
            V_TOKEN(t1, 1, t2, t3);
        }
        asm volatile("s_waitcnt vmcnt(0)" ::: "memory");
#undef V_TOKEN
#undef V_TILES
#undef V_IDS
#undef V_DMA_A
#undef V_DMA_E
    }
}
__device__ __forceinline__ void final_phase(Frame& F) {
    const bf16_t* Y = (const bf16_t*)(F.ws + WS_Y); const float* mod = (const float*)(F.ws + WS_MOD);
    const int gw = F.vcu * 8 + F.wave, NGW = F.G * 8;
    int tid_ = threadIdx.x; asm volatile("" : "+v"(tid_));
    const int lane = tid_ & 63;
    f32x4 fg[4];
#pragma unroll
    for (int j = 0; j < 4; ++j) fg[j] = *(const f32x4*)(F.final_g + 4 * lane + 256 * j);
    for (int tokb = gw * 32; tokb < MT; tokb += NGW * 32) {
        const int b = tokb >> 12;
        f32x4 g2[4];
#pragma unroll
        for (int j = 0; j < 4; ++j) g2[j] = *(const f32x4*)(mod + b * 6144 + 5120 + 4 * lane + 256 * j);
        for (int tok = tokb; tok < tokb + 32; ++tok) {
            float* orow = F.out + (size_t)tok * 1024 + 4 * lane;
            const bf16_t* xrow = (const bf16_t*)F.out + (size_t)tok * 2048 + 4 * lane; const bf16_t* yrow = Y + (size_t)tok * 1024 + 4 * lane;
            u32x2 w[4], yv[4];
#pragma unroll
            for (int j = 0; j < 4; ++j) { w[j] = *(const u32x2*)(xrow + 256 * j); yv[j] = *(const u32x2*)(yrow + 256 * j); }
            asm volatile("s_waitcnt vmcnt(0)" ::: "memory");
            f32x4 v[4]; float ss = 0.f;
#pragma unroll
            for (int j = 0; j < 4; ++j) { v[j] = (f32x4){bf_lo(w[j].x), bf_hi(w[j].x), bf_lo(w[j].y), bf_hi(w[j].y)} + g2[j] * (f32x4){bf_lo(yv[j].x), bf_hi(yv[j].x), bf_lo(yv[j].y), bf_hi(yv[j].y)};
                ss += v[j][0] * v[j][0] + v[j][1] * v[j][1] + v[j][2] * v[j][2] + v[j][3] * v[j][3]; }
            ss = wave_sum(ss);
            const float rstd = 1.0f / sqrtf(ss * (1.f / 1024.f) + NORM_EPS);
#pragma unroll
            for (int j = 0; j < 4; ++j) *(f32x4*)(orow + 256 * j) = v[j] * rstd * fg[j];
        }
    }
}

#ifndef MK_N_LAUNCHES
#define MK_N_LAUNCHES 1
#endif
constexpr int N_PHASES = 9;
struct Args { const float* in[16]; float* out; unsigned char* ws; int ph_lo, ph_hi; };
__global__ void __launch_bounds__(512, 2) mk_fwd(Args args) {
    extern __shared__ __attribute__((aligned(16))) unsigned char lds[];
    Frame F;
    F.lds = (LAS unsigned char*)lds;
    F.tid = threadIdx.x; F.lane = F.tid & 63; F.wave = __builtin_amdgcn_readfirstlane(F.tid >> 6);
    F.G = gridDim.x; { const int bx = blockIdx.x; F.vcu = (F.G % 8 == 0) ? (bx % 8) * (F.G / 8) + bx / 8 : bx; }
    F.x = args.in[0]; F.c = args.in[1]; F.rel_bias = args.in[2]; F.w_ada = args.in[3]; F.b_ada = args.in[4]; F.norm1_g = args.in[5]; F.w_in = args.in[6]; F.diff_lambda = args.in[7];
    F.subln_g = args.in[8]; F.w_out = args.in[9]; F.norm2_g = args.in[10]; F.peer_wq = args.in[11]; F.peer_keys = args.in[12]; F.peer_u = args.in[13]; F.peer_v = args.in[14]; F.final_g = args.in[15];
    F.out = args.out; F.ws = args.ws;
    volatile LAS unsigned* MISC = (volatile LAS unsigned*)(F.lds + MISC_OFF);
    if (F.tid < 64) MISC[F.tid] = 0u;
    __syncthreads();
    XcdBarrier bar; bar.bar = (unsigned*)(F.ws + WS_CTL) + CW_BAR; bar.x = 0; bar.st = nullptr;
    const int lo = args.ph_lo, hi = args.ph_hi;
    if (hi - lo > 1) bar = xcd_barrier_post((unsigned*)(F.ws + WS_CTL) + CW_BAR, MISC + 8);
#define IN(k) (lo <= (k) && (k) < hi)
#define SEAM(k) do { if (IN(k) && IN((k) + 1)) xcd_barrier(bar); } while (0)
    bf16_t* H = (bf16_t*)(F.ws + WS_H);
    if (IN(0)) { p0_prologue(F); } SEAM(0);
    if (IN(1)) { norm_phase<false>(F, F.x, F.norm1_g, 0, 1024, H, nullptr); } SEAM(1);
    if (IN(2)) {
        { pg8::Gemm g{H, (const bf16_t*)(F.ws + WS_WQK), MT, 2048, 1024}; pg8::StaticOrder S; S.init(MT, 2048, F.G, (int)blockIdx.x);
          pg8::EpiQK E{(bf16_t*)(F.ws + WS_QK), (float*)(F.ws + WS_KSUM), C2};
          pg8::gemm_phase<pg8::EpiQK, pg8::StaticOrder, true, true>(F.lds, g, S, E); }
        __syncthreads();
        { pg8::Gemm g{(const bf16_t*)(F.ws + WS_WV), H, 1024, MT, 1024}; pg8::StaticOrder S; S.init(1024, MT, F.G, (int)blockIdx.x);
          pg8::EpiVT E{(bf16_t*)(F.ws + WS_VT), MT};
          pg8::gemm_phase<pg8::EpiVT, pg8::StaticOrder, true, true>(F.lds, g, S, E); }
    } SEAM(2);
    if (IN(3)) { attn_phase(F); } SEAM(3);
    if (IN(4)) {
        const int pm = (int)blockIdx.x;
        float* scp = (float*)(F.ws + (pm < 192 ? WS_SCA + (size_t)pm * (2 * MiB) : WS_SCB + (size_t)(pm - 192) * (2 * MiB)));
        { pg8::Gemm g{(const bf16_t*)(F.ws + WS_AO), (const bf16_t*)(F.ws + WS_WO), MT, 1024, 1024}; pg8::PanelOrder S{pm, 4};
          pg8::EpiRes E{F.x, (bf16_t*)F.out, (const float*)(F.ws + WS_MOD)};
          pg8::gemm_phase<pg8::EpiRes, pg8::PanelOrder, true, true>(F.lds, g, S, E); }
        __syncthreads();
        norm_phase<true>(F, F.out, F.norm2_g, 3072, 4096, H, F.ws + WS_H8);
        asm volatile("s_waitcnt vmcnt(0)" ::: "memory"); __syncthreads();
        { pg8::Gemm g{H, (const bf16_t*)(F.ws + WS_WC), MT, 2048, 1024}; pg8::PanelOrder S{pm, 8};
          pg8::EpiSC E{scp};
          pg8::gemm_phase<pg8::EpiSC, pg8::PanelOrder, true, true>(F.lds, g, S, E); }
        __syncthreads();
        topk_panel(F, scp, pm);
    } SEAM(4);
    if (IN(5)) { peer_u_phase(F); } SEAM(5);
    if (IN(6)) { peer_w_phase(F); } SEAM(6);
    if (IN(7)) { peer_v_phase(F); } SEAM(7);
    if (IN(8)) { final_phase(F); }
#undef IN
#undef SEAM
}

extern "C" void kernel_launch(void* const* d_in, const int* in_sizes, int n_in, void* d_out, int out_size, void* d_ws, size_t ws_size, hipStream_t stream) {
    static int grid = 0;
    if (grid == 0) {
        if (n_in != 16 || in_sizes[0] != MT * DM || out_size != MT * DM || ws_size < WS_END) { fprintf(stderr, "kernel_launch: unexpected shapes (n_in %d, in0 %d, out %d, ws %zu); nothing launched\n", n_in, n_in > 0 ? in_sizes[0] : -1, out_size, ws_size); grid = -1; return; }
        int dev = 0, cus = 0, per_cu = 0;
        if (hipGetDevice(&dev) != hipSuccess || hipDeviceGetAttribute(&cus, hipDeviceAttributeMultiprocessorCount, dev) != hipSuccess) { grid = -1; return; }
        if (hipFuncSetAttribute((const void*)mk_fwd, hipFuncAttributeMaxDynamicSharedMemorySize, LDS_BYTES) != hipSuccess) { fprintf(stderr, "kernel_launch: hipFuncSetAttribute failed\n"); grid = -1; return; }
        if (hipOccupancyMaxActiveBlocksPerMultiprocessor(&per_cu, (const void*)mk_fwd, 512, LDS_BYTES) != hipSuccess || per_cu < 1) fprintf(stderr, "kernel_launch: note: occupancy query reports %d\n", per_cu);
        (void)hipGetLastError();
        grid = cus;
        if (grid != 256) { fprintf(stderr, "kernel_launch: built for a 256-CU device (one 256-row panel per workgroup in the fused phase); found %d CUs; nothing launched\n", cus); grid = -1; return; }
    }
    if (grid < 0) return;
    if (hipMemsetAsync((char*)d_ws + WS_CTL, 0, CTL_ZERO_BYTES, stream) != hipSuccess) return;
    Args a{};
    for (int i = 0; i < 16; ++i) a.in[i] = (const float*)d_in[i];
    a.out = (float*)d_out; a.ws = (unsigned char*)d_ws;
#if MK_N_LAUNCHES == 1
    a.ph_lo = 0; a.ph_hi = N_PHASES;
    hipLaunchKernelGGL(mk_fwd, dim3(grid), dim3(512), LDS_BYTES, stream, a);
#else
    for (int p = 0; p < N_PHASES; ++p) { a.ph_lo = p; a.ph_hi = p + 1; hipLaunchKernelGGL(mk_fwd, dim3(grid), dim3(512), LDS_BYTES, stream, a); }
#endif
}
```

```cpp
#include <hip/hip_runtime.h>
#include <type_traits>
#include <cstdio>
#include <cstdint>
#include <cmath>

#define LAS __attribute__((address_space(3)))
#define GAS __attribute__((address_space(1)))

constexpr int NB = 16, SEQ = 4096, DM = 1024, MT = NB * SEQ;
constexpr float NORM_EPS = 1e-6f, LOG2E = 1.4426950408889634f, C2 = 0.125f * LOG2E, NEGBIG = -1e30f;
constexpr int QKW = 2048;
constexpr int NEXP = 16384;

namespace pg8 {
#define PG8_LAS __attribute__((address_space(3)))
typedef unsigned short bf16_t;
typedef short bf16x8 __attribute__((ext_vector_type(8)));
typedef float f32x4 __attribute__((ext_vector_type(4)));
typedef unsigned u32x4 __attribute__((ext_vector_type(4)));
constexpr int BM = 256, BK = 64, HALF = 128, HTB = HALF * BK * 2  , STAGE_BYTES = 8 * HTB, NXCD = 8, WGM = 8;

__host__ __device__ __forceinline__ int lds_byte(int r, int c) { const int st = (r >> 4) * 2 + (c >> 5), rr = r & 15, cc = c & 31, ob = rr * 64 + cc * 2; return st * 1024 + (ob ^ (((ob >> 9) & 1) << 5)); }
__host__ __device__ __forceinline__ void stage_rc(int b, int& R, int& C) { const int st = b / 1024, sb = b % 1024, swz = sb ^ (((sb >> 9) & 1) << 5); R = (st >> 1) * 16 + swz / 64; C = (st & 1) * 32 + (swz % 64) / 2; }
__host__ __device__ __forceinline__ int perm32(int rho) { const int n = rho >> 4, i = rho & 15; return 8 * (i >> 2) + 4 * n + (i & 3); }

struct Unit { int pm, pn; };
struct Gemm { const bf16_t* A; const bf16_t* Bt; int M, N, K; };

struct StaticOrder {
    int nM, nN, nwg, G, c;
    __host__ __device__ void init(int M, int N, int G_, int c_) { nM = M / BM; nN = N / BM; nwg = nM * nN; G = G_; c = c_; }
    __host__ __device__ bool next(int i, Unit& u) const {
        const long L = (long)i * G + c; if (L >= nwg) return false;
        int wgid = (int)L; { const int q = nwg / NXCD, r = nwg % NXCD, xcd = wgid % NXCD, off = wgid / NXCD; wgid = (xcd < r ? xcd * (q + 1) : r * (q + 1) + (xcd - r) * q) + off; }
        const int nig = WGM * nN, gid = wgid / nig, fm = gid * WGM, gsz = (nM - fm) < WGM ? (nM - fm) : WGM;
        u.pm = fm + ((wgid % nig) % gsz); u.pn = (wgid % nig) / gsz; return true;
    }
    __device__ __forceinline__ void a_ready(const Unit&) const {}
    __device__ __forceinline__ void done(const Unit&) const {}
};

struct PanelOrder {
    int pm, n;
    __host__ __device__ bool next(int i, Unit& u) const { if (i >= n) return false; u.pm = pm; u.pn = i; return true; }
    __device__ __forceinline__ void a_ready(const Unit&) const {}
    __device__ __forceinline__ void done(const Unit&) const {}
};

typedef float f32x2 __attribute__((ext_vector_type(2)));
typedef unsigned u32x2 __attribute__((ext_vector_type(2)));
typedef __bf16 bf16x2_t __attribute__((ext_vector_type(2)));
__device__ __forceinline__ unsigned cvt_pk_bf16(float lo, float hi) { f32x2 v = {lo, hi}; bf16x2_t b = __builtin_convertvector(v, bf16x2_t); return __builtin_bit_cast(unsigned, b); }

struct EpiBf16 {
    static constexpr bool PERM = true, AFTER_DRAIN = false;
    bf16_t* O; int ldc;
    __device__ __forceinline__ void operator()(const f32x4 (&acc)[2][2][4][2], const Unit& u, int wr, int wc, int fr, int fq) const {
        const int row0 = u.pm * BM + wr * 64 + fr; const int col0 = u.pn * BM + wc * 32 + 8 * fq;
#pragma unroll
        for (int ai = 0; ai < 2; ++ai)
#pragma unroll
            for (int m = 0; m < 4; ++m) { bf16_t* rowp = O + (size_t)(row0 + ai * HALF + m * 16) * ldc + col0;
#pragma unroll
                for (int bj = 0; bj < 2; ++bj) { const f32x4 v0 = acc[ai][bj][m][0], v1 = acc[ai][bj][m][1];
                    u32x4 w; w.x = cvt_pk_bf16(v0[0], v0[1]); w.y = cvt_pk_bf16(v0[2], v0[3]); w.z = cvt_pk_bf16(v1[0], v1[1]); w.w = cvt_pk_bf16(v1[2], v1[3]);
                    *(u32x4*)(rowp + bj * HALF) = w; } }
    }
};
struct EpiVT {
    static constexpr bool PERM = true, AFTER_DRAIN = false;
    bf16_t* O; int ldc;
    __device__ __forceinline__ void operator()(const f32x4 (&acc)[2][2][4][2], const Unit& u, int wr, int wc, int fr, int fq) const {
        const int row0 = u.pm * BM + wr * 64 + fr; const int col0 = u.pn * BM + wc * 32 + 16 * (fq >> 1) + 4 * (fq & 1);
#pragma unroll
        for (int ai = 0; ai < 2; ++ai)
#pragma unroll
            for (int m = 0; m < 4; ++m) { bf16_t* rowp = O + (size_t)(row0 + ai * HALF + m * 16) * ldc + col0;
#pragma unroll
                for (int bj = 0; bj < 2; ++bj) { const f32x4 v0 = acc[ai][bj][m][0], v1 = acc[ai][bj][m][1];
                    u32x2 w0, w1; w0.x = cvt_pk_bf16(v0[0], v0[1]); w0.y = cvt_pk_bf16(v0[2], v0[3]); w1.x = cvt_pk_bf16(v1[0], v1[1]); w1.y = cvt_pk_bf16(v1[2], v1[3]);
                    *(u32x2*)(rowp + bj * HALF) = w0; *(u32x2*)(rowp + bj * HALF + 8) = w1; } }
    }
};
struct EpiQK {
    static constexpr bool PERM = true, AFTER_DRAIN = false;
    bf16_t* O; float* ksum; float qscale;
    __device__ __forceinline__ void operator()(const f32x4 (&acc)[2][2][4][2], const Unit& u, int wr, int wc, int fr, int fq) const {
        const int row0 = u.pm * BM + wr * 64 + fr; const int col0 = u.pn * BM + wc * 32 + 8 * fq;
        const float sc = (u.pn < 2 || (u.pn >= 4 && u.pn < 6)) ? qscale : 1.f;
#pragma unroll
        for (int ai = 0; ai < 2; ++ai)
#pragma unroll
            for (int m = 0; m < 4; ++m) { bf16_t* rowp = O + (size_t)(row0 + ai * HALF + m * 16) * 2048 + col0;
#pragma unroll
                for (int bj = 0; bj < 2; ++bj) { const f32x4 v0 = acc[ai][bj][m][0] * sc, v1 = acc[ai][bj][m][1] * sc;
                    u32x4 w; w.x = cvt_pk_bf16(v0[0], v0[1]); w.y = cvt_pk_bf16(v0[2], v0[3]); w.z = cvt_pk_bf16(v1[0], v1[1]); w.w = cvt_pk_bf16(v1[2], v1[3]);
                    *(u32x4*)(rowp + bj * HALF) = w; } }
        if (u.pn >= 6) {
            float* kdst = ksum + (size_t)u.pm * 512 + (u.pn - 6) * BM + wc * 32 + 8 * fq;
#pragma unroll
            for (int bj = 0; bj < 2; ++bj)
#pragma unroll
                for (int n = 0; n < 2; ++n)
#pragma unroll
                    for (int e = 0; e < 4; ++e) {
                        float s = 0.f;
#pragma unroll
                        for (int ai = 0; ai < 2; ++ai)
#pragma unroll
                            for (int m = 0; m < 4; ++m) s += acc[ai][bj][m][n][e];
                        s += __shfl_xor(s, 1); s += __shfl_xor(s, 2); s += __shfl_xor(s, 4); s += __shfl_xor(s, 8);
                        if (fr == 0) atomicAdd(kdst + bj * HALF + 4 * n + e, s);
                    }
        }
    }
};
struct EpiRes {
    static constexpr bool PERM = false, AFTER_DRAIN = false;
    const float* x; bf16_t* out; const float* mod;
    __device__ __forceinline__ void operator()(const f32x4 (&acc)[2][2][4][2], const Unit& u, int wr, int wc, int fr, int fq) const { asm volatile("" : "+v"(fr));
        const int row0 = u.pm * BM + wr * 64 + fr; const int col0 = u.pn * BM + wc * 32 + 4 * fq;
        const float* g1 = mod + (size_t)(u.pm >> 4) * 6144 + 2048 + col0;
        f32x4 gv[2][2];
#pragma unroll
        for (int bj = 0; bj < 2; ++bj)
#pragma unroll
            for (int n = 0; n < 2; ++n) gv[bj][n] = *(const f32x4*)(g1 + bj * HALF + n * 16);
#pragma unroll
        for (int ai = 0; ai < 2; ++ai)
#pragma unroll
            for (int m = 0; m < 4; ++m) { const size_t off = (size_t)(row0 + ai * HALF + m * 16) * 1024 + col0;
#pragma unroll
                for (int bj = 0; bj < 2; ++bj)
#pragma unroll
                    for (int n = 0; n < 2; ++n) { const f32x4 xv = *(const f32x4*)(x + off + bj * HALF + n * 16);
                        const f32x4 y = xv + gv[bj][n] * acc[ai][bj][m][n]; u32x2 w; w.x = cvt_pk_bf16(y[0], y[1]); w.y = cvt_pk_bf16(y[2], y[3]);
                        *(u32x2*)(out + off + (size_t)(row0 + ai * HALF + m * 16) * 1024 + bj * HALF + n * 16) = w; } }
    }
};
typedef unsigned u32x2v __attribute__((ext_vector_type(2)));
struct EpiSC {
    static constexpr bool PERM = false, AFTER_DRAIN = false;
    float* P;
    __device__ __forceinline__ void operator()(const f32x4 (&acc)[2][2][4][2], const Unit& u, int wr, int wc, int fr, int fq) const { asm volatile("" : "+v"(fr));
        const int row0 = wr * 64 + fr; const int cg0 = u.pn * 64 + wc * 8 + fq;
#pragma unroll
        for (int ai = 0; ai < 2; ++ai)
#pragma unroll
            for (int m = 0; m < 4; ++m) { const int r = row0 + ai * HALF + m * 16;
#pragma unroll
                for (int bj = 0; bj < 2; ++bj)
#pragma unroll
                    for (int n = 0; n < 2; ++n) { const f32x4 a = acc[ai][bj][m][n];
                        *(u32x2v*)((char*)P + ((size_t)(cg0 + bj * 32 + n * 4) * 256 + r) * 8) = (u32x2v){__builtin_bit_cast(unsigned, __builtin_amdgcn_cvt_pkrtz(a[0], a[1])), __builtin_bit_cast(unsigned, __builtin_amdgcn_cvt_pkrtz(a[2], a[3]))}; } }
    }
};
struct EpiF32 {
    static constexpr bool PERM = false, AFTER_DRAIN = false;
    float* O; int ldc;
    __device__ __forceinline__ void operator()(const f32x4 (&acc)[2][2][4][2], const Unit& u, int wr, int wc, int fr, int fq) const {
        const int row0 = u.pm * BM + wr * 64 + fr; const int col0 = u.pn * BM + wc * 32 + 4 * fq;
#pragma unroll
        for (int ai = 0; ai < 2; ++ai)
#pragma unroll
            for (int m = 0; m < 4; ++m) { const size_t off = (size_t)(row0 + ai * HALF + m * 16) * ldc + col0;
#pragma unroll
                for (int bj = 0; bj < 2; ++bj)
#pragma unroll
                    for (int n = 0; n < 2; ++n) *(f32x4*)(O + off + bj * HALF + n * 16) = acc[ai][bj][m][n]; }
    }
};

template <class Epi, class Sched, bool ALIGN_EPI = false, bool SP2 = false>
__device__ __forceinline__ void gemm_phase(PG8_LAS unsigned char* lds, const Gemm g, const Sched& S, const Epi& E) {
    const int tid = threadIdx.x, wid = __builtin_amdgcn_readfirstlane(tid >> 6), lane = tid & 63, wr = wid >> 2, wc = wid & 3, fr = lane & 15, fq = lane >> 4;
    const int K = g.K, nt = K / BK;
    unsigned voffA[2], voffB[2];
#pragma unroll
    for (int i = 0; i < 2; ++i) { int R, C; stage_rc(tid * 16 + i * 8192, R, C); const int Rb = Epi::PERM ? ((R & ~31) + perm32(R & 31)) : R;
        voffA[i] = (unsigned)(R * K + C) * 2u; voffB[i] = (unsigned)(Rb * K + C) * 2u; }
    const size_t kstep = (size_t)(BK * 2);
    const size_t hstep = (size_t)HALF * K * 2;
    const size_t tstep = 2 * hstep;
    const unsigned ldsw = (unsigned)wid * 1024u;
    const int aoff = lds_byte(wr * 64 + fr, fq * 8), boff = lds_byte(wc * 32 + fr, fq * 8);
#define PG8_SA(b, h) (((b) * 2 + (h)) * HTB)
#define PG8_SB(b, h) ((4 + (b) * 2 + (h)) * HTB)
#define PG8_STAGE(bufoff, gbase, voff) do { _Pragma("unroll") for (int _i = 0; _i < 2; ++_i) \
        __builtin_amdgcn_global_load_lds((const unsigned*)((const char*)(gbase) + (voff)[_i]), (PG8_LAS unsigned*)(lds + (bufoff) + ldsw + _i * 8192), 16, 0, 0); } while (0)
#define PG8_LDA(dst, b, h) do { _Pragma("unroll") for (int m = 0; m < 4; ++m) _Pragma("unroll") for (int k = 0; k < 2; ++k) dst[m][k] = *(const PG8_LAS bf16x8*)(lds + PG8_SA(b, h) + aoff + m * 2048 + k * 1024); } while (0)
#define PG8_LDB(dst, b, h) do { _Pragma("unroll") for (int n = 0; n < 2; ++n) _Pragma("unroll") for (int k = 0; k < 2; ++k) dst[n][k] = *(const PG8_LAS bf16x8*)(lds + PG8_SB(b, h) + boff + n * 2048 + k * 1024); } while (0)
#define PG8_MMA(ai, bj, At, Bt) do { __builtin_amdgcn_s_setprio(1); _Pragma("unroll") for (int m = 0; m < 4; ++m) _Pragma("unroll") for (int n = 0; n < 2; ++n) _Pragma("unroll") for (int k = 0; k < 2; ++k) \
        acc[ai][bj][m][n] = __builtin_amdgcn_mfma_f32_16x16x32_bf16(Bt[n][k], At[m][k], acc[ai][bj][m][n], 0, 0, 0); __builtin_amdgcn_s_setprio(0); } while (0)
#define PG8_WAIT_V(n) asm volatile("s_waitcnt vmcnt(" #n ")" ::: "memory")
#define PG8_WAIT_L(n) asm volatile("s_waitcnt lgkmcnt(" #n ")" ::: "memory")
#define PG8_BAR __builtin_amdgcn_s_barrier()
#define PG8_SCHED __builtin_amdgcn_sched_barrier(0)
    Unit cur, nxt; int ui = 0;
    if (!S.next(0, cur)) return;
    f32x4 acc[2][2][4][2];
#pragma unroll
    for (int a = 0; a < 2; ++a)
#pragma unroll
        for (int b = 0; b < 2; ++b)
#pragma unroll
            for (int m = 0; m < 4; ++m)
#pragma unroll
                for (int n = 0; n < 2; ++n) acc[a][b][m][n] = (f32x4){0.f, 0.f, 0.f, 0.f};
    bf16x8 At[4][2], B0[2][2], B1[2][2];
    const char* cA = (const char*)g.A + (size_t)cur.pm * tstep; const char* cB = (const char*)g.Bt + (size_t)cur.pn * tstep;
    S.a_ready(cur);
    if constexpr (SP2) {
        PG8_STAGE(PG8_SB(0, 0), cB, voffB); PG8_STAGE(PG8_SB(0, 1), cB + hstep, voffB); PG8_STAGE(PG8_SA(0, 0), cA, voffA); PG8_STAGE(PG8_SA(0, 1), cA + hstep, voffA);
        if (wr == 1) PG8_BAR;
        PG8_WAIT_V(2); PG8_BAR;
        PG8_STAGE(PG8_SB(1, 0), cB + kstep, voffB); PG8_STAGE(PG8_SA(1, 0), cA + kstep, voffA); PG8_STAGE(PG8_SB(1, 1), cB + hstep + kstep, voffB);
        PG8_WAIT_V(6); PG8_BAR;
    } else {
        PG8_STAGE(PG8_SB(0, 0), cB, voffB); PG8_STAGE(PG8_SA(0, 0), cA, voffA); PG8_STAGE(PG8_SB(0, 1), cB + hstep, voffB); PG8_STAGE(PG8_SA(0, 1), cA + hstep, voffA);
        if (wr == 1) PG8_BAR;
        PG8_WAIT_V(4); PG8_BAR;
        PG8_STAGE(PG8_SB(1, 0), cB + kstep, voffB); PG8_STAGE(PG8_SA(1, 0), cA + kstep, voffA); PG8_STAGE(PG8_SB(1, 1), cB + hstep + kstep, voffB);
        PG8_WAIT_V(6); PG8_BAR;
    }
    for (;;) {
        const bool has_next = S.next(ui + 1, nxt);
        const char* nA = has_next ? (const char*)g.A + (size_t)nxt.pm * tstep : cA; const char* nB = has_next ? (const char*)g.Bt + (size_t)nxt.pn * tstep : cB;
        for (int t = 0; t < nt; t += 2) {
            const bool last = (t == nt - 2);
            const char* a1 = cA + (size_t)(t + 1) * kstep;
            const char* a2 = last ? nA : cA + (size_t)(t + 2) * kstep; const char* b2 = last ? nB : cB + (size_t)(t + 2) * kstep;
            const char* a3 = a2 + kstep; const char* b3 = b2 + kstep;
            if (last && has_next) S.a_ready(nxt);
            if constexpr (SP2) {
            PG8_LDB(B0, 0, 0); PG8_LDB(B1, 0, 1); PG8_SCHED; PG8_LDA(At, 0, 0); PG8_STAGE(PG8_SA(1, 1), a1 + hstep, voffA);
            PG8_WAIT_V(8); PG8_WAIT_L(0); PG8_BAR; PG8_MMA(0, 0, At, B0); PG8_MMA(0, 1, At, B1); PG8_BAR; PG8_SCHED;
            PG8_LDA(At, 0, 1); PG8_STAGE(PG8_SB(0, 0), b2, voffB); PG8_STAGE(PG8_SB(0, 1), b2 + hstep, voffB); PG8_STAGE(PG8_SA(0, 0), a2, voffA);
            PG8_WAIT_V(8); PG8_WAIT_L(0); PG8_BAR; PG8_MMA(1, 0, At, B0); PG8_MMA(1, 1, At, B1); PG8_BAR; PG8_SCHED;
            PG8_LDB(B0, 1, 0); PG8_LDB(B1, 1, 1); PG8_SCHED; PG8_LDA(At, 1, 0); PG8_STAGE(PG8_SA(0, 1), a2 + hstep, voffA);
            PG8_WAIT_V(8); PG8_WAIT_L(0); PG8_BAR; PG8_MMA(0, 0, At, B0); PG8_MMA(0, 1, At, B1); PG8_BAR; PG8_SCHED;
            PG8_LDA(At, 1, 1); PG8_STAGE(PG8_SB(1, 0), b3, voffB); PG8_STAGE(PG8_SB(1, 1), b3 + hstep, voffB); PG8_STAGE(PG8_SA(1, 0), a3, voffA);
            PG8_WAIT_V(8); PG8_WAIT_L(0); PG8_BAR; PG8_MMA(1, 0, At, B0); PG8_MMA(1, 1, At, B1); PG8_BAR; PG8_SCHED;
            } else {
            PG8_LDB(B0, 0, 0); PG8_SCHED; PG8_LDA(At, 0, 0); PG8_STAGE(PG8_SA(1, 1), a1 + hstep, voffA);
            PG8_WAIT_L(8); PG8_BAR; PG8_WAIT_L(0); PG8_MMA(0, 0, At, B0); PG8_BAR; PG8_SCHED;
            PG8_LDB(B1, 0, 1); PG8_STAGE(PG8_SB(0, 0), b2, voffB);
            PG8_BAR; PG8_WAIT_L(0); PG8_MMA(0, 1, At, B1); PG8_BAR;
            PG8_LDA(At, 0, 1); PG8_STAGE(PG8_SA(0, 0), a2, voffA);
            PG8_BAR; PG8_WAIT_L(0); PG8_MMA(1, 0, At, B0); PG8_BAR; PG8_SCHED;
            PG8_STAGE(PG8_SB(0, 1), b2 + hstep, voffB);
            PG8_WAIT_V(6); PG8_BAR; PG8_MMA(1, 1, At, B1); PG8_BAR;
            PG8_LDB(B0, 1, 0); PG8_SCHED; PG8_LDA(At, 1, 0); PG8_STAGE(PG8_SA(0, 1), a2 + hstep, voffA);
            PG8_WAIT_L(8); PG8_BAR; PG8_WAIT_L(0); PG8_MMA(0, 0, At, B0); PG8_BAR; PG8_SCHED;
            PG8_LDB(B1, 1, 1); PG8_STAGE(PG8_SB(1, 0), b3, voffB);
            PG8_BAR; PG8_WAIT_L(0); PG8_MMA(0, 1, At, B1); PG8_BAR;
            PG8_LDA(At, 1, 1); PG8_STAGE(PG8_SA(1, 0), a3, voffA);
            PG8_BAR; PG8_WAIT_L(0); PG8_MMA(1, 0, At, B0); PG8_BAR; PG8_SCHED;
            PG8_STAGE(PG8_SB(1, 1), b3 + hstep, voffB);
            PG8_WAIT_V(6); PG8_BAR; PG8_MMA(1, 1, At, B1); PG8_BAR;
            }
        }
        if constexpr (ALIGN_EPI) { if (wr == 0) PG8_BAR; }
        if constexpr (!Epi::AFTER_DRAIN) { E(acc, cur, wr, wc, fr, fq); S.done(cur); }
        if (!has_next) break;
#pragma unroll
        for (int a = 0; a < 2; ++a)
#pragma unroll
            for (int b = 0; b < 2; ++b)
#pragma unroll
                for (int m = 0; m < 4; ++m)
#pragma unroll
                    for (int n = 0; n < 2; ++n) acc[a][b][m][n] = (f32x4){0.f, 0.f, 0.f, 0.f};
        cur = nxt; cA = nA; cB = nB; ++ui;
        if constexpr (ALIGN_EPI) { if (wr == 1) PG8_BAR; }
    }
    PG8_WAIT_V(0);
    if constexpr (!ALIGN_EPI) { if (wr == 0) PG8_BAR; }
    PG8_BAR;
    if constexpr (Epi::AFTER_DRAIN) { E.fused(acc, cur, wr, wc, fr, fq, lds, wid, lane); S.done(cur); }
#undef PG8_SA
#undef PG8_SB
#undef PG8_STAGE
#undef PG8_LDA
#undef PG8_LDB
#undef PG8_MMA
#undef PG8_WAIT_V
#undef PG8_WAIT_L
#undef PG8_BAR
#undef PG8_SCHED
}
}

typedef unsigned short bf16_t;
typedef short bf16x8 __attribute__((ext_vector_type(8)));
typedef float f32x4 __attribute__((ext_vector_type(4)));
typedef float f32x16 __attribute__((ext_vector_type(16)));
typedef unsigned u32x4 __attribute__((ext_vector_type(4)));
typedef unsigned u32x2 __attribute__((ext_vector_type(2)));
typedef __bf16 bf16x2v __attribute__((ext_vector_type(2)));
#define LDS_WAIT() asm volatile("s_waitcnt lgkmcnt(0)" ::: "memory")
__device__ __forceinline__ unsigned pk2(float lo, float hi) { return pg8::cvt_pk_bf16(lo, hi); }
__device__ __forceinline__ float bf_lo(unsigned w) { return __uint_as_float(w << 16); }
__device__ __forceinline__ float bf_hi(unsigned w) { return __uint_as_float(w & 0xffff0000u); }
__device__ __forceinline__ float wave_sum(float v) {
#pragma unroll
    for (int o = 1; o < 64; o <<= 1) v += __shfl_xor(v, o);
    return v;
}
__device__ __forceinline__ float swap32_f(float v) {
    auto rr = __builtin_amdgcn_permlane32_swap(__float_as_uint(v), __float_as_uint(v), false, false);
    return (threadIdx.x & 32) ? __uint_as_float(rr[0]) : __uint_as_float(rr[1]);
}
__device__ __forceinline__ float dot2bf(unsigned a, unsigned b, float acc) { return __builtin_amdgcn_fdot2_f32_bf16(__builtin_bit_cast(bf16x2v, a), __builtin_bit_cast(bf16x2v, b), acc, false); }

constexpr size_t MiB = 1u << 20;
constexpr size_t WS_CTL = 0, CTL_ZERO_BYTES = 1 * MiB;
constexpr size_t WS_KSUM = 512 * 1024;
constexpr size_t WS_MOD = 1 * MiB;
constexpr size_t WS_WQK = 2 * MiB;
constexpr size_t WS_WV = 6 * MiB;
constexpr size_t WS_WO = 8 * MiB;
constexpr size_t WS_WC = 10 * MiB;
constexpr size_t WS_U8 = 16 * MiB, WS_V8 = 32 * MiB;
constexpr size_t WS_US = 51 * MiB;
constexpr size_t WS_WB = 52 * MiB;
constexpr size_t WS_VS = 50 * MiB;
constexpr size_t WS_H = 128 * MiB;
constexpr size_t WS_QK = 256 * MiB;
constexpr size_t WS_VT = 512 * MiB;
constexpr size_t WS_AO = 640 * MiB, WS_H8 = 640 * MiB, WS_Y = 640 * MiB;
constexpr size_t WS_SCA = 256 * MiB, WS_SCB = 832 * MiB;
constexpr size_t WS_PART = 256 * MiB;
constexpr size_t WS_PE = 960 * MiB, WS_PG = 976 * MiB;
constexpr size_t WS_END = 1008 * MiB;
constexpr int CW_BAR = 4096;

constexpr int LDS_BYTES = 163840, MISC_OFF = LDS_BYTES - 256;

#define XB_TMO      128
#define XB_XCNT(j)  (256  + 64 * (j))
#define XB_XSUB(j)  (1280 + 64 * (j))
#define XB_XGEN(j)  (2304 + 64 * (j))
#define XB_TOP      3328
#define XB_TOPGEN   3392
#define XCD_BAR_WORDS 3456
#define XB_SPIN_CAP (1u << 18)
__device__ __forceinline__ unsigned xb_ld(unsigned* p)              { return __hip_atomic_load(p, __ATOMIC_RELAXED, __HIP_MEMORY_SCOPE_AGENT); }
__device__ __forceinline__ unsigned xb_add(unsigned* p, unsigned v) { return __hip_atomic_fetch_add(p, v, __ATOMIC_RELAXED, __HIP_MEMORY_SCOPE_AGENT); }
__device__ __forceinline__ unsigned xb_xcc_id() { return (unsigned)__builtin_amdgcn_s_getreg((3 << 11) | 20) & 0xFu; }
#define XB_SPIN(cond, bar) do { unsigned _sp = 0; while (cond) { __builtin_amdgcn_s_sleep(1); \
    if ((++_sp & 255u) == 0u) { if (xb_ld(&(bar)[XB_TMO])) break; if (_sp > XB_SPIN_CAP) { atomicAdd(&(bar)[XB_TMO], 1u); break; } } } } while (0)
struct XcdBarrier { unsigned* bar; unsigned x; volatile LAS unsigned* st; };
__device__ __forceinline__ XcdBarrier xcd_barrier_post(unsigned* bar, volatile LAS unsigned* st) {
    XcdBarrier b; b.bar = bar; b.x = xb_xcc_id(); b.st = st;
    if (threadIdx.x == 0) (void)xb_add(&bar[XB_XCNT(b.x)], 1u);
    return b;
}
__device__ __forceinline__ void xcd_barrier_complete(unsigned* bar, unsigned x, unsigned& nloc, unsigned& nx) {
    const unsigned G = gridDim.x * gridDim.y * gridDim.z;
    unsigned sum, cnt, mine, sp = 0u;
    for (;;) {
        sum = 0u; cnt = 0u; mine = 0u;
#pragma unroll
        for (unsigned j = 0; j < 16; ++j) { const unsigned c = xb_ld(&bar[XB_XCNT(j)]); sum += c; cnt += (c > 0u) ? 1u : 0u; mine = (j == x) ? c : mine; }
        if (sum == G) break;
        __builtin_amdgcn_s_sleep(1);
        if ((++sp & 255u) == 0u) { if (xb_ld(&bar[XB_TMO])) break; if (sp > XB_SPIN_CAP) { atomicAdd(&bar[XB_TMO], 1u); break; } }
    }
    nloc = mine > 0u ? mine : 1u; nx = cnt > 0u ? cnt : 1u;
}
__device__ __forceinline__ void xcd_barrier(const XcdBarrier& b) {
    asm volatile("s_waitcnt vmcnt(0)" ::: "memory");
    __syncthreads();
    if (threadIdx.x == 0) {
        unsigned* bar = b.bar;
        __builtin_amdgcn_s_waitcnt(0);
        unsigned nloc = b.st[0], nx = b.st[1];
        if (nloc == 0u) { xcd_barrier_complete(bar, b.x, nloc, nx); b.st[0] = nloc; b.st[1] = nx; }
        const unsigned old = xb_add(&bar[XB_XSUB(b.x)], 1u);
        const unsigned gen = old / nloc;
        if (old + 1u == (gen + 1u) * nloc) {
            __builtin_amdgcn_fence(__ATOMIC_RELEASE, "agent");
            asm volatile("s_waitcnt vmcnt(0)" ::: "memory");
            const unsigned og = xb_add(&bar[XB_TOP], 1u);
            const unsigned tg = og / nx;
            if (og + 1u == (tg + 1u) * nx) xb_add(&bar[XB_TOPGEN], 1u);
            else XB_SPIN(xb_ld(&bar[XB_TOPGEN]) == tg, bar);
            __builtin_amdgcn_fence(__ATOMIC_ACQUIRE, "agent");
            xb_add(&bar[XB_XGEN(b.x)], 1u);
            asm volatile("s_waitcnt vmcnt(0)" ::: "memory");
        } else {
            XB_SPIN(xb_ld(&bar[XB_XGEN(b.x)]) == gen, bar);
            __builtin_amdgcn_fence(__ATOMIC_ACQUIRE, "agent");
            asm volatile("s_waitcnt vmcnt(0)" ::: "memory");
        }
    }
    __syncthreads();
}

struct Frame {
    LAS unsigned char* lds;
    int tid, lane, wave, vcu, G;
    const float *x, *c, *rel_bias, *w_ada, *b_ada, *norm1_g, *w_in, *diff_lambda, *subln_g, *w_out, *norm2_g, *peer_wq, *peer_keys, *peer_u, *peer_v, *final_g;
    float* out; unsigned char* ws;
};

__device__ __forceinline__ void p0_transpose_item(const float* W, int K, int N, bf16_t* WT, int row_off, LAS float* scr, int item, int lane) {
    const int nblk = N / 32, kb = item / nblk, nb = item % nblk, k0 = 64 * kb, n0 = 32 * nb;
#pragma unroll 8
    for (int i = 0; i < 32; ++i) { const int kk = 2 * i + (lane >> 5); scr[kk * 33 + (lane & 31)] = W[(size_t)(k0 + kk) * N + n0 + (lane & 31)]; }
    LDS_WAIT(); asm volatile("" ::: "memory");
    const int c = lane & 7;
#pragma unroll
    for (int j = 0; j < 4; ++j) { const int n = (lane >> 3) + 8 * j; const LAS float* s = scr + (8 * c) * 33 + n;
        u32x4 o; o.x = pk2(s[0 * 33], s[1 * 33]); o.y = pk2(s[2 * 33], s[3 * 33]); o.z = pk2(s[4 * 33], s[5 * 33]); o.w = pk2(s[6 * 33], s[7 * 33]);
        *(u32x4*)(WT + (size_t)(row_off + n0 + n) * K + k0 + 8 * c) = o; }
    LDS_WAIT(); asm volatile("" ::: "memory");
}
__device__ __forceinline__ void p0_prologue(Frame& F) {
    const int tid = F.tid, lane = F.lane, wave = F.wave;
    float* mod = (float*)(F.ws + WS_MOD);
    for (int it = blockIdx.x; it < 96; it += F.G) {
        LAS float* sc = (LAS float*)F.lds;
        LAS float* red = (LAS float*)(F.lds + 65536);
        for (int idx = tid; idx < 16384; idx += 512) { const int b = idx >> 10, k = idx & 1023; const float v = F.c[idx]; sc[k * 16 + b] = v / (1.f + __expf(-v)); }
        __syncthreads();
        const int n0 = it * 64;
        float acc[16];
#pragma unroll
        for (int b = 0; b < 16; ++b) acc[b] = 0.f;
        const float* wp = F.w_ada + (size_t)(wave * 128) * 6144 + n0 + lane;
#pragma unroll 4
        for (int k = 0; k < 128; ++k) {
            const float wv = wp[(size_t)k * 6144];
            const LAS f32x4* s4 = (const LAS f32x4*)(sc + (wave * 128 + k) * 16);
#pragma unroll
            for (int q = 0; q < 4; ++q) { const f32x4 s = s4[q]; acc[4 * q + 0] += s[0] * wv; acc[4 * q + 1] += s[1] * wv; acc[4 * q + 2] += s[2] * wv; acc[4 * q + 3] += s[3] * wv; }
        }
#pragma unroll
        for (int b = 0; b < 16; ++b) red[(wave * 16 + b) * 64 + lane] = acc[b];
        __syncthreads();
        for (int o = tid; o < 1024; o += 512) { const int b = o >> 6, ln = o & 63; float s = F.b_ada[n0 + ln];
#pragma unroll
            for (int w = 0; w < 8; ++w) s += red[(w * 16 + b) * 64 + ln];
            mod[b * 6144 + n0 + ln] = s; }
        __syncthreads();
    }
    for (int it = blockIdx.x; it < 256; it += F.G) {
        const int g = it >> 4, k0 = (it & 15) * 64;
        LAS float* KK = (LAS float*)F.lds;
        LAS float* AA = (LAS float*)(F.lds + 67584);
#pragma unroll
        for (int i = 0; i < 8; ++i) { const int idx = tid * 4 + 2048 * i, n = idx >> 7, d = idx & 127; *(LAS f32x4*)(KK + n * 132 + d) = *(const f32x4*)(F.peer_keys + (size_t)g * 16384 + idx); }
#pragma unroll
        for (int i = 0; i < 4; ++i) { const int idx = tid * 4 + 2048 * i, r = idx >> 7, d = idx & 127; *(LAS f32x4*)(AA + r * 132 + d) = *(const f32x4*)(F.peer_wq + (size_t)(k0 + r) * 2048 + g * 128 + d); }
        __syncthreads();
        const int kk = tid & 63, nq = wave;
        float acc[16];
#pragma unroll
        for (int j = 0; j < 16; ++j) acc[j] = 0.f;
        for (int d4 = 0; d4 < 32; ++d4) {
            const f32x4 a = *(const LAS f32x4*)(AA + kk * 132 + 4 * d4);
#pragma unroll
            for (int j = 0; j < 16; ++j) { const f32x4 kv = *(const LAS f32x4*)(KK + (nq * 16 + j) * 132 + 4 * d4); acc[j] += a[0] * kv[0] + a[1] * kv[1] + a[2] * kv[2] + a[3] * kv[3]; }
        }
        bf16_t* wc = (bf16_t*)(F.ws + WS_WC);
#pragma unroll
        for (int j = 0; j < 16; ++j) wc[(size_t)(g * 128 + nq * 16 + j) * 1024 + k0 + kk] = (bf16_t)(pk2(acc[j], 0.f) & 0xffffu);
        __syncthreads();
    }
    {
        LAS float* scr = (LAS float*)(F.lds + wave * 8448);
        const int gw = F.vcu * 8 + wave, NGW = F.G * 8;
        bf16_t* wqk = (bf16_t*)(F.ws + WS_WQK); bf16_t* wv = (bf16_t*)(F.ws + WS_WV); bf16_t* wo = (bf16_t*)(F.ws + WS_WO);
        constexpr int I_IN = 16 * 96, I_O = 16 * 32;
        for (int it = gw; it < I_IN + I_O; it += NGW) {
            if (it < I_IN) {
                const int nb = it % 96, n0 = nb * 32;
                if (n0 < 1024) p0_transpose_item(F.w_in, 1024, 3072, wqk, 0, scr, it, lane);
                else if (n0 < 1536) p0_transpose_item(F.w_in, 1024, 3072, wv, -1024, scr, it, lane);
                else if (n0 < 2560) p0_transpose_item(F.w_in, 1024, 3072, wqk, -512, scr, it, lane);
                else p0_transpose_item(F.w_in, 1024, 3072, wv, -2048, scr, it, lane);
            } else p0_transpose_item(F.w_out, 1024, 1024, wo, 0, scr, it - I_IN, lane);
        }
    }
    {
        const int gw = F.vcu * 8 + wave, NGW = F.G * 8;
        float* us = (float*)(F.ws + WS_US);
        for (int e = gw; e < NEXP; e += NGW) {
            const f32x4* src = (const f32x4*)(F.peer_u + (size_t)e * 1024 + lane * 16);
            f32x4 a[4]; float mx = 0.f;
#pragma unroll
            for (int q = 0; q < 4; ++q) { a[q] = src[q]; mx = fmaxf(mx, fmaxf(fmaxf(fabsf(a[q][0]), fabsf(a[q][1])), fmaxf(fabsf(a[q][2]), fabsf(a[q][3])))); }
#pragma unroll
            for (int o = 1; o < 64; o <<= 1) mx = fmaxf(mx, __shfl_xor(mx, o));
            const float sc = mx > 0.f ? mx * (0.9f / 6.f) : 1.f, inv = 1.f / sc;
            if (lane == 0) us[e] = sc;
            unsigned w[2] = {0u, 0u};
#pragma unroll
            for (int q = 0; q < 4; ++q)
#pragma unroll
                for (int k = 0; k < 4; ++k) {
                    const float v = a[q][k], t = fabsf(v) * inv;
                    unsigned code = (t > 0.25f) + (t > 0.75f) + (t > 1.25f) + (t > 1.75f) + (t > 2.5f) + (t > 3.5f) + (t > 5.0f);
                    code |= (v < 0.f) ? 8u : 0u;
                    const int el = q * 4 + k;
                    w[el >> 3] |= code << (4 * (el & 7));
                }
            *(u32x2*)(F.ws + WS_U8 + (size_t)(lane >> 4) * (NEXP * 128) + (size_t)e * 128 + (lane & 15) * 8) = (u32x2){w[0], w[1]};
        }
    }
    {
        const int gw = F.vcu * 8 + wave, NGW = F.G * 8;
        float* vs = (float*)(F.ws + WS_VS);
        for (int e = gw; e < NEXP; e += NGW) {
            const f32x4* src = (const f32x4*)(F.peer_v + (size_t)e * 1024 + lane * 16);
            f32x4 a[4]; float mx = 0.f;
#pragma unroll
            for (int q = 0; q < 4; ++q) { a[q] = src[q]; mx = fmaxf(mx, fmaxf(fmaxf(fabsf(a[q][0]), fabsf(a[q][1])), fmaxf(fabsf(a[q][2]), fabsf(a[q][3])))); }
#pragma unroll
            for (int o = 1; o < 64; o <<= 1) mx = fmaxf(mx, __shfl_xor(mx, o));
            const float sc = mx > 0.f ? mx * (0.9f / 6.f) : 1.f, inv = 1.f / sc;
            if (lane == 0) vs[e] = sc;
            unsigned w[2] = {0u, 0u};
#pragma unroll
            for (int q = 0; q < 4; ++q)
#pragma unroll
                for (int k = 0; k < 4; ++k) {
                    const float v = a[q][k], t = fabsf(v) * inv;
                    unsigned code = (t > 0.25f) + (t > 0.75f) + (t > 1.25f) + (t > 1.75f) + (t > 2.5f) + (t > 3.5f) + (t > 5.0f);
                    code |= (v < 0.f) ? 8u : 0u;
                    const int el = q * 4 + k;
                    w[el >> 3] |= code << (4 * (el & 7));
                }
            unsigned o2[2] = {0u, 0u}; const int nn = lane & 15, gb = lane & 48;
#pragma unroll
            for (int j = 0; j < 16; ++j) { const unsigned w0 = __shfl(w[0], gb + j), w1 = __shfl(w[1], gb + j); const unsigned nib = (((nn < 8) ? w0 : w1) >> (4 * (nn & 7))) & 15u; o2[j >> 3] |= nib << (4 * (j & 7)); }
            *(u32x2*)(F.ws + WS_V8 + (size_t)(lane >> 4) * (NEXP * 128) + (size_t)e * 128 + (lane & 15) * 8) = (u32x2){o2[0], o2[1]};
        }
    }
}

template <bool WITH8> __device__ __forceinline__ void norm_phase(Frame& F, const float* xin, const float* g, int sh_off, int sc_off, bf16_t* H, unsigned char* H8) {
    const float* mod = (const float*)(F.ws + WS_MOD);
    for (int tile = blockIdx.x; tile < MT / 256; tile += F.G) {
        const int b = tile >> 4, r0 = tile * 256 + F.wave * 32;
        f32x4 A[4], Bv[4];
#pragma unroll
        for (int j = 0; j < 4; ++j) { const int cix = 4 * F.lane + 256 * j;
            const f32x4 gg = *(const f32x4*)(g + cix), sc = *(const f32x4*)(mod + b * 6144 + sc_off + cix);
            A[j] = gg * (sc + 1.0f); Bv[j] = *(const f32x4*)(mod + b * 6144 + sh_off + cix); }
#pragma unroll 2
        for (int rr = 0; rr < 32; ++rr) {
            const float* xr = xin + (size_t)(r0 + rr) * 1024 + 4 * F.lane;
            f32x4 v[4]; float s = 0.f;
#pragma unroll
            for (int j = 0; j < 4; ++j) {
                if constexpr (WITH8) { const u32x2 w = *(const u32x2*)((const bf16_t*)xin + (size_t)(r0 + rr) * 2048 + 4 * F.lane + 256 * j); v[j] = (f32x4){bf_lo(w.x), bf_hi(w.x), bf_lo(w.y), bf_hi(w.y)}; }
                else v[j] = *(const f32x4*)(xr + 256 * j);
                s += (v[j][0] * v[j][0] + v[j][1] * v[j][1]) + (v[j][2] * v[j][2] + v[j][3] * v[j][3]); }
            const float rstd = 1.0f / sqrtf(wave_sum(s) * (1.f / 1024.f) + NORM_EPS);
            bf16_t* hr = H + (size_t)(r0 + rr) * 1024 + 4 * F.lane;
#pragma unroll
            for (int j = 0; j < 4; ++j) { const f32x4 y = v[j] * rstd * A[j] + Bv[j]; u32x2 o; o.x = pk2(y[0], y[1]); o.y = pk2(y[2], y[3]); *(u32x2*)(hr + 256 * j) = o;
                if constexpr (WITH8) {
                    int wh = 0; wh = __builtin_amdgcn_cvt_pk_fp8_f32(y[0], y[1], wh, false); wh = __builtin_amdgcn_cvt_pk_fp8_f32(y[2], y[3], wh, true);
                    const auto h01 = __builtin_amdgcn_cvt_pk_f32_fp8(wh, false), h23 = __builtin_amdgcn_cvt_pk_f32_fp8(wh, true);
                    int wl = 0; wl = __builtin_amdgcn_cvt_pk_fp8_f32((y[0] - h01[0]) * 16.f, (y[1] - h01[1]) * 16.f, wl, false); wl = __builtin_amdgcn_cvt_pk_fp8_f32((y[2] - h23[0]) * 16.f, (y[3] - h23[1]) * 16.f, wl, true);
                    unsigned char* h8 = H8 + (size_t)(r0 + rr) * 2048 + 4 * F.lane + 256 * j;
                    *(int*)h8 = wh; *(int*)(h8 + 1024) = wl; } }
        }
    }
}

namespace att {
constexpr int LDS_TAB = 98304;
constexpr int LDS_KM = LDS_TAB + 8192;
constexpr int LDS_SG = LDS_KM + 4096;
constexpr int LDS_LAM = LDS_SG + 512;
constexpr float THR = 8.0f;
__device__ __forceinline__ int crow(int r, int hi) { return (r & 3) + 8 * (r >> 2) + 4 * hi; }
__device__ __forceinline__ float pair_max(float v) { auto rr = __builtin_amdgcn_permlane32_swap(__float_as_uint(v), __float_as_uint(v), false, false); return fmaxf(__uint_as_float(rr[0]), __uint_as_float(rr[1])); }
__device__ __forceinline__ float pair_sum(float v) { auto rr = __builtin_amdgcn_permlane32_swap(__float_as_uint(v), __float_as_uint(v), false, false); return __uint_as_float(rr[0]) + __uint_as_float(rr[1]); }
__device__ __forceinline__ float max3f(float a, float b, float c) { return fmaxf(fmaxf(a, b), c); }

template <bool DIFF>
__device__ __forceinline__ bool unit(LAS unsigned char* lds, const bf16_t* __restrict__ QK, const bf16_t* __restrict__ VT, bf16_t* AO, const float* __restrict__ ksum, int b, int hh, int qt, float& mshift, bool pre, bool has_next, int nb, int nhh, int nqt, int& b0) {
    constexpr int DV = DIFF ? 128 : 64, ND0 = DV / 32;
    constexpr int STG = DIFF ? 32768 : 16384, VOFF = DIFF ? 16384 : 8192;
    const int tid = threadIdx.x, lane = tid & 63, r32 = lane & 31, hi = lane >> 5;
    const int wid = __builtin_amdgcn_readfirstlane(tid >> 6);
    const int map = DIFF ? (wid >> 2) : 0;
    const int qw0 = DIFF ? (qt * 128 + 32 * (wid & 3)) : (qt * 256 + 32 * wid);
    const int qpos = qw0 + r32;
    const size_t tok0 = (size_t)b * SEQ;
    const int srow = wid * 8 + (lane >> 3), sch = (lane & 7) ^ ((srow >> 1) & 7);
    const bf16_t* kg0 = QK + (tok0 + srow) * QKW + (DIFF ? (512 + hh * 128) : (1536 + hh * 64)) + sch * 8;
    const bf16_t* vg0 = VT + (size_t)((DIFF ? hh * 128 : 512 + hh * 64) + srow) * MT + tok0 + sch * 8;
    const int kx = (r32 >> 1) & 7;
    const int kr_base = r32 * 128 + (DIFF ? map * 8192 : 0);
    const int vr_base = VOFF + r32 * 128;
    bf16x8 qf[4];
    {
        const bf16_t* qp = QK + (tok0 + qpos) * QKW + (DIFF ? (hh * 128 + map * 64) : (1024 + hh * 64)) + hi * 8;
#pragma unroll
        for (int s = 0; s < 4; ++s) qf[s] = *(const bf16x8*)(qp + 16 * s);
    }
    const LAS float* tab = (const LAS float*)(lds + LDS_TAB) + (DIFF ? (map * 4 + hh) : (8 + hh)) * 128;
    unsigned selmask = 0u;
    if constexpr (!DIFF) {
        LAS float* km = (LAS float*)(lds + LDS_KM);
        for (int i = tid; i < 1024; i += 512) { const int n = i >> 6, dd = i & 63; km[i] = ksum[(size_t)(b * 16 + n) * 512 + hh * 64 + dd] * (1.f / 256.f); }
        __syncthreads();
        float qv[32];
#pragma unroll
        for (int s = 0; s < 4; ++s)
#pragma unroll
            for (int j = 0; j < 8; ++j) qv[s * 8 + j] = __uint_as_float(((unsigned)(unsigned short)qf[s][j]) << 16);
        float v0 = -INFINITY, v1 = -INFINITY, v2 = -INFINITY; int i0 = -1, i1 = -1, i2 = -1;
        for (int n = 0; n < qt; ++n) {
            float part = 0.f;
#pragma unroll
            for (int s = 0; s < 4; ++s) {
                const f32x4 ka = *(const LAS f32x4*)(km + n * 64 + 16 * s + 8 * hi), kb = *(const LAS f32x4*)(km + n * 64 + 16 * s + 8 * hi + 4);
                part += qv[s * 8 + 0] * ka[0] + qv[s * 8 + 1] * ka[1] + qv[s * 8 + 2] * ka[2] + qv[s * 8 + 3] * ka[3] + qv[s * 8 + 4] * kb[0] + qv[s * 8 + 5] * kb[1] + qv[s * 8 + 6] * kb[2] + qv[s * 8 + 7] * kb[3];
            }
            const float gte = pair_sum(part);
            if (gte > v0) { v2 = v1; i2 = i1; v1 = v0; i1 = i0; v0 = gte; i0 = n; }
            else if (gte > v1) { v2 = v1; i2 = i1; v1 = gte; i1 = n; }
            else if (gte > v2) { v2 = gte; i2 = n; }
        }
        if (i0 >= 0) selmask |= 1u << i0;
        if (i1 >= 0) selmask |= 1u << i1;
        if (i2 >= 0) selmask |= 1u << i2;
    }
    const int NTILE = DIFF ? 2 * (qt + 1) : 4 * (qt + 1);
    auto tile_k0 = [&](int i) -> int { if constexpr (DIFF) return 64 * i; else return (i < 4) ? (qt * 256 + 64 * i) : (((i - 4) >> 2) * 256 + 64 * ((i - 4) & 3)); };
    auto stage_from = [&](const bf16_t* kp, const bf16_t* vp, int buf) {
        LAS unsigned char* sb = lds + buf * STG + wid * 1024;
        __builtin_amdgcn_global_load_lds((const unsigned*)kp, (LAS unsigned*)sb, 16, 0, 0);
        if constexpr (DIFF) {
            __builtin_amdgcn_global_load_lds((const unsigned*)(kp + 64), (LAS unsigned*)(sb + 8192), 16, 0, 0);
            __builtin_amdgcn_global_load_lds((const unsigned*)vp, (LAS unsigned*)(sb + VOFF), 16, 0, 0);
            __builtin_amdgcn_global_load_lds((const unsigned*)(vp + (size_t)64 * MT), (LAS unsigned*)(sb + VOFF + 8192), 16, 0, 0);
        } else {
            __builtin_amdgcn_global_load_lds((const unsigned*)vp, (LAS unsigned*)(sb + VOFF), 16, 0, 0);
        }
    };
    auto stage = [&](int k0, int buf) { stage_from(kg0 + (size_t)k0 * QKW, vg0 + k0, buf); };
    auto stage_next = [&](int ti, int buf) {
        const size_t ntok0 = (size_t)nb * SEQ; const int nk0 = DIFF ? 0 : nqt * 256 + 64 * ti;
        stage_from(QK + (ntok0 + srow + nk0) * QKW + (DIFF ? (512 + nhh * 128) : (1536 + nhh * 64)) + sch * 8,
                   VT + (size_t)((DIFF ? nhh * 128 : 512 + nhh * 64) + srow) * MT + ntok0 + sch * 8 + nk0, buf);
    };
    float m_ref = 0.f, l_run = 0.f, smax = 0.f;
    float cblk = 0.f;
    f32x16 o[ND0];
#pragma unroll
    for (int d0 = 0; d0 < ND0; ++d0) o[d0] = f32x16{};
    constexpr int NMF = 4 * ND0, EPM = 32 / NMF;
    u32x4 pkA[4], pkB[4];
    constexpr int VB = 2;
    bf16x8 vfr[VB][ND0];
    auto qk_tile = [&](int t, int bufi, int bufprev, f32x16& p0, f32x16& p1, auto firstc) {
        constexpr bool FIRST = decltype(firstc)::value;
        const int k0 = tile_k0(t);
        const LAS unsigned char* sb = lds + bufi * STG;
        if constexpr (!DIFF) {
            if (t >= 4 && ((t & 3) == 0)) { const bool msk = ((selmask >> ((t - 4) >> 2)) & 1u) == 0u; cblk = msk ? NEGBIG : -m_ref; }
        }
        bf16x8 kfa[4], kfb[4];
#pragma unroll
        for (int s = 0; s < 4; ++s) { const int co = ((2 * s + hi) ^ kx) << 4; kfa[s] = *(const LAS bf16x8*)(sb + kr_base + co); kfb[s] = *(const LAS bf16x8*)(sb + kr_base + 4096 + co); }
        if constexpr (!FIRST) {
            const LAS unsigned char* sp = lds + bufprev * STG;
#pragma unroll
            for (int ks = 0; ks < VB; ++ks) { const int vo = ((2 * ks + hi) ^ kx) << 4;
#pragma unroll
                for (int d0 = 0; d0 < ND0; ++d0) vfr[ks][d0] = *(const LAS bf16x8*)(sp + vr_base + d0 * 4096 + vo); }
        }
        __builtin_amdgcn_sched_barrier(0);
        if constexpr (FIRST) { p0 = __builtin_amdgcn_mfma_f32_32x32x16_bf16(kfa[0], qf[0], f32x16{}, 0, 0, 0); p1 = __builtin_amdgcn_mfma_f32_32x32x16_bf16(kfb[0], qf[0], f32x16{}, 0, 0, 0); }
        else {
            const float c0 = (!DIFF && t >= 4) ? cblk : -m_ref;
#pragma unroll
            for (int r = 0; r < 16; ++r) { p0[r] = c0; p1[r] = c0; }
            p0 = __builtin_amdgcn_mfma_f32_32x32x16_bf16(kfa[0], qf[0], p0, 0, 0, 0); p1 = __builtin_amdgcn_mfma_f32_32x32x16_bf16(kfb[0], qf[0], p1, 0, 0, 0); }
#pragma unroll
        for (int s = 1; s < 4; ++s) {
            p0 = __builtin_amdgcn_mfma_f32_32x32x16_bf16(kfa[s], qf[s], p0, 0, 0, 0);
            p1 = __builtin_amdgcn_mfma_f32_32x32x16_bf16(kfb[s], qf[s], p1, 0, 0, 0);
        }
        __builtin_amdgcn_sched_barrier(0);
        if (qw0 - (k0 + 63) < 128) {
            int dbase = qpos - k0 - 4 * hi; asm volatile("" : "+v"(dbase));
#pragma unroll
            for (int rq = 0; rq < 4; ++rq) {
#pragma unroll
                for (int r = 4 * rq; r < 4 * rq + 4; ++r) {
                    const int d0_ = dbase - crow(r, 0), d1_ = d0_ - 32;
                    const float b0 = tab[min(max(d0_, 0), 127)], b1 = tab[min(max(d1_, 0), 127)];
                    p0[r] = d0_ < 0 ? NEGBIG : p0[r] + b0; p1[r] = d1_ < 0 ? NEGBIG : p1[r] + b1;
                }
                __builtin_amdgcn_sched_barrier(0);
            }
        }
    };
    auto softmax_only = [&](f32x16& p0, f32x16& p1, u32x4 (&pkn)[4]) {
        float sum = 0.f;
#pragma unroll
        for (int r = 0; r < 16; ++r) { p0[r] = __builtin_amdgcn_exp2f(p0[r]); p1[r] = __builtin_amdgcn_exp2f(p1[r]); sum += p0[r] + p1[r]; }
        l_run += sum; smax = fmaxf(smax, sum);
        pkn[0] = (u32x4){pk2(p0[0], p0[1]), pk2(p0[2], p0[3]), pk2(p0[4], p0[5]), pk2(p0[6], p0[7])};
        pkn[1] = (u32x4){pk2(p0[8], p0[9]), pk2(p0[10], p0[11]), pk2(p0[12], p0[13]), pk2(p0[14], p0[15])};
        pkn[2] = (u32x4){pk2(p1[0], p1[1]), pk2(p1[2], p1[3]), pk2(p1[4], p1[5]), pk2(p1[6], p1[7])};
        pkn[3] = (u32x4){pk2(p1[8], p1[9]), pk2(p1[10], p1[11]), pk2(p1[12], p1[13]), pk2(p1[14], p1[15])};
    };
    auto pv_exp = [&](int bufprev, const u32x4 (&pkp)[4], f32x16& p0, f32x16& p1, u32x4 (&pkn)[4], auto withexp) {
        constexpr bool WE = decltype(withexp)::value;
        const LAS unsigned char* sp = lds + bufprev * STG;
        float sum = 0.f;
#pragma unroll
        for (int i = 0; i < NMF; ++i) {
            const int ks = i / ND0, d0 = i % ND0;
            const bf16x8 pf = __builtin_bit_cast(bf16x8, pkp[ks]);
            o[d0] = __builtin_amdgcn_mfma_f32_32x32x16_bf16(vfr[ks % VB][d0], pf, o[d0], 0, 0, 0);
            if (d0 == ND0 - 1 && ks + VB < 4) { const int vo = ((2 * (ks + VB) + hi) ^ kx) << 4;
#pragma unroll
                for (int dd = 0; dd < ND0; ++dd) vfr[ks % VB][dd] = *(const LAS bf16x8*)(sp + vr_base + dd * 4096 + vo); }
            if constexpr (WE) {
#pragma unroll
                for (int e2 = 0; e2 < EPM; e2 += 2) {
                    const int j = i * EPM + e2;
                    float a = (j < 16) ? p0[j] : p1[j - 16], b2 = (j < 16) ? p0[j + 1] : p1[j - 15];
                    a = __builtin_amdgcn_exp2f(a); b2 = __builtin_amdgcn_exp2f(b2);
                    sum += a; sum += b2;
                    unsigned wv = pk2(a, b2);
                    asm volatile("" : "+v"(wv), "+v"(sum));
                    pkn[j >> 3][(j >> 1) & 3] = wv;
                }
            }
            __builtin_amdgcn_sched_barrier(0);
        }
        l_run += sum; if constexpr (WE) smax = fmaxf(smax, sum);
    };
    int bp = 0, bc = 1, bn = 2;
    if constexpr (DIFF) {
    bp = b0; bc = (b0 == 2) ? 0 : b0 + 1; bn = (bc == 2) ? 0 : bc + 1;
    if (!pre) stage(tile_k0(0), bp);
    __syncthreads();
    {
        f32x16 p0, p1;
        stage(tile_k0(1), bc);
        qk_tile(0, bp, bp, p0, p1, std::true_type{});
        float mx = max3f(p0[0], p0[1], p1[0]);
#pragma unroll
        for (int r = 2; r < 16; r += 2) mx = max3f(mx, p0[r], p0[r + 1]);
#pragma unroll
        for (int r = 1; r < 15; r += 2) mx = max3f(mx, p1[r], p1[r + 1]);
        mx = fmaxf(mx, p1[15]);
        m_ref = pair_max(mx) + mshift;
#pragma unroll
        for (int r = 0; r < 16; ++r) { p0[r] -= m_ref; p1[r] -= m_ref; }
        softmax_only(p0, p1, pkA);
        __syncthreads();
    }
    for (int t = 1; t < NTILE; t += 2) {
        {   f32x16 p0, p1;
            if (t + 1 < NTILE) stage(tile_k0(t + 1), bn);
            else if (has_next) stage_next(0, bn);
            qk_tile(t, bc, bp, p0, p1, std::false_type{});
            pv_exp(bp, pkA, p0, p1, pkB, std::true_type{});
            __syncthreads();
            const int tmp = bp; bp = bc; bc = bn; bn = tmp; }
        if (t + 1 < NTILE) {
            f32x16 p0, p1;
            if (t + 2 < NTILE) stage(tile_k0(t + 2), bn);
            qk_tile(t + 1, bc, bp, p0, p1, std::false_type{});
            pv_exp(bp, pkB, p0, p1, pkA, std::true_type{});
            __syncthreads();
            const int tmp = bp; bp = bc; bc = bn; bn = tmp; }
    }
    {
        const LAS unsigned char* sp = lds + bp * STG;
#pragma unroll
        for (int ks = 0; ks < VB; ++ks) { const int vo = ((2 * ks + hi) ^ kx) << 4;
#pragma unroll
            for (int d0 = 0; d0 < ND0; ++d0) vfr[ks][d0] = *(const LAS bf16x8*)(sp + vr_base + d0 * 4096 + vo); }
        f32x16 dz0, dz1;
        pv_exp(bp, pkB, dz0, dz1, pkA, std::false_type{});
        __syncthreads();
    }
    } else
    {
        f32x16 pA0, pA1, pB0, pB1;
        bf16x8 kfa[4], kfb[4];
        auto kread = [&](int tt) { const LAS unsigned char* sk = lds + (tt & 3) * STG;
#pragma unroll
            for (int s_ = 0; s_ < 4; ++s_) { const int co = ((2 * s_ + hi) ^ kx) << 4; kfa[s_] = *(const LAS bf16x8*)(sk + kr_base + co); kfb[s_] = *(const LAS bf16x8*)(sk + kr_base + 4096 + co); } };
        auto vread = [&](int tt) { const LAS unsigned char* sp = lds + (tt & 3) * STG;
#pragma unroll
            for (int ks = 0; ks < VB; ++ks) { const int vo = ((2 * ks + hi) ^ kx) << 4;
#pragma unroll
                for (int d0 = 0; d0 < ND0; ++d0) vfr[ks][d0] = *(const LAS bf16x8*)(sp + vr_base + d0 * 4096 + vo); } };
        auto cinit = [&](int tt, f32x16& q0, f32x16& q1) {
            if (tt >= 4 && ((tt & 3) == 0)) { const bool msk = ((selmask >> ((tt - 4) >> 2)) & 1u) == 0u; cblk = msk ? NEGBIG : -m_ref; }
            const float c0 = (tt >= 4) ? cblk : -m_ref;
#pragma unroll
            for (int r = 0; r < 16; ++r) { q0[r] = c0; q1[r] = c0; } };
        auto nearbias = [&](int tt, f32x16& q0, f32x16& q1) {
            const int k0 = tile_k0(tt);
            if (qw0 - (k0 + 63) < 128) {
                int dbase = qpos - k0 - 4 * hi; asm volatile("" : "+v"(dbase));
#pragma unroll
                for (int rq = 0; rq < 4; ++rq) {
#pragma unroll
                    for (int r = 4 * rq; r < 4 * rq + 4; ++r) {
                        const int d0_ = dbase - crow(r, 0), d1_ = d0_ - 32;
                        const float b0 = tab[min(max(d0_, 0), 127)], b1 = tab[min(max(d1_, 0), 127)];
                        q0[r] = d0_ < 0 ? NEGBIG : q0[r] + b0; q1[r] = d1_ < 0 ? NEGBIG : q1[r] + b1;
                    }
                    __builtin_amdgcn_sched_barrier(0);
                }
            } };
        auto seg = [&](int t, f32x16& c0v, f32x16& c1v, f32x16& n0, f32x16& n1, const u32x4 (&pkp)[4], u32x4 (&pkc)[4], auto hasqk, auto haspv) {
            constexpr bool HASQK = decltype(hasqk)::value, HASPV = decltype(haspv)::value;
            const LAS unsigned char* sp = lds + ((t - 1) & 3) * STG;
            float sum = 0.f;
#pragma unroll
            for (int i = 0; i < 8; ++i) {
                if constexpr (HASQK) { const int s_ = i >> 1;
                    if (i & 1) n1 = __builtin_amdgcn_mfma_f32_32x32x16_bf16(kfb[s_], qf[s_], n1, 0, 0, 0);
                    else       n0 = __builtin_amdgcn_mfma_f32_32x32x16_bf16(kfa[s_], qf[s_], n0, 0, 0, 0); }
                if constexpr (HASPV) { const int ks = i >> 1, d0 = i & 1;
                    o[d0] = __builtin_amdgcn_mfma_f32_32x32x16_bf16(vfr[ks % VB][d0], __builtin_bit_cast(bf16x8, pkp[ks]), o[d0], 0, 0, 0);
                    if (d0 == 1 && ks + VB < 4) { const int vo = ((2 * (ks + VB) + hi) ^ kx) << 4;
#pragma unroll
                        for (int dd = 0; dd < ND0; ++dd) vfr[ks % VB][dd] = *(const LAS bf16x8*)(sp + vr_base + dd * 4096 + vo); } }
#pragma unroll
                for (int e2 = 0; e2 < 4; e2 += 2) {
                    const int j = 4 * i + e2;
                    float a_ = (j < 16) ? c0v[j] : c1v[j - 16], b_ = (j < 16) ? c0v[j + 1] : c1v[j - 15];
                    a_ = __builtin_amdgcn_exp2f(a_); b_ = __builtin_amdgcn_exp2f(b_);
                    sum += a_; sum += b_;
                    unsigned wv = pk2(a_, b_);
                    asm volatile("" : "+v"(wv), "+v"(sum));
                    pkc[j >> 3][(j >> 1) & 3] = wv;
                }
                __builtin_amdgcn_sched_barrier(0);
            }
            l_run += sum; smax = fmaxf(smax, sum);
        };
        if (!pre) { stage(tile_k0(0), 0); __syncthreads(); stage(tile_k0(1), 1); }
        {
            kread(0);
            __builtin_amdgcn_sched_barrier(0);
            pA0 = __builtin_amdgcn_mfma_f32_32x32x16_bf16(kfa[0], qf[0], f32x16{}, 0, 0, 0); pA1 = __builtin_amdgcn_mfma_f32_32x32x16_bf16(kfb[0], qf[0], f32x16{}, 0, 0, 0);
#pragma unroll
            for (int s_ = 1; s_ < 4; ++s_) { pA0 = __builtin_amdgcn_mfma_f32_32x32x16_bf16(kfa[s_], qf[s_], pA0, 0, 0, 0); pA1 = __builtin_amdgcn_mfma_f32_32x32x16_bf16(kfb[s_], qf[s_], pA1, 0, 0, 0); }
            __builtin_amdgcn_sched_barrier(0);
            nearbias(0, pA0, pA1);
            float mx = max3f(pA0[0], pA0[1], pA1[0]);
#pragma unroll
            for (int r = 2; r < 16; r += 2) mx = max3f(mx, pA0[r], pA0[r + 1]);
#pragma unroll
            for (int r = 1; r < 15; r += 2) mx = max3f(mx, pA1[r], pA1[r + 1]);
            mx = fmaxf(mx, pA1[15]);
            m_ref = pair_max(mx) + mshift;
#pragma unroll
            for (int r = 0; r < 16; ++r) { pA0[r] -= m_ref; pA1[r] -= m_ref; }
        }
        __syncthreads();
        {
            stage(tile_k0(2), 2);
            kread(1); cinit(1, pB0, pB1);
            __builtin_amdgcn_sched_barrier(0);
            seg(0, pA0, pA1, pB0, pB1, pkB, pkA, std::true_type{}, std::false_type{});
            nearbias(1, pB0, pB1);
            __syncthreads();
        }
        for (int t = 1; t + 2 < NTILE; t += 2) {
            {
                if (t + 2 < NTILE) stage(tile_k0(t + 2), (t + 2) & 3);
                kread(t + 1); vread(t - 1); cinit(t + 1, pA0, pA1);
                __builtin_amdgcn_sched_barrier(0);
                seg(t, pB0, pB1, pA0, pA1, pkA, pkB, std::true_type{}, std::true_type{});
                nearbias(t + 1, pA0, pA1);
                __syncthreads(); }
            {
                if (t + 3 < NTILE) stage(tile_k0(t + 3), (t + 3) & 3);
                else if (has_next) stage_next(0, 0);
                kread(t + 2); vread(t); cinit(t + 2, pB0, pB1);
                __builtin_amdgcn_sched_barrier(0);
                seg(t + 1, pA0, pA1, pB0, pB1, pkB, pkA, std::true_type{}, std::true_type{});
                nearbias(t + 2, pB0, pB1);
                __syncthreads(); }
        }
        {
            if (has_next) stage_next(1, 1);
            vread(NTILE - 2);
            __builtin_amdgcn_sched_barrier(0);
            seg(NTILE - 1, pB0, pB1, pA0, pA1, pkA, pkB, std::false_type{}, std::true_type{});
            __syncthreads();
        }
        {
            vread(NTILE - 1);
            f32x16 dz0, dz1;
            pv_exp((NTILE - 1) & 3, pkB, dz0, dz1, pkA, std::false_type{});
            __syncthreads();
        }
    }
    {
        const bool badl = !(smax <= 0x1p60f);
        const int badp = __shfl_xor((int)badl, 32);
        const bool badrow = badl || (badp != 0);
        if (badrow) mshift += 64.f;
        LAS unsigned* flag = (LAS unsigned*)(lds + MISC_OFF + 64);
        if (tid == 0) *flag = 0u;
        __syncthreads();
        if (badrow) *flag = 1u;
        __syncthreads();
        const bool redo = *flag != 0u;
        __syncthreads();
        if (redo) return true;
    }
    const float linv = 1.0f / pair_sum(l_run);
    if constexpr (DIFF) {
        b0 = bc;
        LAS float* ex0 = (LAS float*)(lds + bp * STG); LAS float* ex1 = (LAS float*)(lds + bn * STG);
        LAS float* ex = nullptr; (void)ex;
        if (map == 1) {
#pragma unroll
            for (int d0 = 0; d0 < ND0; ++d0)
#pragma unroll
                for (int r = 0; r < 16; ++r) ((d0 >> 1) ? ex1 : ex0)[((d0 & 1) * 16 + r) * 256 + (wid & 3) * 64 + lane] = o[d0][r] * linv;
        }
        __syncthreads();
        if (map == 0) {
            const float lam = *(const LAS float*)(lds + LDS_LAM);
            const LAS float* sg = (const LAS float*)(lds + LDS_SG);
            float ss = 0.f;
#pragma unroll
            for (int d0 = 0; d0 < ND0; ++d0)
#pragma unroll
                for (int r = 0; r < 16; ++r) { const float v = o[d0][r] * linv - lam * ((d0 >> 1) ? ex1 : ex0)[((d0 & 1) * 16 + r) * 256 + (wid & 3) * 64 + lane]; o[d0][r] = v; ss += v * v; }
            ss = pair_sum(ss);
            const float rstd = 0.8f / sqrtf(ss * (1.f / 128.f) + NORM_EPS);
            bf16_t* op = AO + (tok0 + qpos) * 1024 + hh * 128 + 4 * hi;
#pragma unroll
            for (int d0 = 0; d0 < ND0; ++d0)
#pragma unroll
                for (int rg = 0; rg < 4; ++rg) {
                    const int dcol = 32 * d0 + 8 * rg + 4 * hi;
                    const f32x4 gg = *(const LAS f32x4*)(sg + dcol);
                    u32x2 w; w.x = pk2(o[d0][4 * rg] * rstd * gg[0], o[d0][4 * rg + 1] * rstd * gg[1]); w.y = pk2(o[d0][4 * rg + 2] * rstd * gg[2], o[d0][4 * rg + 3] * rstd * gg[3]);
                    *(u32x2*)(op + 32 * d0 + 8 * rg) = w;
                }
        }
        __syncthreads();
    } else {
        bf16_t* op = AO + (tok0 + qpos) * 1024 + 512 + hh * 64 + 4 * hi;
#pragma unroll
        for (int d0 = 0; d0 < ND0; ++d0)
#pragma unroll
            for (int rg = 0; rg < 4; ++rg) {
                u32x2 w; w.x = pk2(o[d0][4 * rg] * linv, o[d0][4 * rg + 1] * linv); w.y = pk2(o[d0][4 * rg + 2] * linv, o[d0][4 * rg + 3] * linv);
                *(u32x2*)(op + 32 * d0 + 8 * rg) = w;
            }
    }
    return false;
}
}

__device__ __forceinline__ void attn_phase(Frame& F) {
    const int tid = F.tid;
    {
        LAS float* tabs = (LAS float*)(F.lds + att::LDS_TAB);
        for (int i = tid; i < 2048; i += 512) {
            const int col = i >> 7, n = i & 127;
            int bucket;
            if (n < 16) bucket = n;
            else { const float nf = (float)n; int lg = 16 + (int)(logf(nf / 16.0f) / 2.0794415416798357f * 16.0f); bucket = lg < 31 ? lg : 31; }
            tabs[col * 128 + n] = (F.rel_bias[bucket * 16 + col] - F.rel_bias[31 * 16 + col]) * LOG2E;
        }
        LAS float* sg = (LAS float*)(F.lds + att::LDS_SG);
        if (tid < 128) sg[tid] = F.subln_g[tid];
        if (F.wave == 7) {
            const float a = F.diff_lambda[F.lane] * F.diff_lambda[64 + F.lane], bq = F.diff_lambda[128 + F.lane] * F.diff_lambda[192 + F.lane];
            const float sa = wave_sum(a), sb = wave_sum(bq);
            if (F.lane == 0) *(LAS float*)(F.lds + att::LDS_LAM) = expf(sa) - expf(sb) + 0.2f;
        }
        __syncthreads();
    }
    const bf16_t* QK = (const bf16_t*)(F.ws + WS_QK); const bf16_t* VT = (const bf16_t*)(F.ws + WS_VT); bf16_t* AO = (bf16_t*)(F.ws + WS_AO);
    const float* ksum = (const float*)(F.ws + WS_KSUM);
    if (F.G == 256) {
        { const int bh = F.vcu >> 2, quarter = F.vcu & 3;
          bool pre = false; int b0 = 0;
          for (int i = 0; i < 8; ++i) { const int s = quarter * 4 + (i >> 1), qt = (i & 1) ? 31 - s : s; const int i2 = i + 1, s2 = quarter * 4 + (i2 >> 1), qt2 = (i2 & 1) ? 31 - s2 : s2;
              float msh = 0.f; bool mypre = pre; for (int a = 0; a < 8; ++a) { if (!att::unit<true>(F.lds, QK, VT, AO, ksum, bh >> 2, bh & 3, qt, msh, mypre, i < 7, bh >> 2, bh & 3, qt2, b0)) break; mypre = false; } pre = i < 7; } }
        { const int bh = F.vcu >> 1, half = F.vcu & 1;
          bool pre = false; int b0 = 0;
          for (int i = 0; i < 8; ++i) { const int s = half * 4 + (i >> 1), qt = (i & 1) ? 15 - s : s; const int i2 = i + 1, s2 = half * 4 + (i2 >> 1), qt2 = (i2 & 1) ? 15 - s2 : s2;
              float msh = 0.f; bool mypre = pre; for (int a = 0; a < 8; ++a) { if (!att::unit<false>(F.lds, QK, VT, AO, ksum, bh >> 3, bh & 7, qt, msh, mypre, i < 7, bh >> 3, bh & 7, qt2, b0)) break; mypre = false; } pre = i < 7; } }
    } else {
        for (int u = blockIdx.x; u < 2048; u += F.G) { const int bh = u >> 5; float msh = 0.f; int b0 = 0; for (int a = 0; a < 8 && att::unit<true>(F.lds, QK, VT, AO, ksum, bh >> 2, bh & 3, u & 31, msh, false, false, 0, 0, 0, b0); ++a) {} }
        for (int u = blockIdx.x; u < 2048; u += F.G) { const int bh = u >> 4; float msh = 0.f; int b0 = 0; for (int a = 0; a < 8 && att::unit<false>(F.lds, QK, VT, AO, ksum, bh >> 3, bh & 7, u & 15, msh, false, false, 0, 0, 0, b0); ++a) {} }
    }
}

__device__ __forceinline__ unsigned f2key(float f) { const unsigned u = __float_as_uint(f); return (u & 0x80000000u) ? ~u : (u | 0x80000000u); }
typedef short s16x2 __attribute__((ext_vector_type(2)));
__device__ __forceinline__ unsigned h2key2(unsigned w) { const s16x2 s = __builtin_bit_cast(s16x2, w) >> 15; return w ^ (__builtin_bit_cast(unsigned, s) | 0x80008000u); }
__device__ __forceinline__ unsigned h2key(unsigned x) { return (x & 0x80000000u) ? ~x : (x | 0x80000000u); }
__device__ __forceinline__ float key2h(unsigned k) { const unsigned hb = ((k & 0x80000000u) ? (k & 0x7fffffffu) : ~k) >> 16; return (float)__builtin_bit_cast(_Float16, (unsigned short)hb); }
__device__ __forceinline__ float key2f(unsigned k) { const unsigned u = (k & 0x80000000u) ? (k & 0x7fffffffu) : ~k; return __uint_as_float(u); }
__device__ __forceinline__ void ins16(unsigned (&L)[16], unsigned x) {
#pragma unroll
    for (int k = 0; k < 16; ++k) { const unsigned t = max(L[k], x); x = min(L[k], x); L[k] = t; }
}
#define SORT16_DESC(L) do { unsigned t_; \
    t_ = max(L[0], L[1]); L[1] = min(L[0], L[1]); L[0] = t_; \
    t_ = max(L[2], L[3]); L[3] = min(L[2], L[3]); L[2] = t_; \
    t_ = max(L[0], L[2]); L[2] = min(L[0], L[2]); L[0] = t_; \
    t_ = max(L[1], L[3]); L[3] = min(L[1], L[3]); L[1] = t_; \
    t_ = max(L[1], L[2]); L[2] = min(L[1], L[2]); L[1] = t_; \
    t_ = max(L[4], L[5]); L[5] = min(L[4], L[5]); L[4] = t_; \
    t_ = max(L[6], L[7]); L[7] = min(L[6], L[7]); L[6] = t_; \
    t_ = max(L[4], L[6]); L[6] = min(L[4], L[6]); L[4] = t_; \
    t_ = max(L[5], L[7]); L[7] = min(L[5], L[7]); L[5] = t_; \
    t_ = max(L[5], L[6]); L[6] = min(L[5], L[6]); L[5] = t_; \
    t_ = max(L[0], L[4]); L[4] = min(L[0], L[4]); L[0] = t_; \
    t_ = max(L[2], L[6]); L[6] = min(L[2], L[6]); L[2] = t_; \
    t_ = max(L[2], L[4]); L[4] = min(L[2], L[4]); L[2] = t_; \
    t_ = max(L[1], L[5]); L[5] = min(L[1], L[5]); L[1] = t_; \
    t_ = max(L[3], L[7]); L[7] = min(L[3], L[7]); L[3] = t_; \
    t_ = max(L[3], L[5]); L[5] = min(L[3], L[5]); L[3] = t_; \
    t_ = max(L[1], L[2]); L[2] = min(L[1], L[2]); L[1] = t_; \
    t_ = max(L[3], L[4]); L[4] = min(L[3], L[4]); L[3] = t_; \
    t_ = max(L[5], L[6]); L[6] = min(L[5], L[6]); L[5] = t_; \
    t_ = max(L[8], L[9]); L[9] = min(L[8], L[9]); L[8] = t_; \
    t_ = max(L[10], L[11]); L[11] = min(L[10], L[11]); L[10] = t_; \
    t_ = max(L[8], L[10]); L[10] = min(L[8], L[10]); L[8] = t_; \
    t_ = max(L[9], L[11]); L[11] = min(L[9], L[11]); L[9] = t_; \
    t_ = max(L[9], L[10]); L[10] = min(L[9], L[10]); L[9] = t_; \
    t_ = max(L[12], L[13]); L[13] = min(L[12], L[13]); L[12] = t_; \
    t_ = max(L[14], L[15]); L[15] = min(L[14], L[15]); L[14] = t_; \
    t_ = max(L[12], L[14]); L[14] = min(L[12], L[14]); L[12] = t_; \
    t_ = max(L[13], L[15]); L[15] = min(L[13], L[15]); L[13] = t_; \
    t_ = max(L[13], L[14]); L[14] = min(L[13], L[14]); L[13] = t_; \
    t_ = max(L[8], L[12]); L[12] = min(L[8], L[12]); L[8] = t_; \
    t_ = max(L[10], L[14]); L[14] = min(L[10], L[14]); L[10] = t_; \
    t_ = max(L[10], L[12]); L[12] = min(L[10], L[12]); L[10] = t_; \
    t_ = max(L[9], L[13]); L[13] = min(L[9], L[13]); L[9] = t_; \
    t_ = max(L[11], L[15]); L[15] = min(L[11], L[15]); L[11] = t_; \
    t_ = max(L[11], L[13]); L[13] = min(L[11], L[13]); L[11] = t_; \
    t_ = max(L[9], L[10]); L[10] = min(L[9], L[10]); L[9] = t_; \
    t_ = max(L[11], L[12]); L[12] = min(L[11], L[12]); L[11] = t_; \
    t_ = max(L[13], L[14]); L[14] = min(L[13], L[14]); L[13] = t_; \
    t_ = max(L[0], L[8]); L[8] = min(L[0], L[8]); L[0] = t_; \
    t_ = max(L[4], L[12]); L[12] = min(L[4], L[12]); L[4] = t_; \
    t_ = max(L[4], L[8]); L[8] = min(L[4], L[8]); L[4] = t_; \
    t_ = max(L[2], L[10]); L[10] = min(L[2], L[10]); L[2] = t_; \
    t_ = max(L[6], L[14]); L[14] = min(L[6], L[14]); L[6] = t_; \
    t_ = max(L[6], L[10]); L[10] = min(L[6], L[10]); L[6] = t_; \
    t_ = max(L[2], L[4]); L[4] = min(L[2], L[4]); L[2] = t_; \
    t_ = max(L[6], L[8]); L[8] = min(L[6], L[8]); L[6] = t_; \
    t_ = max(L[10], L[12]); L[12] = min(L[10], L[12]); L[10] = t_; \
    t_ = max(L[1], L[9]); L[9] = min(L[1], L[9]); L[1] = t_; \
    t_ = max(L[5], L[13]); L[13] = min(L[5], L[13]); L[5] = t_; \
    t_ = max(L[5], L[9]); L[9] = min(L[5], L[9]); L[5] = t_; \
    t_ = max(L[3], L[11]); L[11] = min(L[3], L[11]); L[3] = t_; \
    t_ = max(L[7], L[15]); L[15] = min(L[7], L[15]); L[7] = t_; \
    t_ = max(L[7], L[11]); L[11] = min(L[7], L[11]); L[7] = t_; \
    t_ = max(L[3], L[5]); L[5] = min(L[3], L[5]); L[3] = t_; \
    t_ = max(L[7], L[9]); L[9] = min(L[7], L[9]); L[7] = t_; \
    t_ = max(L[11], L[13]); L[13] = min(L[11], L[13]); L[11] = t_; \
    t_ = max(L[1], L[2]); L[2] = min(L[1], L[2]); L[1] = t_; \
    t_ = max(L[3], L[4]); L[4] = min(L[3], L[4]); L[3] = t_; \
    t_ = max(L[5], L[6]); L[6] = min(L[5], L[6]); L[5] = t_; \
    t_ = max(L[7], L[8]); L[8] = min(L[7], L[8]); L[7] = t_; \
    t_ = max(L[9], L[10]); L[10] = min(L[9], L[10]); L[9] = t_; \
    t_ = max(L[11], L[12]); L[12] = min(L[11], L[12]); L[11] = t_; \
    t_ = max(L[13], L[14]); L[14] = min(L[13], L[14]); L[13] = t_; \
} while (0)
#define BITONIC16_DESC(L) do { unsigned t_; \
    t_ = max(L[0], L[8]); L[8] = min(L[0], L[8]); L[0] = t_; \
    t_ = max(L[1], L[9]); L[9] = min(L[1], L[9]); L[1] = t_; \
    t_ = max(L[2], L[10]); L[10] = min(L[2], L[10]); L[2] = t_; \
    t_ = max(L[3], L[11]); L[11] = min(L[3], L[11]); L[3] = t_; \
    t_ = max(L[4], L[12]); L[12] = min(L[4], L[12]); L[4] = t_; \
    t_ = max(L[5], L[13]); L[13] = min(L[5], L[13]); L[5] = t_; \
    t_ = max(L[6], L[14]); L[14] = min(L[6], L[14]); L[6] = t_; \
    t_ = max(L[7], L[15]); L[15] = min(L[7], L[15]); L[7] = t_; \
    t_ = max(L[0], L[4]); L[4] = min(L[0], L[4]); L[0] = t_; \
    t_ = max(L[1], L[5]); L[5] = min(L[1], L[5]); L[1] = t_; \
    t_ = max(L[2], L[6]); L[6] = min(L[2], L[6]); L[2] = t_; \
    t_ = max(L[3], L[7]); L[7] = min(L[3], L[7]); L[3] = t_; \
    t_ = max(L[8], L[12]); L[12] = min(L[8], L[12]); L[8] = t_; \
    t_ = max(L[9], L[13]); L[13] = min(L[9], L[13]); L[9] = t_; \
    t_ = max(L[10], L[14]); L[14] = min(L[10], L[14]); L[10] = t_; \
    t_ = max(L[11], L[15]); L[15] = min(L[11], L[15]); L[11] = t_; \
    t_ = max(L[0], L[2]); L[2] = min(L[0], L[2]); L[0] = t_; \
    t_ = max(L[1], L[3]); L[3] = min(L[1], L[3]); L[1] = t_; \
    t_ = max(L[4], L[6]); L[6] = min(L[4], L[6]); L[4] = t_; \
    t_ = max(L[5], L[7]); L[7] = min(L[5], L[7]); L[5] = t_; \
    t_ = max(L[8], L[10]); L[10] = min(L[8], L[10]); L[8] = t_; \
    t_ = max(L[9], L[11]); L[11] = min(L[9], L[11]); L[9] = t_; \
    t_ = max(L[12], L[14]); L[14] = min(L[12], L[14]); L[12] = t_; \
    t_ = max(L[13], L[15]); L[15] = min(L[13], L[15]); L[13] = t_; \
    t_ = max(L[0], L[1]); L[1] = min(L[0], L[1]); L[0] = t_; \
    t_ = max(L[2], L[3]); L[3] = min(L[2], L[3]); L[2] = t_; \
    t_ = max(L[4], L[5]); L[5] = min(L[4], L[5]); L[4] = t_; \
    t_ = max(L[6], L[7]); L[7] = min(L[6], L[7]); L[6] = t_; \
    t_ = max(L[8], L[9]); L[9] = min(L[8], L[9]); L[8] = t_; \
    t_ = max(L[10], L[11]); L[11] = min(L[10], L[11]); L[10] = t_; \
    t_ = max(L[12], L[13]); L[13] = min(L[12], L[13]); L[12] = t_; \
    t_ = max(L[14], L[15]); L[15] = min(L[14], L[15]); L[14] = t_; \
} while (0)
__device__ __forceinline__ void topk_panel(Frame& F, const void* P, int pm) {
    const int tid = F.tid, row = tid & 255, hq = tid >> 8;
    LAS unsigned* OUT = (LAS unsigned*)(F.lds + 16384) + row * 132;
    for (int hh = 0; hh < 4; ++hh) {
        const int h = hq * 4 + hh;
        unsigned L1[16], L2[16];
#pragma unroll
        for (int k = 0; k < 16; ++k) { L1[k] = 0u; L2[k] = 0u; }
        const u32x2* p1 = (const u32x2*)P + ((size_t)(h * 2) * 32 * 256 + row);
        const u32x2* p2 = p1 + (size_t)32 * 256;
        u32x2 cv[4], cw[4], nv[4], nw[4];
#pragma unroll
        for (int q = 0; q < 4; ++q) { cv[q] = p1[(size_t)q * 256]; cw[q] = p2[(size_t)q * 256]; }
#pragma unroll
        for (int c = 0; c < 8; ++c) {
            const int cn = (c < 7) ? c + 1 : 7;
#pragma unroll
            for (int q = 0; q < 4; ++q) { nv[q] = p1[(size_t)(cn * 4 + q) * 256]; nw[q] = p2[(size_t)(cn * 4 + q) * 256]; }
            unsigned C1[16], C2[16];
#pragma unroll
            for (int q = 0; q < 4; ++q)
#pragma unroll
                for (int e = 0; e < 4; e += 2) { const unsigned idx = (unsigned)(127 - (c * 16 + q * 4 + e));
                    const unsigned k1 = h2key2(cv[q][e >> 1]), k2 = h2key2(cw[q][e >> 1]);
                    C1[q * 4 + e] = (k1 << 16) | idx; C1[q * 4 + e + 1] = (k1 & 0xffff0000u) | (idx - 1u);
                    C2[q * 4 + e] = (k2 << 16) | idx; C2[q * 4 + e + 1] = (k2 & 0xffff0000u) | (idx - 1u); }
            SORT16_DESC(C1); SORT16_DESC(C2);
            if (c == 0) {
#pragma unroll
                for (int i = 0; i < 16; ++i) { L1[i] = C1[i]; L2[i] = C2[i]; }
            } else {
#pragma unroll
                for (int i = 0; i < 16; ++i) { L1[i] = max(L1[i], C1[15 - i]); L2[i] = max(L2[i], C2[15 - i]); }
                BITONIC16_DESC(L1); BITONIC16_DESC(L2);
            }
#pragma unroll
            for (int q = 0; q < 4; ++q) { cv[q] = nv[q]; cw[q] = nw[q]; }
        }
        float v1[16], v2[16];
#pragma unroll
        for (int k = 0; k < 16; ++k) { v1[k] = key2h(L1[k]); v2[k] = key2h(L2[k]); }
        LAS unsigned* myw = (LAS unsigned*)(F.lds + tid * 32);
#pragma unroll
        for (int q = 0; q < 4; ++q) {
            myw[q] = (127u - (L1[4 * q] & 127u)) | ((127u - (L1[4 * q + 1] & 127u)) << 8) | ((127u - (L1[4 * q + 2] & 127u)) << 16) | ((127u - (L1[4 * q + 3] & 127u)) << 24);
            myw[4 + q] = (127u - (L2[4 * q] & 127u)) | ((127u - (L2[4 * q + 1] & 127u)) << 8) | ((127u - (L2[4 * q + 2] & 127u)) << 16) | ((127u - (L2[4 * q + 3] & 127u)) << 24);
        }
        const LAS unsigned char* myb = (const LAS unsigned char*)myw;
#define CKEY(a, bb) ((f2key(v1[a] + v2[bb]) & ~255u) | (unsigned)(255 - ((a) * 16 + (bb))))
        unsigned L[16];
#pragma unroll
        for (int k = 0; k < 16; ++k) L[k] = CKEY(0, k);
#pragma unroll
        for (int a = 1; a <= 4; ++a) {
#pragma unroll
            for (int bb = 0; bb < 16; ++bb) if ((a + 1) * (bb + 1) <= 16) L[15 - bb] = max(L[15 - bb], CKEY(a, bb));
            BITONIC16_DESC(L);
        }
#pragma unroll
        for (int a = 5; a < 16; ++a)
#pragma unroll
            for (int bb = 0; bb < 16; ++bb)
                if ((a + 1) * (bb + 1) <= 16) ins16(L, CKEY(a, bb));
#undef CKEY
        float w[16]; float ssum = 0.f;
        const float mtop = key2f((L[0] & ~255u) | 128u);
#pragma unroll
        for (int k = 0; k < 16; ++k) { w[k] = __expf(key2f((L[k] & ~255u) | 128u) - mtop); ssum += w[k]; }
        const float inv = 1.0f / ssum;
#pragma unroll
        for (int k = 0; k < 16; ++k) {
            const int ci = 255 - (int)(L[k] & 255u);
            const int e1 = myb[ci >> 4], e2 = myb[16 + (ci & 15)];
            const int pos = (k & 7) * 16 + h * 2 + (k >> 3);
            OUT[pos] = (unsigned)(e1 * 128 + e2) | (pk2(0.f, w[k] * inv) & 0xffff0000u);
        }
    }
    __syncthreads();
    {
        unsigned char* PE = F.ws + WS_PE + (size_t)pm * (256 * 256); unsigned char* PG = F.ws + WS_PG + (size_t)pm * (256 * 256);
#pragma unroll
        for (int i = 0; i < 8; ++i) {
            const int c = tid + 512 * i, r = c >> 4, part = c & 15;
            const LAS u32x4* q = (const LAS u32x4*)(F.lds + 16384 + r * 528 + part * 32);
            const u32x4 a = q[0], b2 = q[1];
            *(u32x4*)(PE + (size_t)c * 16) = (u32x4){(a.x & 0xffffu) | (a.y << 16), (a.z & 0xffffu) | (a.w << 16), (b2.x & 0xffffu) | (b2.y << 16), (b2.z & 0xffffu) | (b2.w << 16)};
            *(u32x4*)(PG + (size_t)c * 16) = (u32x4){(a.x >> 16) | (a.y & 0xffff0000u), (a.z >> 16) | (a.w & 0xffff0000u), (b2.x >> 16) | (b2.y & 0xffff0000u), (b2.z >> 16) | (b2.w & 0xffff0000u)};
        }
    }
}

__device__ __forceinline__ float gelu_erf(float v) { return 0.5f * v * (1.0f + erff(v * 0.70710678118654752f)); }
typedef float f32x2 __attribute__((ext_vector_type(2)));
typedef int i32x2 __attribute__((ext_vector_type(2)));
typedef int i32x8 __attribute__((ext_vector_type(8)));
__device__ __forceinline__ float dpp_x1(float v) { return __int_as_float(__builtin_amdgcn_update_dpp(0, __float_as_int(v), 0xB1, 0xf, 0xf, false)); }
__device__ __forceinline__ float dpp_x2(float v) { return __int_as_float(__builtin_amdgcn_update_dpp(0, __float_as_int(v), 0x4E, 0xf, 0xf, false)); }
__device__ __forceinline__ float dpp_hm(float v) { return __int_as_float(__builtin_amdgcn_update_dpp(0, __float_as_int(v), 0x141, 0xf, 0xf, false)); }
__device__ __forceinline__ float dpp_r8(float v) { return __int_as_float(__builtin_amdgcn_update_dpp(0, __float_as_int(v), 0x128, 0xf, 0xf, false)); }
__device__ __forceinline__ unsigned e16_of(const u32x4& ea, const u32x4& eb, int i) { const unsigned w = (i < 8) ? ea[(i & 7) >> 1] : eb[(i & 7) >> 1]; return (i & 1) ? (w >> 16) : (w & 0xffffu); }

__device__ __forceinline__ void peer_u_phase(Frame& F) {
    const int lane = F.lane, wave = F.wave, g = lane >> 3, l8 = lane & 7, n = lane & 15, kg = lane >> 4;
    const unsigned char* PE = F.ws + WS_PE; const unsigned char* H8 = F.ws + WS_H8; bf16_t* PART = (bf16_t*)(F.ws + WS_PART);
    LAS unsigned char* stg = F.lds + wave * 16384;
    LAS unsigned char* ebuf = F.lds + 131072 + wave * 2048;
    const int soff0 = (l8 ^ (g >> 1)) << 4, soff1 = soff0 ^ 64;
    const int rkey = (n >> 1) & 7, rd0 = n * 128 + ((kg ^ rkey) << 4), rd1 = n * 128 + (((4 + kg) ^ rkey) << 4);
    const int erd = g * 32, brd = 512 + (n & 1) * 256 + kg * 16;
    for (int it = blockIdx.x; it < 256; it += F.G) {
        const int x = it & 3, cb = it >> 2;
        const unsigned char* Ux = F.ws + WS_U8 + (size_t)x * (NEXP * 128);
        bf16_t* part = PART + (size_t)x * ((size_t)MT * 128);
        const int tok0 = cb * 1024 + wave * 128, tokl = tok0 + 127;
        const unsigned char* pe = PE + lane * 4; const unsigned char* ph = H8 + x * 256 + lane * 4;
#define U_DMA_E(tok, par) __builtin_amdgcn_global_load_lds((const unsigned*)(pe + (size_t)(tok) * 256), (LAS unsigned*)(ebuf + (par) * 256), 4, 0, 0)
#define U_DMA_B(tok, par) do { __builtin_amdgcn_global_load_lds((const unsigned*)(ph + (size_t)(tok) * 2048), (LAS unsigned*)(ebuf + 512 + (par) * 512), 4, 0, 0); \
                               __builtin_amdgcn_global_load_lds((const unsigned*)(ph + (size_t)(tok) * 2048 + 1024), (LAS unsigned*)(ebuf + 512 + (par) * 512 + 256), 4, 0, 0); } while (0)
#define U_TILES(ea, eb) do { _Pragma("unroll") for (int j_ = 0; j_ < 16; ++j_) \
        __builtin_amdgcn_global_load_lds((const unsigned*)(Ux + (size_t)e16_of(ea, eb, j_) * 128 + ((j_ & 1) ? soff1 : soff0)), (LAS unsigned*)(stg + j_ * 1024), 16, 0, 0); } while (0)
#define U_TOKEN(tok, par, tokn1, tokn2) do { \
            U_DMA_E(tokn2, par); U_DMA_B(tokn1, (par) ^ 1); \
              \
            asm volatile("s_waitcnt vmcnt(4)" ::: "memory"); \
            u32x4 img[16]; \
            _Pragma("unroll") for (int T = 0; T < 8; ++T) { img[2 * T] = *(const LAS u32x4*)(stg + T * 2048 + rd0); img[2 * T + 1] = *(const LAS u32x4*)(stg + T * 2048 + rd1); } \
            const u32x4 eC0 = *(const LAS u32x4*)(ebuf + ((par) ^ 1) * 256 + erd), eC1 = *(const LAS u32x4*)(ebuf + ((par) ^ 1) * 256 + erd + 16); \
            const u32x4 h0 = *(const LAS u32x4*)(ebuf + (par) * 512 + brd), h1 = *(const LAS u32x4*)(ebuf + (par) * 512 + brd + 64), h2_ = *(const LAS u32x4*)(ebuf + (par) * 512 + brd + 128), h3 = *(const LAS u32x4*)(ebuf + (par) * 512 + brd + 192); \
            asm volatile("s_waitcnt lgkmcnt(0)" ::: "memory");                    \
            U_TILES(eC0, eC1); \
            const i32x8 A0_ = {(int)h0.x, (int)h0.y, (int)h0.z, (int)h0.w, (int)h1.x, (int)h1.y, (int)h1.z, (int)h1.w}; \
            const i32x8 A1_ = {(int)h2_.x, (int)h2_.y, (int)h2_.z, (int)h2_.w, (int)h3.x, (int)h3.y, (int)h3.z, (int)h3.w}; \
            float res[8]; \
            _Pragma("unroll") for (int T = 0; T < 8; ++T) { \
                const i32x8 B0_ = {(int)img[2 * T].x, (int)img[2 * T].y, (int)img[2 * T].z, (int)img[2 * T].w, 0, 0, 0, 0}; \
                const i32x8 B1_ = {(int)img[2 * T + 1].x, (int)img[2 * T + 1].y, (int)img[2 * T + 1].z, (int)img[2 * T + 1].w, 0, 0, 0, 0}; \
                f32x4 d_ = __builtin_amdgcn_mfma_scale_f32_16x16x128_f8f6f4(A0_, B0_, (f32x4){0.f, 0.f, 0.f, 0.f}, 0, 4, 0, 0, 0, 0); \
                d_ = __builtin_amdgcn_mfma_scale_f32_16x16x128_f8f6f4(A1_, B1_, d_, 0, 4, 0, 0, 0, 0); \
                res[T] = d_[0] + d_[1] * 0.0625f; }                                  \
              \
            unsigned d2_[8]; \
            _Pragma("unroll") for (int T = 0; T < 8; ++T) { const float p_ = dpp_r8(res[T]); d2_[T] = (n < 8) ? pk2(res[T], p_) : pk2(p_, res[T]); } \
            if (lane < 16) *(u32x4*)(part + (size_t)(tok) * 128 + 16 * (n & 7) + 8 * (n >> 3)) = (n < 8) ? (u32x4){d2_[0], d2_[1], d2_[2], d2_[3]} : (u32x4){d2_[4], d2_[5], d2_[6], d2_[7]}; \
        } while (0)
        {
            U_DMA_E(tok0, 0); U_DMA_E(tok0 + 1, 1); U_DMA_B(tok0, 0);
            asm volatile("s_waitcnt vmcnt(0)" ::: "memory");
            const u32x4 eX0 = *(const LAS u32x4*)(ebuf + erd), eX1 = *(const LAS u32x4*)(ebuf + erd + 16);
            asm volatile("s_waitcnt lgkmcnt(0)" ::: "memory");
            U_TILES(eX0, eX1);
            U_DMA_E(tok0 + 1, 1);
        }
        for (int tt = 0; tt < 128; tt += 2) {
            const int t0 = tok0 + tt, t1 = t0 + 1, t2 = min(t0 + 2, tokl), t3 = min(t0 + 3, tokl);
            U_TOKEN(t0, 0, t1, t2);
            U_TOKEN(t1, 1, t2, t3);
        }
        asm volatile("s_waitcnt vmcnt(0)" ::: "memory");
#undef U_TOKEN
#undef U_TILES
#undef U_DMA_B
#undef U_DMA_E
    }
}
__device__ __forceinline__ void peer_w_phase(Frame& F) {
    const u32x2* PART = (const u32x2*)(F.ws + WS_PART); const u32x2* PG = (const u32x2*)(F.ws + WS_PG); const unsigned short* PE = (const unsigned short*)(F.ws + WS_PE); const float* vs = (const float*)(F.ws + WS_VS); const float* us = (const float*)(F.ws + WS_US);
    const size_t n4 = (size_t)MT * 128 / 4, stride = (size_t)F.G * 512;
    for (size_t p = (size_t)blockIdx.x * 512 + F.tid; p < n4; p += stride) {
        f32x4 s = {0.f, 0.f, 0.f, 0.f};
#pragma unroll
        for (int x = 0; x < 4; ++x) { const u32x2 w_ = PART[(size_t)x * n4 + p]; s += (f32x4){bf_lo(w_.x), bf_hi(w_.x), bf_lo(w_.y), bf_hi(w_.y)}; }
        const u32x2 gw_ = PG[p]; const f32x4 gt = {bf_lo(gw_.x), bf_hi(gw_.x), bf_lo(gw_.y), bf_hi(gw_.y)}; f32x4 o;
#pragma unroll
        for (int e = 0; e < 4; ++e) { const int ex = PE[4 * p + e]; o[e] = gt[e] * gelu_erf(s[e] * us[ex]) * vs[ex]; }
        float mx = fmaxf(fmaxf(fabsf(o[0]), fabsf(o[1])), fmaxf(fabsf(o[2]), fabsf(o[3])));
#pragma unroll
        for (int off = 1; off < 32; off <<= 1) mx = fmaxf(mx, __shfl_xor(mx, off));
        const float inv = mx > 0.f ? 256.f / mx : 0.f;
        o = o * inv;
        int hw = 0; hw = __builtin_amdgcn_cvt_pk_fp8_f32(o[0], o[1], hw, false); hw = __builtin_amdgcn_cvt_pk_fp8_f32(o[2], o[3], hw, true);
        const f32x4 r = {16.f * (o[0] - __builtin_amdgcn_cvt_f32_fp8(hw, 0)), 16.f * (o[1] - __builtin_amdgcn_cvt_f32_fp8(hw, 1)), 16.f * (o[2] - __builtin_amdgcn_cvt_f32_fp8(hw, 2)), 16.f * (o[3] - __builtin_amdgcn_cvt_f32_fp8(hw, 3))};
        int lw = 0; lw = __builtin_amdgcn_cvt_pk_fp8_f32(r[0], r[1], lw, false); lw = __builtin_amdgcn_cvt_pk_fp8_f32(r[2], r[3], lw, true);
        unsigned char* rec = F.ws + WS_WB + (p >> 5) * 512; const int q = (int)(p & 31);
        *(unsigned*)(rec + 4 * q) = (unsigned)hw; *(unsigned*)(rec + 128 + 4 * q) = (unsigned)lw;
        if (q == 0) *(float*)(rec + 256) = mx * (1.f / 256.f);
    }
}
__device__ __forceinline__ void peer_v_phase(Frame& F) {
    const int lane = F.lane, wave = F.wave, g = lane >> 3, l8 = lane & 7, n = lane & 15, kg = lane >> 4;
    const unsigned char* PE = F.ws + WS_PE; const unsigned char* WB = F.ws + WS_WB; bf16_t* Y = (bf16_t*)(F.ws + WS_Y);
    LAS unsigned char* stg = F.lds + wave * 16384;
    LAS unsigned char* ebuf = F.lds + 131072 + wave * 2048;
    const int soff0 = (l8 ^ (g >> 1)) << 4, soff1 = soff0 ^ 64;
    const int kq = (n >> 1) & 7, tb = (32 * kg + n) * 128;
    unsigned tba[8];
#pragma unroll
    for (int c2 = 0; c2 < 8; ++c2) tba[c2] = (unsigned)(unsigned long)(stg + tb + ((c2 ^ kq) << 4));
    const int erd = 2 * g, ard = 512 + (n & 1) * 128 + kg * 16;
    for (int it = blockIdx.x; it < 256; it += F.G) {
        const int x = it & 3, cb = it >> 2;
        const unsigned char* Vx = F.ws + WS_V8 + (size_t)x * (NEXP * 128);
        const int tok0 = cb * 1024 + wave * 128, tokl = tok0 + 127;
        const unsigned char* pe = PE + lane * 4; const unsigned char* pw = WB + lane * 4; const unsigned char* psc = WB + 256;
#define V_DMA_E(tok, par) __builtin_amdgcn_global_load_lds((const unsigned*)(pe + (size_t)(tok) * 256), (LAS unsigned*)(ebuf + (par) * 256), 4, 0, 0)
#define V_DMA_A(tok, par) do { __builtin_amdgcn_global_load_lds((const unsigned*)(pw + (size_t)(tok) * 512), (LAS unsigned*)(ebuf + 512 + (par) * 512), 4, 0, 0); \
                               __builtin_amdgcn_global_load_lds((const unsigned*)(psc + (size_t)(tok) * 512), (LAS unsigned*)(ebuf + 512 + (par) * 512 + 256), 4, 0, 0); } while (0)
#define V_IDS(par, id) do { _Pragma("unroll") for (int j_ = 0; j_ < 16; ++j_) id[j_] = *(const LAS unsigned short*)(ebuf + (par) * 256 + 16 * j_ + erd); } while (0)
#define V_TILES(id) do { _Pragma("unroll") for (int j_ = 0; j_ < 16; ++j_) \
        __builtin_amdgcn_global_load_lds((const unsigned*)(Vx + (size_t)id[j_] * 128 + ((j_ & 1) ? soff1 : soff0)), (LAS unsigned*)(stg + j_ * 1024), 16, 0, 0); } while (0)
#define V_TOKEN(tok, par, tokn1, tokn2) do { \
            V_DMA_E(tokn2, par); V_DMA_A(tokn1, (par) ^ 1); \
              \
            asm volatile("s_waitcnt vmcnt(5)" ::: "memory"); \
            i32x2 bt[32]; unsigned id[16]; \
              \
            _Pragma("unroll") for (int c = 0; c < 16; ++c) { \
                asm volatile("ds_read_b64_tr_b4 %0, %1 offset:%2" : "=v"(bt[2 * c]) : "v"(tba[c >> 1]), "n"((c & 1) * 8)); \
                asm volatile("ds_read_b64_tr_b4 %0, %1 offset:%2" : "=v"(bt[2 * c + 1]) : "v"(tba[c >> 1]), "n"((c & 1) * 8 + 2048)); } \
            V_IDS((par) ^ 1, id); \
            const u32x4 a0 = *(const LAS u32x4*)(ebuf + (par) * 512 + ard), a1 = *(const LAS u32x4*)(ebuf + (par) * 512 + ard + 64); \
            const float wsc = *(const LAS float*)(ebuf + 512 + (par) * 512 + 256); \
            asm volatile("s_waitcnt lgkmcnt(0)" : "+v"(bt[0]), "+v"(bt[1]), "+v"(bt[2]), "+v"(bt[3]), "+v"(bt[4]), "+v"(bt[5]), "+v"(bt[6]), "+v"(bt[7]), "+v"(bt[8]), "+v"(bt[9]), "+v"(bt[10]), "+v"(bt[11]) :: "memory");    \
            asm volatile("" : "+v"(bt[12]), "+v"(bt[13]), "+v"(bt[14]), "+v"(bt[15]), "+v"(bt[16]), "+v"(bt[17]), "+v"(bt[18]), "+v"(bt[19]), "+v"(bt[20]), "+v"(bt[21]), "+v"(bt[22]), "+v"(bt[23])); \
            asm volatile("" : "+v"(bt[24]), "+v"(bt[25]), "+v"(bt[26]), "+v"(bt[27]), "+v"(bt[28]), "+v"(bt[29]), "+v"(bt[30]), "+v"(bt[31])); \
            V_TILES(id); \
            const i32x8 A_ = {(int)a0.x, (int)a0.y, (int)a0.z, (int)a0.w, (int)a1.x, (int)a1.y, (int)a1.z, (int)a1.w}; \
            float res[16]; \
            _Pragma("unroll") for (int c = 0; c < 16; ++c) { \
                const i32x8 B_ = {bt[2 * c].x, bt[2 * c].y, bt[2 * c + 1].x, bt[2 * c + 1].y, 0, 0, 0, 0}; \
                const f32x4 d_ = __builtin_amdgcn_mfma_scale_f32_16x16x128_f8f6f4(A_, B_, (f32x4){0.f, 0.f, 0.f, 0.f}, 0, 4, 0, 0, 0, 0); \
                res[c] = (d_[0] + d_[1] * 0.0625f) * wsc; }                          \
            _Pragma("unroll") for (int c = 0; c < 16; ++c) asm volatile("" : "+v"(res[c]));        \
            if (lane < 16) { u32x4* yp = (u32x4*)(Y + (size_t)(tok) * 1024 + x * 256 + 16 * n); \
                yp[0] = (u32x4){pk2(res[0], res[1]), pk2(res[2], res[3]), pk2(res[4], res[5]), pk2(res[6], res[7])}; \
                yp[1] = (u32x4){pk2(res[8], res[9]), pk2(res[10], res[11]), pk2(res[12], res[13]), pk2(res[14], res[15])}; } \
        } while (0)
        {
            V_DMA_E(tok0, 0); V_DMA_E(tok0 + 1, 1); V_DMA_A(tok0, 0);
            asm volatile("s_waitcnt vmcnt(0)" ::: "memory");
            unsigned id[16]; V_IDS(0, id);
            asm volatile("s_waitcnt lgkmcnt(0)" ::: "memory");
            V_TILES(id);
            V_DMA_A(tok0, 0);
        }
        for (int tt = 0; tt < 128; tt += 2) {
            const int t0 = tok0 + tt, t1 = t0 + 1, t2 = min(t0 + 2, tokl), t3 = min(t0 + 3, tokl);
            V_TOKEN(t0, 0, t1, t2);
            V_TOKEN(t1, 1, t2, t3);
        }
        asm volatile("s_waitcnt vmcnt(0)" ::: "memory");
#undef V_TOKEN
#undef V_TILES
#undef V_IDS
#undef V_DMA_A
#undef V_DMA_E
    }
}
__device__ __forceinline__ void final_phase(Frame& F) {
    const bf16_t* Y = (const bf16_t*)(F.ws + WS_Y); const float* mod = (const float*)(F.ws + WS_MOD);
    const int gw = F.vcu * 8 + F.wave, NGW = F.G * 8;
    int tid_ = threadIdx.x; asm volatile("" : "+v"(tid_));
    const int lane = tid_ & 63;
    f32x4 fg[4];
#pragma unroll
    for (int j = 0; j < 4; ++j) fg[j] = *(const f32x4*)(F.final_g + 4 * lane + 256 * j);
    for (int tokb = gw * 32; tokb < MT; tokb += NGW * 32) {
        const int b = tokb >> 12;
        f32x4 g2[4];
#pragma unroll
        for (int j = 0; j < 4; ++j) g2[j] = *(const f32x4*)(mod + b * 6144 + 5120 + 4 * lane + 256 * j);
        for (int tok = tokb; tok < tokb + 32; ++tok) {
            float* orow = F.out + (size_t)tok * 1024 + 4 * lane;
            const bf16_t* xrow = (const bf16_t*)F.out + (size_t)tok * 2048 + 4 * lane; const bf16_t* yrow = Y + (size_t)tok * 1024 + 4 * lane;
            u32x2 w[4], yv[4];
#pragma unroll
            for (int j = 0; j < 4; ++j) { w[j] = *(const u32x2*)(xrow + 256 * j); yv[j] = *(const u32x2*)(yrow + 256 * j); }
            asm volatile("s_waitcnt vmcnt(0)" ::: "memory");
            f32x4 v[4]; float ss = 0.f;
#pragma unroll
            for (int j = 0; j < 4; ++j) { v[j] = (f32x4){bf_lo(w[j].x), bf_hi(w[j].x), bf_lo(w[j].y), bf_hi(w[j].y)} + g2[j] * (f32x4){bf_lo(yv[j].x), bf_hi(yv[j].x), bf_lo(yv[j].y), bf_hi(yv[j].y)};
                ss += v[j][0] * v[j][0] + v[j][1] * v[j][1] + v[j][2] * v[j][2] + v[j][3] * v[j][3]; }
            ss = wave_sum(ss);
            const float rstd = 1.0f / sqrtf(ss * (1.f / 1024.f) + NORM_EPS);
#pragma unroll
            for (int j = 0; j < 4; ++j) *(f32x4*)(orow + 256 * j) = v[j] * rstd * fg[j];
        }
    }
}

#ifndef MK_N_LAUNCHES
#define MK_N_LAUNCHES 1
#endif
constexpr int N_PHASES = 9;
struct Args { const float* in[16]; float* out; unsigned char* ws; int ph_lo, ph_hi; };
__global__ void __launch_bounds__(512, 2) mk_fwd(Args args) {
    extern __shared__ __attribute__((aligned(16))) unsigned char lds[];
    Frame F;
    F.lds = (LAS unsigned char*)lds;
    F.tid = threadIdx.x; F.lane = F.tid & 63; F.wave = __builtin_amdgcn_readfirstlane(F.tid >> 6);
    F.G = gridDim.x; { const int bx = blockIdx.x; F.vcu = (F.G % 8 == 0) ? (bx % 8) * (F.G / 8) + bx / 8 : bx; }
    F.x = args.in[0]; F.c = args.in[1]; F.rel_bias = args.in[2]; F.w_ada = args.in[3]; F.b_ada = args.in[4]; F.norm1_g = args.in[5]; F.w_in = args.in[6]; F.diff_lambda = args.in[7];
    F.subln_g = args.in[8]; F.w_out = args.in[9]; F.norm2_g = args.in[10]; F.peer_wq = args.in[11]; F.peer_keys = args.in[12]; F.peer_u = args.in[13]; F.peer_v = args.in[14]; F.final_g = args.in[15];
    F.out = args.out; F.ws = args.ws;
    volatile LAS unsigned* MISC = (volatile LAS unsigned*)(F.lds + MISC_OFF);
    if (F.tid < 64) MISC[F.tid] = 0u;
    __syncthreads();
    XcdBarrier bar; bar.bar = (unsigned*)(F.ws + WS_CTL) + CW_BAR; bar.x = 0; bar.st = nullptr;
    const int lo = args.ph_lo, hi = args.ph_hi;
    if (hi - lo > 1) bar = xcd_barrier_post((unsigned*)(F.ws + WS_CTL) + CW_BAR, MISC + 8);
#define IN(k) (lo <= (k) && (k) < hi)
#define SEAM(k) do { if (IN(k) && IN((k) + 1)) xcd_barrier(bar); } while (0)
    bf16_t* H = (bf16_t*)(F.ws + WS_H);
    if (IN(0)) { p0_prologue(F); } SEAM(0);
    if (IN(1)) { norm_phase<false>(F, F.x, F.norm1_g, 0, 1024, H, nullptr); } SEAM(1);
    if (IN(2)) {
        { pg8::Gemm g{H, (const bf16_t*)(F.ws + WS_WQK), MT, 2048, 1024}; pg8::StaticOrder S; S.init(MT, 2048, F.G, (int)blockIdx.x);
          pg8::EpiQK E{(bf16_t*)(F.ws + WS_QK), (float*)(F.ws + WS_KSUM), C2};
          pg8::gemm_phase<pg8::EpiQK, pg8::StaticOrder, true, true>(F.lds, g, S, E); }
        __syncthreads();
        { pg8::Gemm g{(const bf16_t*)(F.ws + WS_WV), H, 1024, MT, 1024}; pg8::StaticOrder S; S.init(1024, MT, F.G, (int)blockIdx.x);
          pg8::EpiVT E{(bf16_t*)(F.ws + WS_VT), MT};
          pg8::gemm_phase<pg8::EpiVT, pg8::StaticOrder, true, true>(F.lds, g, S, E); }
    } SEAM(2);
    if (IN(3)) { attn_phase(F); } SEAM(3);
    if (IN(4)) {
        const int pm = (int)blockIdx.x;
        { pg8::Gemm g{(const bf16_t*)(F.ws + WS_AO), (const bf16_t*)(F.ws + WS_WO), MT, 1024, 1024}; pg8::PanelOrder S{pm, 4};
          pg8::EpiRes E{F.x, (bf16_t*)F.out, (const float*)(F.ws + WS_MOD)};
          pg8::gemm_phase<pg8::EpiRes, pg8::PanelOrder, true, true>(F.lds, g, S, E); }
        __syncthreads();
        norm_phase<true>(F, F.out, F.norm2_g, 3072, 4096, H, F.ws + WS_H8);
        asm volatile("s_waitcnt vmcnt(0)" ::: "memory"); __syncthreads();
        float* scp = (float*)(F.ws + (pm < 192 ? WS_SCA + (size_t)pm * (2 * MiB) : WS_SCB + (size_t)(pm - 192) * (2 * MiB)));
        { pg8::Gemm g{H, (const bf16_t*)(F.ws + WS_WC), MT, 2048, 1024}; pg8::PanelOrder S{pm, 8};
          pg8::EpiSC E{scp};
          pg8::gemm_phase<pg8::EpiSC, pg8::PanelOrder, true, true>(F.lds, g, S, E); }
        __syncthreads();
        topk_panel(F, scp, pm);
    } SEAM(4);
    if (IN(5)) { peer_u_phase(F); } SEAM(5);
    if (IN(6)) { peer_w_phase(F); } SEAM(6);
    if (IN(7)) { peer_v_phase(F); } SEAM(7);
    if (IN(8)) { final_phase(F); }
#undef IN
#undef SEAM
}

extern "C" void kernel_launch(void* const* d_in, const int* in_sizes, int n_in, void* d_out, int out_size, void* d_ws, size_t ws_size, hipStream_t stream) {
    static int grid = 0;
    if (grid == 0) {
        if (n_in != 16 || in_sizes[0] != MT * DM || out_size != MT * DM || ws_size < WS_END) { fprintf(stderr, "kernel_launch: unexpected shapes (n_in %d, in0 %d, out %d, ws %zu); nothing launched\n", n_in, n_in > 0 ? in_sizes[0] : -1, out_size, ws_size); grid = -1; return; }
        int dev = 0, cus = 0, per_cu = 0;
        if (hipGetDevice(&dev) != hipSuccess || hipDeviceGetAttribute(&cus, hipDeviceAttributeMultiprocessorCount, dev) != hipSuccess) { grid = -1; return; }
        if (hipFuncSetAttribute((const void*)mk_fwd, hipFuncAttributeMaxDynamicSharedMemorySize, LDS_BYTES) != hipSuccess) { fprintf(stderr, "kernel_launch: hipFuncSetAttribute failed\n"); grid = -1; return; }
        if (hipOccupancyMaxActiveBlocksPerMultiprocessor(&per_cu, (const void*)mk_fwd, 512, LDS_BYTES) != hipSuccess || per_cu < 1) fprintf(stderr, "kernel_launch: note: occupancy query reports %d\n", per_cu);
        (void)hipGetLastError();
        grid = cus;
        if (grid != 256) { fprintf(stderr, "kernel_launch: built for a 256-CU device (one 256-row panel per workgroup in the fused phase); found %d CUs; nothing launched\n", cus); grid = -1; return; }
    }
    if (grid < 0) return;
    if (hipMemsetAsync((char*)d_ws + WS_CTL, 0, CTL_ZERO_BYTES, stream) != hipSuccess) return;
    Args a{};
    for (int i = 0; i < 16; ++i) a.in[i] = (const float*)d_in[i];
    a.out = (float*)d_out; a.ws = (unsigned char*)d_ws;
#if MK_N_LAUNCHES == 1
    a.ph_lo = 0; a.ph_hi = N_PHASES;
    hipLaunchKernelGGL(mk_fwd, dim3(grid), dim3(512), LDS_BYTES, stream, a);
#else
    for (int p = 0; p < N_PHASES; ++p) { a.ph_lo = p; a.ph_hi = p + 1; hipLaunchKernelGGL(mk_fwd, dim3(grid), dim3(512), LDS_BYTES, stream, a); }
#endif
}
```

```cpp
#include <hip/hip_runtime.h>
#include <type_traits>
#include <cstdio>
#include <cstdint>
#include <cmath>

#define LAS __attribute__((address_space(3)))
#define GAS __attribute__((address_space(1)))

constexpr int NB = 16, SEQ = 4096, DM = 1024, MT = NB * SEQ;
constexpr float NORM_EPS = 1e-6f, LOG2E = 1.4426950408889634f, C2 = 0.125f * LOG2E, NEGBIG = -1e30f;
constexpr int QKW = 2048;
constexpr int NEXP = 16384;

namespace pg8 {
#define PG8_LAS __attribute__((address_space(3)))
typedef unsigned short bf16_t;
typedef unsigned u32x4v __attribute__((ext_vector_type(4)));
typedef int i32x8v __attribute__((ext_vector_type(8)));
typedef short bf16x8 __attribute__((ext_vector_type(8)));
typedef float f32x4 __attribute__((ext_vector_type(4)));
typedef unsigned u32x4 __attribute__((ext_vector_type(4)));
constexpr int BM = 256, BK = 64, HALF = 128, HTB = HALF * BK * 2  , STAGE_BYTES = 8 * HTB, NXCD = 8, WGM = 8;

__host__ __device__ __forceinline__ int lds_byte(int r, int c) { const int st = (r >> 4) * 2 + (c >> 5), rr = r & 15, cc = c & 31, ob = rr * 64 + cc * 2; return st * 1024 + (ob ^ (((ob >> 9) & 1) << 5)); }
__host__ __device__ __forceinline__ void stage_rc(int b, int& R, int& C) { const int st = b / 1024, sb = b % 1024, swz = sb ^ (((sb >> 9) & 1) << 5); R = (st >> 1) * 16 + swz / 64; C = (st & 1) * 32 + (swz % 64) / 2; }
__host__ __device__ __forceinline__ int perm32(int rho) { const int n = rho >> 4, i = rho & 15; return 8 * (i >> 2) + 4 * n + (i & 3); }

struct Unit { int pm, pn; };
struct Gemm { const bf16_t* A; const bf16_t* Bt; int M, N, K; };

struct StaticOrder {
    int nM, nN, nwg, G, c;
    __host__ __device__ void init(int M, int N, int G_, int c_) { nM = M / BM; nN = N / BM; nwg = nM * nN; G = G_; c = c_; }
    __host__ __device__ bool next(int i, Unit& u) const {
        const long L = (long)i * G + c; if (L >= nwg) return false;
        int wgid = (int)L; { const int q = nwg / NXCD, r = nwg % NXCD, xcd = wgid % NXCD, off = wgid / NXCD; wgid = (xcd < r ? xcd * (q + 1) : r * (q + 1) + (xcd - r) * q) + off; }
        const int nig = WGM * nN, gid = wgid / nig, fm = gid * WGM, gsz = (nM - fm) < WGM ? (nM - fm) : WGM;
        u.pm = fm + ((wgid % nig) % gsz); u.pn = (wgid % nig) / gsz; return true;
    }
    __device__ __forceinline__ void a_ready(const Unit&) const {}
    __device__ __forceinline__ void done(const Unit&) const {}
};

struct PanelOrder {
    int pm, n;
    __host__ __device__ bool next(int i, Unit& u) const { if (i >= n) return false; u.pm = pm; u.pn = i; return true; }
    __device__ __forceinline__ void a_ready(const Unit&) const {}
    __device__ __forceinline__ void done(const Unit&) const {}
};

typedef float f32x2 __attribute__((ext_vector_type(2)));
typedef unsigned u32x2 __attribute__((ext_vector_type(2)));
typedef __bf16 bf16x2_t __attribute__((ext_vector_type(2)));
__device__ __forceinline__ unsigned cvt_pk_bf16(float lo, float hi) { f32x2 v = {lo, hi}; bf16x2_t b = __builtin_convertvector(v, bf16x2_t); return __builtin_bit_cast(unsigned, b); }

struct EpiBf16 {
    static constexpr bool PERM = true, AFTER_DRAIN = false;
    bf16_t* O; int ldc;
    __device__ __forceinline__ void operator()(const f32x4 (&acc)[2][2][4][2], const Unit& u, int wr, int wc, int fr, int fq) const {
        const int row0 = u.pm * BM + wr * 64 + fr; const int col0 = u.pn * BM + wc * 32 + 8 * fq;
#pragma unroll
        for (int ai = 0; ai < 2; ++ai)
#pragma unroll
            for (int m = 0; m < 4; ++m) { bf16_t* rowp = O + (size_t)(row0 + ai * HALF + m * 16) * ldc + col0;
#pragma unroll
                for (int bj = 0; bj < 2; ++bj) { const f32x4 v0 = acc[ai][bj][m][0], v1 = acc[ai][bj][m][1];
                    u32x4 w; w.x = cvt_pk_bf16(v0[0], v0[1]); w.y = cvt_pk_bf16(v0[2], v0[3]); w.z = cvt_pk_bf16(v1[0], v1[1]); w.w = cvt_pk_bf16(v1[2], v1[3]);
                    *(u32x4*)(rowp + bj * HALF) = w; } }
    }
};
struct EpiVT {
    static constexpr bool PERM = true, AFTER_DRAIN = false;
    bf16_t* O; int ldc;
    __device__ __forceinline__ void operator()(const f32x4 (&acc)[2][2][4][2], const Unit& u, int wr, int wc, int fr, int fq) const {
        const int row0 = u.pm * BM + wr * 64 + fr; const int col0 = u.pn * BM + wc * 32 + 16 * (fq >> 1) + 4 * (fq & 1);
#pragma unroll
        for (int ai = 0; ai < 2; ++ai)
#pragma unroll
            for (int m = 0; m < 4; ++m) { bf16_t* rowp = O + (size_t)(row0 + ai * HALF + m * 16) * ldc + col0;
#pragma unroll
                for (int bj = 0; bj < 2; ++bj) { const f32x4 v0 = acc[ai][bj][m][0], v1 = acc[ai][bj][m][1];
                    u32x2 w0, w1; w0.x = cvt_pk_bf16(v0[0], v0[1]); w0.y = cvt_pk_bf16(v0[2], v0[3]); w1.x = cvt_pk_bf16(v1[0], v1[1]); w1.y = cvt_pk_bf16(v1[2], v1[3]);
                    *(u32x2*)(rowp + bj * HALF) = w0; *(u32x2*)(rowp + bj * HALF + 8) = w1; } }
    }
};
struct EpiQK {
    static constexpr bool PERM = true, AFTER_DRAIN = false;
    bf16_t* O; float* ksum; float qscale;
    __device__ __forceinline__ void operator()(const f32x4 (&acc)[2][2][4][2], const Unit& u, int wr, int wc, int fr, int fq) const {
        const int row0 = u.pm * BM + wr * 64 + fr; const int col0 = u.pn * BM + wc * 32 + 8 * fq;
        const float sc = (u.pn < 2 || (u.pn >= 4 && u.pn < 6)) ? qscale : 1.f;
#pragma unroll
        for (int ai = 0; ai < 2; ++ai)
#pragma unroll
            for (int m = 0; m < 4; ++m) { bf16_t* rowp = O + (size_t)(row0 + ai * HALF + m * 16) * 2048 + col0;
#pragma unroll
                for (int bj = 0; bj < 2; ++bj) { const f32x4 v0 = acc[ai][bj][m][0] * sc, v1 = acc[ai][bj][m][1] * sc;
                    u32x4 w; w.x = cvt_pk_bf16(v0[0], v0[1]); w.y = cvt_pk_bf16(v0[2], v0[3]); w.z = cvt_pk_bf16(v1[0], v1[1]); w.w = cvt_pk_bf16(v1[2], v1[3]);
                    *(u32x4*)(rowp + bj * HALF) = w; } }
        if (u.pn >= 6) {
            float* kdst = ksum + (size_t)u.pm * 512 + (u.pn - 6) * BM + wc * 32 + 8 * fq;
#pragma unroll
            for (int bj = 0; bj < 2; ++bj)
#pragma unroll
                for (int n = 0; n < 2; ++n)
#pragma unroll
                    for (int e = 0; e < 4; ++e) {
                        float s = 0.f;
#pragma unroll
                        for (int ai = 0; ai < 2; ++ai)
#pragma unroll
                            for (int m = 0; m < 4; ++m) s += acc[ai][bj][m][n][e];
                        s += __shfl_xor(s, 1); s += __shfl_xor(s, 2); s += __shfl_xor(s, 4); s += __shfl_xor(s, 8);
                        if (fr == 0) atomicAdd(kdst + bj * HALF + 4 * n + e, s);
                    }
        }
    }
};
struct EpiRes {
    static constexpr bool PERM = false, AFTER_DRAIN = false;
    const float* x; bf16_t* out; const float* mod;
    __device__ __forceinline__ void operator()(const f32x4 (&acc)[2][2][4][2], const Unit& u, int wr, int wc, int fr, int fq) const { asm volatile("" : "+v"(fr));
        const int row0 = u.pm * BM + wr * 64 + fr; const int col0 = u.pn * BM + wc * 32 + 4 * fq;
        const float* g1 = mod + (size_t)(u.pm >> 4) * 6144 + 2048 + col0;
        f32x4 gv[2][2];
#pragma unroll
        for (int bj = 0; bj < 2; ++bj)
#pragma unroll
            for (int n = 0; n < 2; ++n) gv[bj][n] = *(const f32x4*)(g1 + bj * HALF + n * 16);
#pragma unroll
        for (int ai = 0; ai < 2; ++ai)
#pragma unroll
            for (int m = 0; m < 4; ++m) { const size_t off = (size_t)(row0 + ai * HALF + m * 16) * 1024 + col0;
#pragma unroll
                for (int bj = 0; bj < 2; ++bj)
#pragma unroll
                    for (int n = 0; n < 2; ++n) { const f32x4 xv = *(const f32x4*)(x + off + bj * HALF + n * 16);
                        const f32x4 y = xv + gv[bj][n] * acc[ai][bj][m][n]; u32x2 w; w.x = cvt_pk_bf16(y[0], y[1]); w.y = cvt_pk_bf16(y[2], y[3]);
                        *(u32x2*)(out + off + (size_t)(row0 + ai * HALF + m * 16) * 1024 + bj * HALF + n * 16) = w; } }
    }
};
typedef unsigned u32x2v __attribute__((ext_vector_type(2)));
struct EpiSC {
    static constexpr bool PERM = false, AFTER_DRAIN = false;
    float* P;
    __device__ __forceinline__ void operator()(const f32x4 (&acc)[2][2][4][2], const Unit& u, int wr, int wc, int fr, int fq) const { asm volatile("" : "+v"(fr));
        const int row0 = wr * 64 + fr; const int cg0 = u.pn * 64 + wc * 8 + fq;
#pragma unroll
        for (int ai = 0; ai < 2; ++ai)
#pragma unroll
            for (int m = 0; m < 4; ++m) { const int r = row0 + ai * HALF + m * 16;
#pragma unroll
                for (int bj = 0; bj < 2; ++bj)
#pragma unroll
                    for (int n = 0; n < 2; ++n) { const f32x4 a = acc[ai][bj][m][n];
                        *(u32x2v*)((char*)P + ((size_t)(cg0 + bj * 32 + n * 4) * 256 + r) * 8) = (u32x2v){__builtin_bit_cast(unsigned, __builtin_amdgcn_cvt_pkrtz(a[0], a[1])), __builtin_bit_cast(unsigned, __builtin_amdgcn_cvt_pkrtz(a[2], a[3]))}; } }
    }
};
struct EpiF32 {
    static constexpr bool PERM = false, AFTER_DRAIN = false;
    float* O; int ldc;
    __device__ __forceinline__ void operator()(const f32x4 (&acc)[2][2][4][2], const Unit& u, int wr, int wc, int fr, int fq) const {
        const int row0 = u.pm * BM + wr * 64 + fr; const int col0 = u.pn * BM + wc * 32 + 4 * fq;
#pragma unroll
        for (int ai = 0; ai < 2; ++ai)
#pragma unroll
            for (int m = 0; m < 4; ++m) { const size_t off = (size_t)(row0 + ai * HALF + m * 16) * ldc + col0;
#pragma unroll
                for (int bj = 0; bj < 2; ++bj)
#pragma unroll
                    for (int n = 0; n < 2; ++n) *(f32x4*)(O + off + bj * HALF + n * 16) = acc[ai][bj][m][n]; }
    }
};

template <class Epi, class Sched, bool ALIGN_EPI = false, bool SP2 = false, bool F8 = false>
__device__ __forceinline__ void gemm_phase(PG8_LAS unsigned char* lds, const Gemm g, const Sched& S, const Epi& E) {
    const int tid = threadIdx.x, wid = __builtin_amdgcn_readfirstlane(tid >> 6), lane = tid & 63, wr = wid >> 2, wc = wid & 3, fr = lane & 15, fq = lane >> 4;
    const int K = g.K, nt = K / BK;
    unsigned voffA[2], voffB[2];
#pragma unroll
    for (int i = 0; i < 2; ++i) { int R, C; stage_rc(tid * 16 + i * 8192, R, C); const int Rb = Epi::PERM ? ((R & ~31) + perm32(R & 31)) : R;
        voffA[i] = (unsigned)(R * K + C) * 2u; voffB[i] = (unsigned)(Rb * K + C) * 2u; }
    const size_t kstep = (size_t)(BK * 2);
    const size_t hstep = (size_t)HALF * K * 2;
    const size_t tstep = 2 * hstep;
    const unsigned ldsw = (unsigned)wid * 1024u;
    const int aoff = lds_byte(wr * 64 + fr, fq * 8), boff = lds_byte(wc * 32 + fr, fq * 8);
#define PG8_SA(b, h) (((b) * 2 + (h)) * HTB)
#define PG8_SB(b, h) ((4 + (b) * 2 + (h)) * HTB)
#define PG8_STAGE(bufoff, gbase, voff) do { _Pragma("unroll") for (int _i = 0; _i < 2; ++_i) \
        __builtin_amdgcn_global_load_lds((const unsigned*)((const char*)(gbase) + (voff)[_i]), (PG8_LAS unsigned*)(lds + (bufoff) + ldsw + _i * 8192), 16, 0, 0); } while (0)
#define PG8_LDA(dst, b, h) do { if constexpr (F8) { _Pragma("unroll") for (int m = 0; m < 4; ++m) { const u32x4v l_ = *(const PG8_LAS u32x4v*)(lds + PG8_SA(b, h) + aoff + m * 2048), h_ = *(const PG8_LAS u32x4v*)(lds + PG8_SA(b, h) + aoff + m * 2048 + 1024); \
        dst##8[m] = (i32x8v){(int)l_.x, (int)l_.y, (int)l_.z, (int)l_.w, (int)h_.x, (int)h_.y, (int)h_.z, (int)h_.w}; } } \
    else { _Pragma("unroll") for (int m = 0; m < 4; ++m) _Pragma("unroll") for (int k = 0; k < 2; ++k) dst[m][k] = *(const PG8_LAS bf16x8*)(lds + PG8_SA(b, h) + aoff + m * 2048 + k * 1024); } } while (0)
#define PG8_LDB(dst, b, h) do { if constexpr (F8) { _Pragma("unroll") for (int n = 0; n < 2; ++n) { const u32x4v l_ = *(const PG8_LAS u32x4v*)(lds + PG8_SB(b, h) + boff + n * 2048), h_ = *(const PG8_LAS u32x4v*)(lds + PG8_SB(b, h) + boff + n * 2048 + 1024); \
        dst##8[n] = (i32x8v){(int)l_.x, (int)l_.y, (int)l_.z, (int)l_.w, (int)h_.x, (int)h_.y, (int)h_.z, (int)h_.w}; } } \
    else { _Pragma("unroll") for (int n = 0; n < 2; ++n) _Pragma("unroll") for (int k = 0; k < 2; ++k) dst[n][k] = *(const PG8_LAS bf16x8*)(lds + PG8_SB(b, h) + boff + n * 2048 + k * 1024); } } while (0)
#define PG8_MMA(ai, bj, At, Bt) do { __builtin_amdgcn_s_setprio(1); _Pragma("unroll") for (int m = 0; m < 4; ++m) _Pragma("unroll") for (int n = 0; n < 2; ++n) { \
        if constexpr (F8) asm volatile("v_mfma_f32_16x16x128_f8f6f4 %0, %1, %2, %0" : "+v"(acc[ai][bj][m][n]) : "v"(Bt##8[n]), "v"(At##8[m]));     \
        else { _Pragma("unroll") for (int k = 0; k < 2; ++k) acc[ai][bj][m][n] = __builtin_amdgcn_mfma_f32_16x16x32_bf16(Bt[n][k], At[m][k], acc[ai][bj][m][n], 0, 0, 0); } } \
        __builtin_amdgcn_s_setprio(0); } while (0)
#define PG8_WAIT_V(n) asm volatile("s_waitcnt vmcnt(" #n ")" ::: "memory")
#define PG8_WAIT_L(n) asm volatile("s_waitcnt lgkmcnt(" #n ")" ::: "memory")
#define PG8_BAR __builtin_amdgcn_s_barrier()
#define PG8_SCHED __builtin_amdgcn_sched_barrier(0)
    Unit cur, nxt; int ui = 0;
    if (!S.next(0, cur)) return;
    f32x4 acc[2][2][4][2];
#pragma unroll
    for (int a = 0; a < 2; ++a)
#pragma unroll
        for (int b = 0; b < 2; ++b)
#pragma unroll
            for (int m = 0; m < 4; ++m)
#pragma unroll
                for (int n = 0; n < 2; ++n) acc[a][b][m][n] = (f32x4){0.f, 0.f, 0.f, 0.f};
    bf16x8 At[4][2], B0[2][2], B1[2][2]; i32x8v At8[4], B08[2], B18[2];
    const char* cA = (const char*)g.A + (size_t)cur.pm * tstep; const char* cB = (const char*)g.Bt + (size_t)cur.pn * tstep;
    S.a_ready(cur);
    if constexpr (SP2) {
        PG8_STAGE(PG8_SB(0, 0), cB, voffB); PG8_STAGE(PG8_SB(0, 1), cB + hstep, voffB); PG8_STAGE(PG8_SA(0, 0), cA, voffA); PG8_STAGE(PG8_SA(0, 1), cA + hstep, voffA);
        if (wr == 1) PG8_BAR;
        PG8_WAIT_V(2); PG8_BAR;
        PG8_STAGE(PG8_SB(1, 0), cB + kstep, voffB); PG8_STAGE(PG8_SA(1, 0), cA + kstep, voffA); PG8_STAGE(PG8_SB(1, 1), cB + hstep + kstep, voffB);
        PG8_WAIT_V(6); PG8_BAR;
    } else {
        PG8_STAGE(PG8_SB(0, 0), cB, voffB); PG8_STAGE(PG8_SA(0, 0), cA, voffA); PG8_STAGE(PG8_SB(0, 1), cB + hstep, voffB); PG8_STAGE(PG8_SA(0, 1), cA + hstep, voffA);
        if (wr == 1) PG8_BAR;
        PG8_WAIT_V(4); PG8_BAR;
        PG8_STAGE(PG8_SB(1, 0), cB + kstep, voffB); PG8_STAGE(PG8_SA(1, 0), cA + kstep, voffA); PG8_STAGE(PG8_SB(1, 1), cB + hstep + kstep, voffB);
        PG8_WAIT_V(6); PG8_BAR;
    }
    for (;;) {
        const bool has_next = S.next(ui + 1, nxt);
        const char* nA = has_next ? (const char*)g.A + (size_t)nxt.pm * tstep : cA; const char* nB = has_next ? (const char*)g.Bt + (size_t)nxt.pn * tstep : cB;
#pragma unroll 1
        for (int t = 0; t < nt; t += 2) {
            const bool last = (t == nt - 2);
            const char* a1 = cA + (size_t)(t + 1) * kstep;
            const char* a2 = last ? nA : cA + (size_t)(t + 2) * kstep; const char* b2 = last ? nB : cB + (size_t)(t + 2) * kstep;
            const char* a3 = a2 + kstep; const char* b3 = b2 + kstep;
            if (last && has_next) S.a_ready(nxt);
            if constexpr (SP2) {
            PG8_LDB(B0, 0, 0); PG8_LDB(B1, 0, 1); PG8_SCHED; PG8_LDA(At, 0, 0); PG8_STAGE(PG8_SA(1, 1), a1 + hstep, voffA);
            PG8_WAIT_V(8); PG8_WAIT_L(0); PG8_BAR; PG8_MMA(0, 0, At, B0); PG8_MMA(0, 1, At, B1); PG8_BAR; PG8_SCHED;
            PG8_LDA(At, 0, 1); PG8_STAGE(PG8_SB(0, 0), b2, voffB); PG8_STAGE(PG8_SB(0, 1), b2 + hstep, voffB); PG8_STAGE(PG8_SA(0, 0), a2, voffA);
            PG8_WAIT_V(8); PG8_WAIT_L(0); PG8_BAR; PG8_MMA(1, 0, At, B0); PG8_MMA(1, 1, At, B1); PG8_BAR; PG8_SCHED;
            PG8_LDB(B0, 1, 0); PG8_LDB(B1, 1, 1); PG8_SCHED; PG8_LDA(At, 1, 0); PG8_STAGE(PG8_SA(0, 1), a2 + hstep, voffA);
            PG8_WAIT_V(8); PG8_WAIT_L(0); PG8_BAR; PG8_MMA(0, 0, At, B0); PG8_MMA(0, 1, At, B1); PG8_BAR; PG8_SCHED;
            PG8_LDA(At, 1, 1); PG8_STAGE(PG8_SB(1, 0), b3, voffB); PG8_STAGE(PG8_SB(1, 1), b3 + hstep, voffB); PG8_STAGE(PG8_SA(1, 0), a3, voffA);
            PG8_WAIT_V(8); PG8_WAIT_L(0); PG8_BAR; PG8_MMA(1, 0, At, B0); PG8_MMA(1, 1, At, B1); PG8_BAR; PG8_SCHED;
            } else {
            PG8_LDB(B0, 0, 0); PG8_SCHED; PG8_LDA(At, 0, 0); PG8_STAGE(PG8_SA(1, 1), a1 + hstep, voffA);
            PG8_WAIT_L(8); PG8_BAR; PG8_WAIT_L(0); PG8_MMA(0, 0, At, B0); PG8_BAR; PG8_SCHED;
            PG8_LDB(B1, 0, 1); PG8_STAGE(PG8_SB(0, 0), b2, voffB);
            PG8_BAR; PG8_WAIT_L(0); PG8_MMA(0, 1, At, B1); PG8_BAR;
            PG8_LDA(At, 0, 1); PG8_STAGE(PG8_SA(0, 0), a2, voffA);
            PG8_BAR; PG8_WAIT_L(0); PG8_MMA(1, 0, At, B0); PG8_BAR; PG8_SCHED;
            PG8_STAGE(PG8_SB(0, 1), b2 + hstep, voffB);
            PG8_WAIT_V(6); PG8_BAR; PG8_MMA(1, 1, At, B1); PG8_BAR;
            PG8_LDB(B0, 1, 0); PG8_SCHED; PG8_LDA(At, 1, 0); PG8_STAGE(PG8_SA(0, 1), a2 + hstep, voffA);
            PG8_WAIT_L(8); PG8_BAR; PG8_WAIT_L(0); PG8_MMA(0, 0, At, B0); PG8_BAR; PG8_SCHED;
            PG8_LDB(B1, 1, 1); PG8_STAGE(PG8_SB(1, 0), b3, voffB);
            PG8_BAR; PG8_WAIT_L(0); PG8_MMA(0, 1, At, B1); PG8_BAR;
            PG8_LDA(At, 1, 1); PG8_STAGE(PG8_SA(1, 0), a3, voffA);
            PG8_BAR; PG8_WAIT_L(0); PG8_MMA(1, 0, At, B0); PG8_BAR; PG8_SCHED;
            PG8_STAGE(PG8_SB(1, 1), b3 + hstep, voffB);
            PG8_WAIT_V(6); PG8_BAR; PG8_MMA(1, 1, At, B1); PG8_BAR;
            }
        }
        if constexpr (F8) asm volatile("s_nop 15\n\ts_nop 15\n\ts_nop 15" ::: "memory");
        if constexpr (ALIGN_EPI) { if (wr == 0) PG8_BAR; }
        if constexpr (!Epi::AFTER_DRAIN) { E(acc, cur, wr, wc, fr, fq); S.done(cur); }
        if (!has_next) break;
#pragma unroll
        for (int a = 0; a < 2; ++a)
#pragma unroll
            for (int b = 0; b < 2; ++b)
#pragma unroll
                for (int m = 0; m < 4; ++m)
#pragma unroll
                    for (int n = 0; n < 2; ++n) acc[a][b][m][n] = (f32x4){0.f, 0.f, 0.f, 0.f};
        cur = nxt; cA = nA; cB = nB; ++ui;
        if constexpr (ALIGN_EPI) { if (wr == 1) PG8_BAR; }
    }
    PG8_WAIT_V(0);
    if constexpr (!ALIGN_EPI) { if (wr == 0) PG8_BAR; }
    PG8_BAR;
    if constexpr (Epi::AFTER_DRAIN) { E.fused(acc, cur, wr, wc, fr, fq, lds, wid, lane); S.done(cur); }
#undef PG8_SA
#undef PG8_SB
#undef PG8_STAGE
#undef PG8_LDA
#undef PG8_LDB
#undef PG8_MMA
#undef PG8_WAIT_V
#undef PG8_WAIT_L
#undef PG8_BAR
#undef PG8_SCHED
}
}

typedef unsigned short bf16_t;
typedef short bf16x8 __attribute__((ext_vector_type(8)));
typedef float f32x4 __attribute__((ext_vector_type(4)));
typedef float f32x16 __attribute__((ext_vector_type(16)));
typedef unsigned u32x4 __attribute__((ext_vector_type(4)));
typedef unsigned u32x2 __attribute__((ext_vector_type(2)));
typedef __bf16 bf16x2v __attribute__((ext_vector_type(2)));
#define LDS_WAIT() asm volatile("s_waitcnt lgkmcnt(0)" ::: "memory")
__device__ __forceinline__ unsigned pk2(float lo, float hi) { return pg8::cvt_pk_bf16(lo, hi); }
__device__ __forceinline__ float bf_lo(unsigned w) { return __uint_as_float(w << 16); }
__device__ __forceinline__ float bf_hi(unsigned w) { return __uint_as_float(w & 0xffff0000u); }
__device__ __forceinline__ float wave_sum(float v) {
#pragma unroll
    for (int o = 1; o < 64; o <<= 1) v += __shfl_xor(v, o);
    return v;
}
__device__ __forceinline__ float swap32_f(float v) {
    auto rr = __builtin_amdgcn_permlane32_swap(__float_as_uint(v), __float_as_uint(v), false, false);
    return (threadIdx.x & 32) ? __uint_as_float(rr[0]) : __uint_as_float(rr[1]);
}
__device__ __forceinline__ float dot2bf(unsigned a, unsigned b, float acc) { return __builtin_amdgcn_fdot2_f32_bf16(__builtin_bit_cast(bf16x2v, a), __builtin_bit_cast(bf16x2v, b), acc, false); }

constexpr size_t MiB = 1u << 20;
constexpr size_t WS_CTL = 0, CTL_ZERO_BYTES = 1 * MiB;
constexpr size_t WS_KSUM = 512 * 1024;
constexpr size_t WS_MOD = 1 * MiB;
constexpr size_t WS_WQK = 2 * MiB;
constexpr size_t WS_WV = 6 * MiB;
constexpr size_t WS_WO = 8 * MiB;
constexpr size_t WS_WC8 = 14 * MiB;
constexpr size_t WS_WC = 10 * MiB;
constexpr size_t WS_U8 = 16 * MiB, WS_V8 = 32 * MiB;
constexpr size_t WS_US = 51 * MiB;
constexpr size_t WS_WB = 52 * MiB;
constexpr size_t WS_VS = 50 * MiB;
constexpr size_t WS_H = 128 * MiB;
constexpr size_t WS_QK = 256 * MiB;
constexpr size_t WS_VT = 512 * MiB;
constexpr size_t WS_AO = 640 * MiB, WS_H8 = 128 * MiB, WS_Y = 640 * MiB;
constexpr size_t WS_SCA = 256 * MiB, WS_SCB = 832 * MiB;
constexpr size_t WS_PART = 256 * MiB;
constexpr size_t WS_PE = 960 * MiB, WS_PG = 976 * MiB;
constexpr size_t WS_END = 1008 * MiB;
constexpr int CW_BAR = 4096;
constexpr int CW_MOD = 8192;

constexpr int LDS_BYTES = 163840, MISC_OFF = LDS_BYTES - 256;

#define XB_TMO      128
#define XB_XCNT(j)  (256  + 64 * (j))
#define XB_XSUB(j)  (1280 + 64 * (j))
#define XB_XGEN(j)  (2304 + 64 * (j))
#define XB_TOP      3328
#define XB_TOPGEN   3392
#define XCD_BAR_WORDS 3456
#define XB_SPIN_CAP (1u << 18)
__device__ __forceinline__ unsigned xb_ld(unsigned* p)              { return __hip_atomic_load(p, __ATOMIC_RELAXED, __HIP_MEMORY_SCOPE_AGENT); }
__device__ __forceinline__ unsigned xb_add(unsigned* p, unsigned v) { return __hip_atomic_fetch_add(p, v, __ATOMIC_RELAXED, __HIP_MEMORY_SCOPE_AGENT); }
__device__ __forceinline__ unsigned xb_xcc_id() { return (unsigned)__builtin_amdgcn_s_getreg((3 << 11) | 20) & 0xFu; }
#define XB_SPIN(cond, bar) do { unsigned _sp = 0; while (cond) { __builtin_amdgcn_s_sleep(1); \
    if ((++_sp & 255u) == 0u) { if (xb_ld(&(bar)[XB_TMO])) break; if (_sp > XB_SPIN_CAP) { atomicAdd(&(bar)[XB_TMO], 1u); break; } } } } while (0)
struct XcdBarrier { unsigned* bar; unsigned x; volatile LAS unsigned* st; };
__device__ __forceinline__ XcdBarrier xcd_barrier_post(unsigned* bar, volatile LAS unsigned* st) {
    XcdBarrier b; b.bar = bar; b.x = xb_xcc_id(); b.st = st;
    if (threadIdx.x == 0) (void)xb_add(&bar[XB_XCNT(b.x)], 1u);
    return b;
}
__device__ __forceinline__ void xcd_barrier_complete(unsigned* bar, unsigned x, unsigned& nloc, unsigned& nx) {
    const unsigned G = gridDim.x * gridDim.y * gridDim.z;
    unsigned sum, cnt, mine, sp = 0u;
    for (;;) {
        sum = 0u; cnt = 0u; mine = 0u;
#pragma unroll
        for (unsigned j = 0; j < 16; ++j) { const unsigned c = xb_ld(&bar[XB_XCNT(j)]); sum += c; cnt += (c > 0u) ? 1u : 0u; mine = (j == x) ? c : mine; }
        if (sum == G) break;
        __builtin_amdgcn_s_sleep(1);
        if ((++sp & 255u) == 0u) { if (xb_ld(&bar[XB_TMO])) break; if (sp > XB_SPIN_CAP) { atomicAdd(&bar[XB_TMO], 1u); break; } }
    }
    nloc = mine > 0u ? mine : 1u; nx = cnt > 0u ? cnt : 1u;
}
__device__ __forceinline__ void xcd_barrier(const XcdBarrier& b) {
    asm volatile("s_waitcnt vmcnt(0)" ::: "memory");
    __syncthreads();
    if (threadIdx.x == 0) {
        unsigned* bar = b.bar;
        __builtin_amdgcn_s_waitcnt(0);
        unsigned nloc = b.st[0], nx = b.st[1];
        if (nloc == 0u) { xcd_barrier_complete(bar, b.x, nloc, nx); b.st[0] = nloc; b.st[1] = nx; }
        const unsigned old = xb_add(&bar[XB_XSUB(b.x)], 1u);
        const unsigned gen = old / nloc;
        if (old + 1u == (gen + 1u) * nloc) {
            __builtin_amdgcn_fence(__ATOMIC_RELEASE, "agent");
            asm volatile("s_waitcnt vmcnt(0)" ::: "memory");
            const unsigned og = xb_add(&bar[XB_TOP], 1u);
            const unsigned tg = og / nx;
            if (og + 1u == (tg + 1u) * nx) xb_add(&bar[XB_TOPGEN], 1u);
            else XB_SPIN(xb_ld(&bar[XB_TOPGEN]) == tg, bar);
            __builtin_amdgcn_fence(__ATOMIC_ACQUIRE, "agent");
            xb_add(&bar[XB_XGEN(b.x)], 1u);
            asm volatile("s_waitcnt vmcnt(0)" ::: "memory");
        } else {
            XB_SPIN(xb_ld(&bar[XB_XGEN(b.x)]) == gen, bar);
            __builtin_amdgcn_fence(__ATOMIC_ACQUIRE, "agent");
            asm volatile("s_waitcnt vmcnt(0)" ::: "memory");
        }
    }
    __syncthreads();
}

struct Frame {
    LAS unsigned char* lds;
    int tid, lane, wave, vcu, G;
    const float *x, *c, *rel_bias, *w_ada, *b_ada, *norm1_g, *w_in, *diff_lambda, *subln_g, *w_out, *norm2_g, *peer_wq, *peer_keys, *peer_u, *peer_v, *final_g;
    float* out; unsigned char* ws;
};

__device__ __forceinline__ void p0_transpose_item(const float* W, int K, int N, bf16_t* WT, int row_off, LAS float* scr, int item, int lane) {
    const int nblk = N / 32, kb = item / nblk, nb = item % nblk, k0 = 64 * kb, n0 = 32 * nb;
#pragma unroll 16
    for (int i = 0; i < 32; ++i) { const int kk = 2 * i + (lane >> 5); scr[kk * 33 + (lane & 31)] = W[(size_t)(k0 + kk) * N + n0 + (lane & 31)]; }
    LDS_WAIT(); asm volatile("" ::: "memory");
    const int c = lane & 7;
#pragma unroll
    for (int j = 0; j < 4; ++j) { const int n = (lane >> 3) + 8 * j; const LAS float* s = scr + (8 * c) * 33 + n;
        u32x4 o; o.x = pk2(s[0 * 33], s[1 * 33]); o.y = pk2(s[2 * 33], s[3 * 33]); o.z = pk2(s[4 * 33], s[5 * 33]); o.w = pk2(s[6 * 33], s[7 * 33]);
        *(u32x4*)(WT + (size_t)(row_off + n0 + n) * K + k0 + 8 * c) = o; }
    LDS_WAIT(); asm volatile("" ::: "memory");
}
__device__ __forceinline__ void p0_prologue(Frame& F) {
    const int tid = F.tid, lane = F.lane, wave = F.wave;
    float* mod = (float*)(F.ws + WS_MOD);
    for (int it = blockIdx.x; it < 192; it += F.G) {
        LAS float* sc = (LAS float*)F.lds;
        LAS float* red = (LAS float*)(F.lds + 65536);
        for (int idx = tid; idx < 16384; idx += 512) { const int b = idx >> 10, k = idx & 1023; const float v = F.c[idx]; sc[k * 16 + b] = v / (1.f + __expf(-v)); }
        __syncthreads();
        const int n0 = it * 32, l5 = lane & 31, kq = wave * 2 + (lane >> 5);
        float acc[16];
#pragma unroll
        for (int b = 0; b < 16; ++b) acc[b] = 0.f;
        const float* wp = F.w_ada + (size_t)(kq * 64) * 6144 + n0 + l5;
#pragma unroll 16
        for (int k = 0; k < 64; ++k) {
            const float wv = wp[(size_t)k * 6144];
            const LAS f32x4* s4 = (const LAS f32x4*)(sc + (kq * 64 + k) * 16);
#pragma unroll
            for (int q = 0; q < 4; ++q) { const f32x4 s = s4[q]; acc[4 * q + 0] += s[0] * wv; acc[4 * q + 1] += s[1] * wv; acc[4 * q + 2] += s[2] * wv; acc[4 * q + 3] += s[3] * wv; }
        }
#pragma unroll
        for (int b = 0; b < 16; ++b) red[(kq * 16 + b) * 32 + l5] = acc[b];
        __syncthreads();
        { const int b = tid >> 5, ln = tid & 31; float s = F.b_ada[n0 + ln];
#pragma unroll
            for (int w = 0; w < 16; ++w) s += red[(w * 16 + b) * 32 + ln];
            mod[b * 6144 + n0 + ln] = s; }
        __syncthreads();
    }
    {
        int mine = 0; for (int it = blockIdx.x; it < 192; it += F.G) ++mine;
        if (mine > 0) { asm volatile("s_waitcnt vmcnt(0)" ::: "memory"); __syncthreads(); }
        if (mine > 0 && tid == 0) {
            __builtin_amdgcn_fence(__ATOMIC_RELEASE, "agent");
            asm volatile("s_waitcnt vmcnt(0)" ::: "memory");
            (void)xb_add((unsigned*)(F.ws + WS_CTL) + CW_MOD, (unsigned)mine);
        }
    }
    for (int it = blockIdx.x; it < 256; it += F.G) {
        const int g = it >> 4, k0 = (it & 15) * 64, mb = wave & 1, nb = wave >> 1, r32 = lane & 31, hi = lane >> 5;
        const float* ap = F.peer_wq + (size_t)(k0 + mb * 32 + r32) * 2048 + g * 128 + hi * 8;
        const float* bp = F.peer_keys + (size_t)g * 16384 + (size_t)(nb * 32 + r32) * 128 + hi * 8;
        f32x4 av[16], bv[16];
#pragma unroll
        for (int q = 0; q < 16; ++q) { av[q] = *(const f32x4*)(ap + 16 * (q >> 1) + 4 * (q & 1)); bv[q] = *(const f32x4*)(bp + 16 * (q >> 1) + 4 * (q & 1)); }
        f32x16 acc = f32x16{};
#pragma unroll
        for (int s8 = 0; s8 < 8; ++s8) {
            const u32x4 aw = {pk2(av[2 * s8][0], av[2 * s8][1]), pk2(av[2 * s8][2], av[2 * s8][3]), pk2(av[2 * s8 + 1][0], av[2 * s8 + 1][1]), pk2(av[2 * s8 + 1][2], av[2 * s8 + 1][3])};
            const u32x4 bw = {pk2(bv[2 * s8][0], bv[2 * s8][1]), pk2(bv[2 * s8][2], bv[2 * s8][3]), pk2(bv[2 * s8 + 1][0], bv[2 * s8 + 1][1]), pk2(bv[2 * s8 + 1][2], bv[2 * s8 + 1][3])};
            acc = __builtin_amdgcn_mfma_f32_32x32x16_bf16(__builtin_bit_cast(bf16x8, aw), __builtin_bit_cast(bf16x8, bw), acc, 0, 0, 0);
        }
        unsigned char* wrow = F.ws + WS_WC8 + (size_t)(g * 128 + nb * 32 + r32) * 1024 + k0 + mb * 32 + 4 * hi;
#pragma unroll
        for (int q = 0; q < 4; ++q) {
            int w8 = 0; w8 = __builtin_amdgcn_cvt_pk_fp8_f32(acc[4 * q] * 64.f, acc[4 * q + 1] * 64.f, w8, false); w8 = __builtin_amdgcn_cvt_pk_fp8_f32(acc[4 * q + 2] * 64.f, acc[4 * q + 3] * 64.f, w8, true);
            *(int*)(wrow + 8 * q) = w8;
        }
    }
    {
        LAS float* scr = (LAS float*)(F.lds + wave * 8448);
        const int gw = F.vcu * 8 + wave, NGW = F.G * 8;
        bf16_t* wqk = (bf16_t*)(F.ws + WS_WQK); bf16_t* wv = (bf16_t*)(F.ws + WS_WV); bf16_t* wo = (bf16_t*)(F.ws + WS_WO);
        constexpr int I_IN = 16 * 96, I_O = 16 * 32;
        for (int it = gw; it < I_IN + I_O; it += NGW) {
            if (it < I_IN) {
                const int nb = it % 96, n0 = nb * 32;
                if (n0 < 1024) p0_transpose_item(F.w_in, 1024, 3072, wqk, 0, scr, it, lane);
                else if (n0 < 1536) p0_transpose_item(F.w_in, 1024, 3072, wv, -1024, scr, it, lane);
                else if (n0 < 2560) p0_transpose_item(F.w_in, 1024, 3072, wqk, -512, scr, it, lane);
                else p0_transpose_item(F.w_in, 1024, 3072, wv, -2048, scr, it, lane);
            } else p0_transpose_item(F.w_out, 1024, 1024, wo, 0, scr, it - I_IN, lane);
        }
    }
    {
        const int gw = F.vcu * 8 + wave, NGW = F.G * 8;
        float* us = (float*)(F.ws + WS_US);
        for (int e0 = gw; e0 < NEXP; e0 += 2 * NGW) {
            f32x4 aa[2][4];
#pragma unroll
            for (int h = 0; h < 2; ++h) { const f32x4* src = (const f32x4*)(F.peer_u + (size_t)(e0 + h * NGW) * 1024 + lane * 16);
#pragma unroll
                for (int q = 0; q < 4; ++q) aa[h][q] = src[q]; }
#pragma unroll
          for (int h = 0; h < 2; ++h) {
            const int e = e0 + h * NGW;
            f32x4 a[4]; float mx = 0.f;
#pragma unroll
            for (int q = 0; q < 4; ++q) { a[q] = aa[h][q]; mx = fmaxf(mx, fmaxf(fmaxf(fabsf(a[q][0]), fabsf(a[q][1])), fmaxf(fabsf(a[q][2]), fabsf(a[q][3])))); }
#pragma unroll
            for (int o = 1; o < 64; o <<= 1) mx = fmaxf(mx, __shfl_xor(mx, o));
            const float sc = mx > 0.f ? mx * (0.9f / 6.f) : 1.f, inv = 1.f / sc;
            if (lane == 0) us[e] = sc;
            unsigned w[2] = {0u, 0u};
#pragma unroll
            for (int q = 0; q < 4; ++q)
#pragma unroll
                for (int k = 0; k < 4; ++k) {
                    const float v = a[q][k], t = fabsf(v) * inv;
                    unsigned code = (t > 0.25f) + (t > 0.75f) + (t > 1.25f) + (t > 1.75f) + (t > 2.5f) + (t > 3.5f) + (t > 5.0f);
                    code |= (v < 0.f) ? 8u : 0u;
                    const int el = q * 4 + k;
                    w[el >> 3] |= code << (4 * (el & 7));
                }
            *(u32x2*)(F.ws + WS_U8 + (size_t)(lane >> 4) * (NEXP * 128) + (size_t)e * 128 + (lane & 15) * 8) = (u32x2){w[0], w[1]};
          }
        }
    }
    {
        const int gw = F.vcu * 8 + wave, NGW = F.G * 8;
        float* vs = (float*)(F.ws + WS_VS);
        for (int e0 = gw; e0 < NEXP; e0 += 2 * NGW) {
            f32x4 aa[2][4];
#pragma unroll
            for (int h = 0; h < 2; ++h) { const f32x4* src = (const f32x4*)(F.peer_v + (size_t)(e0 + h * NGW) * 1024 + lane * 16);
#pragma unroll
                for (int q = 0; q < 4; ++q) aa[h][q] = src[q]; }
#pragma unroll
          for (int h = 0; h < 2; ++h) {
            const int e = e0 + h * NGW;
            f32x4 a[4]; float mx = 0.f;
#pragma unroll
            for (int q = 0; q < 4; ++q) { a[q] = aa[h][q]; mx = fmaxf(mx, fmaxf(fmaxf(fabsf(a[q][0]), fabsf(a[q][1])), fmaxf(fabsf(a[q][2]), fabsf(a[q][3])))); }
#pragma unroll
            for (int o = 1; o < 64; o <<= 1) mx = fmaxf(mx, __shfl_xor(mx, o));
            const float sc = mx > 0.f ? mx * (0.9f / 6.f) : 1.f, inv = 1.f / sc;
            if (lane == 0) vs[e] = sc;
            unsigned w[2] = {0u, 0u};
#pragma unroll
            for (int q = 0; q < 4; ++q)
#pragma unroll
                for (int k = 0; k < 4; ++k) {
                    const float v = a[q][k], t = fabsf(v) * inv;
                    unsigned code = (t > 0.25f) + (t > 0.75f) + (t > 1.25f) + (t > 1.75f) + (t > 2.5f) + (t > 3.5f) + (t > 5.0f);
                    code |= (v < 0.f) ? 8u : 0u;
                    const int el = q * 4 + k;
                    w[el >> 3] |= code << (4 * (el & 7));
                }
            unsigned o2[2] = {0u, 0u}; const int nn = lane & 15, gb = lane & 48;
#pragma unroll
            for (int j = 0; j < 16; ++j) { const unsigned w0 = __shfl(w[0], gb + j), w1 = __shfl(w[1], gb + j); const unsigned nib = (((nn < 8) ? w0 : w1) >> (4 * (nn & 7))) & 15u; o2[j >> 3] |= nib << (4 * (j & 7)); }
            *(u32x2*)(F.ws + WS_V8 + (size_t)(lane >> 4) * (NEXP * 128) + (size_t)e * 128 + (lane & 15) * 8) = (u32x2){o2[0], o2[1]};
          }
        }
    }
}

template <bool WITH8> __device__ __forceinline__ void norm_phase(Frame& F, const float* xin, const float* g, int sh_off, int sc_off, bf16_t* H, unsigned char* H8) {
    const float* mod = (const float*)(F.ws + WS_MOD);
    for (int tile = blockIdx.x; tile < MT / 256; tile += F.G) {
        const int b = tile >> 4, r0 = tile * 256 + F.wave * 32;
        f32x4 A[4], Bv[4];
#pragma unroll
        for (int j = 0; j < 4; ++j) { const int cix = WITH8 ? 8 * F.lane + 512 * (j >> 1) + 4 * (j & 1) : 4 * F.lane + 256 * j;
            const f32x4 gg = *(const f32x4*)(g + cix), sc = *(const f32x4*)(mod + b * 6144 + sc_off + cix);
            A[j] = gg * (sc + 1.0f); Bv[j] = *(const f32x4*)(mod + b * 6144 + sh_off + cix); }
#pragma unroll 2
        for (int rr = 0; rr < 32; ++rr) {
            const float* xr = xin + (size_t)(r0 + rr) * 1024 + 4 * F.lane;
            f32x4 v[4]; float s = 0.f;
            if constexpr (WITH8) {
#pragma unroll
                for (int jh = 0; jh < 2; ++jh) { const u32x4 w = *(const u32x4*)((const bf16_t*)xin + (size_t)(r0 + rr) * 2048 + 8 * F.lane + 512 * jh);
                    v[2 * jh] = (f32x4){bf_lo(w.x), bf_hi(w.x), bf_lo(w.y), bf_hi(w.y)}; v[2 * jh + 1] = (f32x4){bf_lo(w.z), bf_hi(w.z), bf_lo(w.w), bf_hi(w.w)}; }
            }
#pragma unroll
            for (int j = 0; j < 4; ++j) {
                if constexpr (!WITH8) v[j] = *(const f32x4*)(xr + 256 * j);
                s += (v[j][0] * v[j][0] + v[j][1] * v[j][1]) + (v[j][2] * v[j][2] + v[j][3] * v[j][3]); }
            const float rstd = 1.0f / sqrtf(wave_sum(s) * (1.f / 1024.f) + NORM_EPS);
            bf16_t* hr = H + (size_t)(r0 + rr) * 1024 + 4 * F.lane;
            int wh8[4];
#pragma unroll
            for (int j = 0; j < 4; ++j) { const f32x4 y = v[j] * rstd * A[j] + Bv[j]; if constexpr (!WITH8) { u32x2 o; o.x = pk2(y[0], y[1]); o.y = pk2(y[2], y[3]); *(u32x2*)(hr + 256 * j) = o; }
                if constexpr (WITH8) { int wh = 0; wh = __builtin_amdgcn_cvt_pk_fp8_f32(y[0], y[1], wh, false); wh = __builtin_amdgcn_cvt_pk_fp8_f32(y[2], y[3], wh, true); wh8[j] = wh; } }
            if constexpr (WITH8) {
#pragma unroll
                for (int jh = 0; jh < 2; ++jh) *(u32x2*)(H8 + (size_t)(r0 + rr) * 1024 + 8 * F.lane + 512 * jh) = (u32x2){(unsigned)wh8[2 * jh], (unsigned)wh8[2 * jh + 1]};
            }
        }
    }
}

namespace att {
constexpr int LDS_TAB = 98304;
constexpr int LDS_KM = LDS_TAB + 8192;
constexpr int LDS_SG = LDS_KM + 4096;
constexpr int LDS_LAM = LDS_SG + 512;
constexpr int LDS_TAB2 = 114688;
constexpr int TAB2_W = 512;
constexpr float THR = 8.0f;
__device__ __forceinline__ int crow(int r, int hi) { return (r & 3) + 8 * (r >> 2) + 4 * hi; }
__device__ __forceinline__ float pair_max(float v) { auto rr = __builtin_amdgcn_permlane32_swap(__float_as_uint(v), __float_as_uint(v), false, false); return fmaxf(__uint_as_float(rr[0]), __uint_as_float(rr[1])); }
__device__ __forceinline__ float pair_sum(float v) { auto rr = __builtin_amdgcn_permlane32_swap(__float_as_uint(v), __float_as_uint(v), false, false); return __uint_as_float(rr[0]) + __uint_as_float(rr[1]); }
__device__ __forceinline__ float max3f(float a, float b, float c) { return fmaxf(fmaxf(a, b), c); }

template <bool DIFF>
__device__ __forceinline__ bool unit(LAS unsigned char* lds, const bf16_t* __restrict__ QK, const bf16_t* __restrict__ VT, bf16_t* AO, const float* __restrict__ ksum, int b, int hh, int qt, float& mshift, bool pre, bool has_next, int nb, int nhh, int nqt, int& b0) {
    constexpr int DV = DIFF ? 128 : 64, ND0 = DV / 32;
    constexpr int STG = DIFF ? 32768 : 16384, VOFF = DIFF ? 16384 : 8192;
    const int tid = threadIdx.x, lane = tid & 63, r32 = lane & 31, hi = lane >> 5;
    const int wid = __builtin_amdgcn_readfirstlane(tid >> 6);
    const int map = DIFF ? (wid >> 2) : 0;
    const int qw0 = DIFF ? (qt * 128 + 32 * (wid & 3)) : (qt * 256 + 32 * wid);
    const int qpos = qw0 + r32;
    const size_t tok0 = (size_t)b * SEQ;
    const int srow = wid * 8 + (lane >> 3), sch = (lane & 7) ^ ((srow >> 1) & 7);
    const bf16_t* kg0 = QK + (tok0 + srow) * QKW + (DIFF ? (512 + hh * 128) : (1536 + hh * 64)) + sch * 8;
    const bf16_t* vg0 = VT + (size_t)((DIFF ? hh * 128 : 512 + hh * 64) + srow) * MT + tok0 + sch * 8;
    const int kx = (r32 >> 1) & 7;
    const int kr_base = r32 * 128 + (DIFF ? map * 8192 : 0);
    const int vr_base = VOFF + r32 * 128;
    bf16x8 qf[4];
    {
        const bf16_t* qp = QK + (tok0 + qpos) * QKW + (DIFF ? (hh * 128 + map * 64) : (1024 + hh * 64)) + hi * 8;
#pragma unroll
        for (int s = 0; s < 4; ++s) qf[s] = *(const bf16x8*)(qp + 16 * s);
    }
    const LAS float* tab = (const LAS float*)(lds + LDS_TAB2) + (DIFF ? (map * 4 + hh) : (8 + hh)) * TAB2_W + 197;
    unsigned selmask = 0u;
    if constexpr (!DIFF) {
        LAS float* km = (LAS float*)(lds + LDS_KM);
        for (int i = tid; i < 1024; i += 512) { const int n = i >> 6, dd = i & 63; km[i] = ksum[(size_t)(b * 16 + n) * 512 + hh * 64 + dd] * (1.f / 256.f); }
        __syncthreads();
        float qv[32];
#pragma unroll
        for (int s = 0; s < 4; ++s)
#pragma unroll
            for (int j = 0; j < 8; ++j) qv[s * 8 + j] = __uint_as_float(((unsigned)(unsigned short)qf[s][j]) << 16);
        float v0 = -INFINITY, v1 = -INFINITY, v2 = -INFINITY; int i0 = -1, i1 = -1, i2 = -1;
        for (int n = 0; n < qt; ++n) {
            float part = 0.f;
#pragma unroll
            for (int s = 0; s < 4; ++s) {
                const f32x4 ka = *(const LAS f32x4*)(km + n * 64 + 16 * s + 8 * hi), kb = *(const LAS f32x4*)(km + n * 64 + 16 * s + 8 * hi + 4);
                part += qv[s * 8 + 0] * ka[0] + qv[s * 8 + 1] * ka[1] + qv[s * 8 + 2] * ka[2] + qv[s * 8 + 3] * ka[3] + qv[s * 8 + 4] * kb[0] + qv[s * 8 + 5] * kb[1] + qv[s * 8 + 6] * kb[2] + qv[s * 8 + 7] * kb[3];
            }
            const float gte = pair_sum(part);
            if (gte > v0) { v2 = v1; i2 = i1; v1 = v0; i1 = i0; v0 = gte; i0 = n; }
            else if (gte > v1) { v2 = v1; i2 = i1; v1 = gte; i1 = n; }
            else if (gte > v2) { v2 = gte; i2 = n; }
        }
        if (i0 >= 0) selmask |= 1u << i0;
        if (i1 >= 0) selmask |= 1u << i1;
        if (i2 >= 0) selmask |= 1u << i2;
    }
    const int NTILE = DIFF ? 2 * (qt + 1) : 4 * (qt + 1);
    auto tile_k0 = [&](int i) -> int { if constexpr (DIFF) return 64 * i; else return (i < 4) ? (qt * 256 + 64 * i) : (((i - 4) >> 2) * 256 + 64 * ((i - 4) & 3)); };
    auto stage_from = [&](const bf16_t* kp, const bf16_t* vp, int buf) {
        LAS unsigned char* sb = lds + buf * STG + wid * 1024;
        __builtin_amdgcn_global_load_lds((const unsigned*)kp, (LAS unsigned*)sb, 16, 0, 0);
        if constexpr (DIFF) {
            __builtin_amdgcn_global_load_lds((const unsigned*)(kp + 64), (LAS unsigned*)(sb + 8192), 16, 0, 0);
            __builtin_amdgcn_global_load_lds((const unsigned*)vp, (LAS unsigned*)(sb + VOFF), 16, 0, 0);
            __builtin_amdgcn_global_load_lds((const unsigned*)(vp + (size_t)64 * MT), (LAS unsigned*)(sb + VOFF + 8192), 16, 0, 0);
        } else {
            __builtin_amdgcn_global_load_lds((const unsigned*)vp, (LAS unsigned*)(sb + VOFF), 16, 0, 0);
        }
    };
    auto stage = [&](int k0, int buf) { stage_from(kg0 + (size_t)k0 * QKW, vg0 + k0, buf); };
    auto stage_next = [&](int ti, int buf) {
        const size_t ntok0 = (size_t)nb * SEQ; const int nk0 = DIFF ? 0 : nqt * 256 + 64 * ti;
        stage_from(QK + (ntok0 + srow + nk0) * QKW + (DIFF ? (512 + nhh * 128) : (1536 + nhh * 64)) + sch * 8,
                   VT + (size_t)((DIFF ? nhh * 128 : 512 + nhh * 64) + srow) * MT + ntok0 + sch * 8 + nk0, buf);
    };
    float m_ref = 0.f, l_run = 0.f, smax = 0.f;
    float cblk = 0.f;
    f32x16 o[ND0];
#pragma unroll
    for (int d0 = 0; d0 < ND0; ++d0) o[d0] = f32x16{};
    constexpr int NMF = 4 * ND0, EPM = 32 / NMF;
    u32x4 pkA[4], pkB[4];
    constexpr int VB = 2;
    bf16x8 vfr[VB][ND0];
    auto qk_tile = [&](int t, int bufi, int bufprev, f32x16& p0, f32x16& p1, auto firstc) {
        constexpr bool FIRST = decltype(firstc)::value;
        const int k0 = tile_k0(t);
        const LAS unsigned char* sb = lds + bufi * STG;
        if constexpr (!DIFF) {
            if (t >= 4 && ((t & 3) == 0)) { const bool msk = ((selmask >> ((t - 4) >> 2)) & 1u) == 0u; cblk = msk ? NEGBIG : -m_ref; }
        }
        bf16x8 kfa[4], kfb[4];
#pragma unroll
        for (int s = 0; s < 4; ++s) { const int co = ((2 * s + hi) ^ kx) << 4; kfa[s] = *(const LAS bf16x8*)(sb + kr_base + co); kfb[s] = *(const LAS bf16x8*)(sb + kr_base + 4096 + co); }
        if constexpr (!FIRST) {
            const LAS unsigned char* sp = lds + bufprev * STG;
#pragma unroll
            for (int ks = 0; ks < VB; ++ks) { const int vo = ((2 * ks + hi) ^ kx) << 4;
#pragma unroll
                for (int d0 = 0; d0 < ND0; ++d0) vfr[ks][d0] = *(const LAS bf16x8*)(sp + vr_base + d0 * 4096 + vo); }
        }
        __builtin_amdgcn_sched_barrier(0);
        if constexpr (FIRST) { p0 = __builtin_amdgcn_mfma_f32_32x32x16_bf16(kfa[0], qf[0], f32x16{}, 0, 0, 0); p1 = __builtin_amdgcn_mfma_f32_32x32x16_bf16(kfb[0], qf[0], f32x16{}, 0, 0, 0); }
        else {
            const float c0 = (!DIFF && t >= 4) ? cblk : -m_ref;
#pragma unroll
            for (int r = 0; r < 16; ++r) { p0[r] = c0; p1[r] = c0; }
            p0 = __builtin_amdgcn_mfma_f32_32x32x16_bf16(kfa[0], qf[0], p0, 0, 0, 0); p1 = __builtin_amdgcn_mfma_f32_32x32x16_bf16(kfb[0], qf[0], p1, 0, 0, 0); }
#pragma unroll
        for (int s = 1; s < 4; ++s) {
            p0 = __builtin_amdgcn_mfma_f32_32x32x16_bf16(kfa[s], qf[s], p0, 0, 0, 0);
            p1 = __builtin_amdgcn_mfma_f32_32x32x16_bf16(kfb[s], qf[s], p1, 0, 0, 0);
        }
        __builtin_amdgcn_sched_barrier(0);
        if (qw0 - (k0 + 63) < 128) {
            const LAS float* tb = tab + (qpos - k0 - 4 * hi); asm volatile("" : "+v"(tb));
#pragma unroll
            for (int rq = 0; rq < 4; ++rq) {
#pragma unroll
                for (int r = 4 * rq; r < 4 * rq + 4; ++r) { p0[r] += tb[59 - crow(r, 0)]; p1[r] += tb[27 - crow(r, 0)]; }
                __builtin_amdgcn_sched_barrier(0);
            }
        }
    };
    auto softmax_only = [&](f32x16& p0, f32x16& p1, u32x4 (&pkn)[4]) {
        float sum = 0.f;
#pragma unroll
        for (int r = 0; r < 16; ++r) { p0[r] = __builtin_amdgcn_exp2f(p0[r]); p1[r] = __builtin_amdgcn_exp2f(p1[r]); sum += p0[r] + p1[r]; }
        l_run += sum; smax = fmaxf(smax, sum);
        pkn[0] = (u32x4){pk2(p0[0], p0[1]), pk2(p0[2], p0[3]), pk2(p0[4], p0[5]), pk2(p0[6], p0[7])};
        pkn[1] = (u32x4){pk2(p0[8], p0[9]), pk2(p0[10], p0[11]), pk2(p0[12], p0[13]), pk2(p0[14], p0[15])};
        pkn[2] = (u32x4){pk2(p1[0], p1[1]), pk2(p1[2], p1[3]), pk2(p1[4], p1[5]), pk2(p1[6], p1[7])};
        pkn[3] = (u32x4){pk2(p1[8], p1[9]), pk2(p1[10], p1[11]), pk2(p1[12], p1[13]), pk2(p1[14], p1[15])};
    };
    auto pv_exp = [&](int bufprev, const u32x4 (&pkp)[4], f32x16& p0, f32x16& p1, u32x4 (&pkn)[4], auto withexp) {
        constexpr bool WE = decltype(withexp)::value;
        const LAS unsigned char* sp = lds + bufprev * STG;
        float sum = 0.f;
#pragma unroll
        for (int i = 0; i < NMF; ++i) {
            const int ks = i / ND0, d0 = i % ND0;
            const bf16x8 pf = __builtin_bit_cast(bf16x8, pkp[ks]);
            o[d0] = __builtin_amdgcn_mfma_f32_32x32x16_bf16(vfr[ks % VB][d0], pf, o[d0], 0, 0, 0);
            if (d0 == ND0 - 1 && ks + VB < 4) { const int vo = ((2 * (ks + VB) + hi) ^ kx) << 4;
#pragma unroll
                for (int dd = 0; dd < ND0; ++dd) vfr[ks % VB][dd] = *(const LAS bf16x8*)(sp + vr_base + dd * 4096 + vo); }
            if constexpr (WE) {
#pragma unroll
                for (int e2 = 0; e2 < EPM; e2 += 2) {
                    const int j = i * EPM + e2;
                    float a = (j < 16) ? p0[j] : p1[j - 16], b2 = (j < 16) ? p0[j + 1] : p1[j - 15];
                    a = __builtin_amdgcn_exp2f(a); b2 = __builtin_amdgcn_exp2f(b2);
                    sum += a; sum += b2;
                    unsigned wv = pk2(a, b2);
                    asm volatile("" : "+v"(wv), "+v"(sum));
                    pkn[j >> 3][(j >> 1) & 3] = wv;
                }
            }
            __builtin_amdgcn_sched_barrier(0);
        }
        l_run += sum; if constexpr (WE) smax = fmaxf(smax, sum);
    };
    int bp = 0, bc = 1, bn = 2;
    if constexpr (DIFF) {
    bp = b0; bc = (b0 == 2) ? 0 : b0 + 1; bn = (bc == 2) ? 0 : bc + 1;
    if (!pre) stage(tile_k0(0), bp);
    __syncthreads();
    {
        f32x16 p0, p1;
        stage(tile_k0(1), bc);
        qk_tile(0, bp, bp, p0, p1, std::true_type{});
        float mx = max3f(p0[0], p0[1], p1[0]);
#pragma unroll
        for (int r = 2; r < 16; r += 2) mx = max3f(mx, p0[r], p0[r + 1]);
#pragma unroll
        for (int r = 1; r < 15; r += 2) mx = max3f(mx, p1[r], p1[r + 1]);
        mx = fmaxf(mx, p1[15]);
        m_ref = pair_max(mx) + mshift;
#pragma unroll
        for (int r = 0; r < 16; ++r) { p0[r] -= m_ref; p1[r] -= m_ref; }
        softmax_only(p0, p1, pkA);
        __syncthreads();
    }
    for (int t = 1; t < NTILE; t += 2) {
        {   f32x16 p0, p1;
            if (t + 1 < NTILE) stage(tile_k0(t + 1), bn);
            else if (has_next) stage_next(0, bn);
            qk_tile(t, bc, bp, p0, p1, std::false_type{});
            pv_exp(bp, pkA, p0, p1, pkB, std::true_type{});
            __syncthreads();
            const int tmp = bp; bp = bc; bc = bn; bn = tmp; }
        if (t + 1 < NTILE) {
            f32x16 p0, p1;
            if (t + 2 < NTILE) stage(tile_k0(t + 2), bn);
            qk_tile(t + 1, bc, bp, p0, p1, std::false_type{});
            pv_exp(bp, pkB, p0, p1, pkA, std::true_type{});
            __syncthreads();
            const int tmp = bp; bp = bc; bc = bn; bn = tmp; }
    }
    {
        const LAS unsigned char* sp = lds + bp * STG;
#pragma unroll
        for (int ks = 0; ks < VB; ++ks) { const int vo = ((2 * ks + hi) ^ kx) << 4;
#pragma unroll
            for (int d0 = 0; d0 < ND0; ++d0) vfr[ks][d0] = *(const LAS bf16x8*)(sp + vr_base + d0 * 4096 + vo); }
        f32x16 dz0, dz1;
        pv_exp(bp, pkB, dz0, dz1, pkA, std::false_type{});
        __syncthreads();
    }
    } else
    {
        f32x16 pA0, pA1, pB0, pB1;
        bf16x8 kfa[4], kfb[4];
        auto kread = [&](int tt) { const LAS unsigned char* sk = lds + (tt & 3) * STG;
#pragma unroll
            for (int s_ = 0; s_ < 4; ++s_) { const int co = ((2 * s_ + hi) ^ kx) << 4; kfa[s_] = *(const LAS bf16x8*)(sk + kr_base + co); kfb[s_] = *(const LAS bf16x8*)(sk + kr_base + 4096 + co); } };
        auto vread = [&](int tt) { const LAS unsigned char* sp = lds + (tt & 3) * STG;
#pragma unroll
            for (int ks = 0; ks < VB; ++ks) { const int vo = ((2 * ks + hi) ^ kx) << 4;
#pragma unroll
                for (int d0 = 0; d0 < ND0; ++d0) vfr[ks][d0] = *(const LAS bf16x8*)(sp + vr_base + d0 * 4096 + vo); } };
        f32x16 cvec;
        auto cinit = [&](int tt, f32x16&, f32x16&) {
            if (tt == 1 || (tt >= 4 && ((tt & 3) == 0))) {
                if (tt >= 4) { const bool msk = ((selmask >> ((tt - 4) >> 2)) & 1u) == 0u; cblk = msk ? NEGBIG : -m_ref; }
                const float c0 = (tt >= 4) ? cblk : -m_ref;
#pragma unroll
                for (int r = 0; r < 16; ++r) cvec[r] = c0;
            } };
        auto nearbias = [&](int tt, f32x16& q0, f32x16& q1) {
            const int k0 = tile_k0(tt);
            if (qw0 - (k0 + 63) < 128) {
                const LAS float* tb = tab + (qpos - k0 - 4 * hi); asm volatile("" : "+v"(tb));
#pragma unroll
                for (int rq = 0; rq < 4; ++rq) {
#pragma unroll
                    for (int r = 4 * rq; r < 4 * rq + 4; ++r) { q0[r] += tb[59 - crow(r, 0)]; q1[r] += tb[27 - crow(r, 0)]; }
                    __builtin_amdgcn_sched_barrier(0);
                }
            } };
        auto seg = [&](int t, f32x16& c0v, f32x16& c1v, f32x16& n0, f32x16& n1, const u32x4 (&pkp)[4], u32x4 (&pkc)[4], auto hasqk, auto haspv) {
            constexpr bool HASQK = decltype(hasqk)::value, HASPV = decltype(haspv)::value;
            const LAS unsigned char* sp = lds + ((t - 1) & 3) * STG;
            float sum = 0.f;
#pragma unroll
            for (int i = 0; i < 8; ++i) {
                if constexpr (HASQK) { const int s_ = i >> 1;
                    if (i == 0)      asm volatile("s_nop 1\n\tv_mfma_f32_32x32x16_bf16 %0, %1, %2, %3" : "=&v"(n0) : "v"(kfa[0]), "v"(qf[0]), "v"(cvec));
                    else if (i == 1) asm volatile("v_mfma_f32_32x32x16_bf16 %0, %1, %2, %3" : "=&v"(n1) : "v"(kfb[0]), "v"(qf[0]), "v"(cvec));
                    else if (i & 1) n1 = __builtin_amdgcn_mfma_f32_32x32x16_bf16(kfb[s_], qf[s_], n1, 0, 0, 0);
                    else            n0 = __builtin_amdgcn_mfma_f32_32x32x16_bf16(kfa[s_], qf[s_], n0, 0, 0, 0); }
                if constexpr (HASPV) { const int ks = i >> 1, d0 = i & 1;
                    o[d0] = __builtin_amdgcn_mfma_f32_32x32x16_bf16(vfr[ks % VB][d0], __builtin_bit_cast(bf16x8, pkp[ks]), o[d0], 0, 0, 0);
                    if (d0 == 1 && ks + VB < 4) { const int vo = ((2 * (ks + VB) + hi) ^ kx) << 4;
#pragma unroll
                        for (int dd = 0; dd < ND0; ++dd) vfr[ks % VB][dd] = *(const LAS bf16x8*)(sp + vr_base + dd * 4096 + vo); } }
#pragma unroll
                for (int e2 = 0; e2 < 4; e2 += 2) {
                    const int j = 4 * i + e2;
                    float a_ = (j < 16) ? c0v[j] : c1v[j - 16], b_ = (j < 16) ? c0v[j + 1] : c1v[j - 15];
                    a_ = __builtin_amdgcn_exp2f(a_); b_ = __builtin_amdgcn_exp2f(b_);
                    sum += a_; sum += b_;
                    unsigned wv = pk2(a_, b_);
                    asm volatile("" : "+v"(wv), "+v"(sum));
                    pkc[j >> 3][(j >> 1) & 3] = wv;
                }
                __builtin_amdgcn_sched_barrier(0);
            }
            l_run += sum; smax = fmaxf(smax, sum);
        };
        if (!pre) { stage(tile_k0(0), 0); __syncthreads(); stage(tile_k0(1), 1); }
        {
            kread(0);
            __builtin_amdgcn_sched_barrier(0);
            pA0 = __builtin_amdgcn_mfma_f32_32x32x16_bf16(kfa[0], qf[0], f32x16{}, 0, 0, 0); pA1 = __builtin_amdgcn_mfma_f32_32x32x16_bf16(kfb[0], qf[0], f32x16{}, 0, 0, 0);
#pragma unroll
            for (int s_ = 1; s_ < 4; ++s_) { pA0 = __builtin_amdgcn_mfma_f32_32x32x16_bf16(kfa[s_], qf[s_], pA0, 0, 0, 0); pA1 = __builtin_amdgcn_mfma_f32_32x32x16_bf16(kfb[s_], qf[s_], pA1, 0, 0, 0); }
            __builtin_amdgcn_sched_barrier(0);
            nearbias(0, pA0, pA1);
            float mx = max3f(pA0[0], pA0[1], pA1[0]);
#pragma unroll
            for (int r = 2; r < 16; r += 2) mx = max3f(mx, pA0[r], pA0[r + 1]);
#pragma unroll
            for (int r = 1; r < 15; r += 2) mx = max3f(mx, pA1[r], pA1[r + 1]);
            mx = fmaxf(mx, pA1[15]);
            m_ref = pair_max(mx) + mshift;
#pragma unroll
            for (int r = 0; r < 16; ++r) { pA0[r] -= m_ref; pA1[r] -= m_ref; }
        }
        __syncthreads();
        {
            stage(tile_k0(2), 2);
            kread(1); cinit(1, pB0, pB1);
            __builtin_amdgcn_sched_barrier(0);
            seg(0, pA0, pA1, pB0, pB1, pkB, pkA, std::true_type{}, std::false_type{});
            nearbias(1, pB0, pB1);
            __syncthreads();
        }
        for (int t = 1; t + 2 < NTILE; t += 2) {
            {
                if (t + 2 < NTILE) stage(tile_k0(t + 2), (t + 2) & 3);
                kread(t + 1); vread(t - 1); cinit(t + 1, pA0, pA1);
                __builtin_amdgcn_sched_barrier(0);
                seg(t, pB0, pB1, pA0, pA1, pkA, pkB, std::true_type{}, std::true_type{});
                nearbias(t + 1, pA0, pA1);
                __syncthreads(); }
            {
                if (t + 3 < NTILE) stage(tile_k0(t + 3), (t + 3) & 3);
                else if (has_next) stage_next(0, 0);
                kread(t + 2); vread(t); cinit(t + 2, pB0, pB1);
                __builtin_amdgcn_sched_barrier(0);
                seg(t + 1, pA0, pA1, pB0, pB1, pkB, pkA, std::true_type{}, std::true_type{});
                nearbias(t + 2, pB0, pB1);
                __syncthreads(); }
        }
        {
            if (has_next) stage_next(1, 1);
            vread(NTILE - 2);
            __builtin_amdgcn_sched_barrier(0);
            seg(NTILE - 1, pB0, pB1, pA0, pA1, pkA, pkB, std::false_type{}, std::true_type{});
            __syncthreads();
        }
        {
            vread(NTILE - 1);
            f32x16 dz0, dz1;
            pv_exp((NTILE - 1) & 3, pkB, dz0, dz1, pkA, std::false_type{});
            __syncthreads();
        }
    }
    {
        const bool badl = !(smax <= 0x1p60f);
        const int badp = __shfl_xor((int)badl, 32);
        const bool badrow = badl || (badp != 0);
        if (badrow) mshift += 64.f;
        LAS unsigned* flag = (LAS unsigned*)(lds + MISC_OFF + 64);
        if (tid == 0) *flag = 0u;
        __syncthreads();
        if (badrow) *flag = 1u;
        __syncthreads();
        const bool redo = *flag != 0u;
        __syncthreads();
        if (redo) return true;
    }
    const float linv = 1.0f / pair_sum(l_run);
    if constexpr (DIFF) {
        b0 = bc;
        LAS float* ex0 = (LAS float*)(lds + bp * STG); LAS float* ex1 = (LAS float*)(lds + bn * STG);
        LAS float* ex = nullptr; (void)ex;
        if (map == 1) {
#pragma unroll
            for (int d0 = 0; d0 < ND0; ++d0)
#pragma unroll
                for (int r = 0; r < 16; ++r) ((d0 >> 1) ? ex1 : ex0)[((d0 & 1) * 16 + r) * 256 + (wid & 3) * 64 + lane] = o[d0][r] * linv;
        }
        __syncthreads();
        if (map == 0) {
            const float lam = *(const LAS float*)(lds + LDS_LAM);
            const LAS float* sg = (const LAS float*)(lds + LDS_SG);
            float ss = 0.f;
#pragma unroll
            for (int d0 = 0; d0 < ND0; ++d0)
#pragma unroll
                for (int r = 0; r < 16; ++r) { const float v = o[d0][r] * linv - lam * ((d0 >> 1) ? ex1 : ex0)[((d0 & 1) * 16 + r) * 256 + (wid & 3) * 64 + lane]; o[d0][r] = v; ss += v * v; }
            ss = pair_sum(ss);
            const float rstd = 0.8f / sqrtf(ss * (1.f / 128.f) + NORM_EPS);
            bf16_t* op = AO + (tok0 + qpos) * 1024 + hh * 128 + 4 * hi;
#pragma unroll
            for (int d0 = 0; d0 < ND0; ++d0)
#pragma unroll
                for (int rg = 0; rg < 4; ++rg) {
                    const int dcol = 32 * d0 + 8 * rg + 4 * hi;
                    const f32x4 gg = *(const LAS f32x4*)(sg + dcol);
                    u32x2 w; w.x = pk2(o[d0][4 * rg] * rstd * gg[0], o[d0][4 * rg + 1] * rstd * gg[1]); w.y = pk2(o[d0][4 * rg + 2] * rstd * gg[2], o[d0][4 * rg + 3] * rstd * gg[3]);
                    *(u32x2*)(op + 32 * d0 + 8 * rg) = w;
                }
        }
        __syncthreads();
    } else {
        LAS unsigned char* ob = lds + 2 * STG + wid * 4096;
#pragma unroll
        for (int d0 = 0; d0 < ND0; ++d0)
#pragma unroll
            for (int rg = 0; rg < 4; ++rg) {
                u32x2 w; w.x = pk2(o[d0][4 * rg] * linv, o[d0][4 * rg + 1] * linv); w.y = pk2(o[d0][4 * rg + 2] * linv, o[d0][4 * rg + 3] * linv);
                const int cb_ = (32 * d0 + 8 * rg + 4 * hi) * 2;
                *(LAS u32x2*)(ob + r32 * 128 + (((cb_ >> 4) ^ (r32 & 7)) << 4) + (cb_ & 15)) = w;
            }
#pragma unroll
        for (int i = 0; i < 4; ++i) {
            const int R = (lane >> 3) + 8 * i, c = lane & 7;
            const u32x4 v = *(const LAS u32x4*)(ob + R * 128 + ((c ^ (R & 7)) << 4));
            *(u32x4*)(AO + (tok0 + qw0 + R) * 1024 + 512 + hh * 64 + 8 * c) = v;
        }
    }
    return false;
}
}

__device__ __forceinline__ void attn_phase(Frame& F) {
    const int tid = F.tid;
    {
        LAS float* tabs = (LAS float*)(F.lds + att::LDS_TAB);
        LAS float* tabs2 = (LAS float*)(F.lds + att::LDS_TAB2);
        for (int i = tid; i < 16 * att::TAB2_W; i += 512) {
            const int col = i / att::TAB2_W, n = i % att::TAB2_W - 256;
            float val = 0.f;
            if (n < 0) val = NEGBIG;
            else if (n < 128) { int bucket;
                if (n < 16) bucket = n;
                else { const float nf = (float)n; int lg = 16 + (int)(logf(nf / 16.0f) / 2.0794415416798357f * 16.0f); bucket = lg < 31 ? lg : 31; }
                val = (F.rel_bias[bucket * 16 + col] - F.rel_bias[31 * 16 + col]) * LOG2E; }
            tabs2[i] = val;
        }
        (void)tabs;
        LAS float* sg = (LAS float*)(F.lds + att::LDS_SG);
        if (tid < 128) sg[tid] = F.subln_g[tid];
        if (F.wave == 7) {
            const float a = F.diff_lambda[F.lane] * F.diff_lambda[64 + F.lane], bq = F.diff_lambda[128 + F.lane] * F.diff_lambda[192 + F.lane];
            const float sa = wave_sum(a), sb = wave_sum(bq);
            if (F.lane == 0) *(LAS float*)(F.lds + att::LDS_LAM) = expf(sa) - expf(sb) + 0.2f;
        }
        __syncthreads();
    }
    const bf16_t* QK = (const bf16_t*)(F.ws + WS_QK); const bf16_t* VT = (const bf16_t*)(F.ws + WS_VT); bf16_t* AO = (bf16_t*)(F.ws + WS_AO);
    const float* ksum = (const float*)(F.ws + WS_KSUM);
    unsigned lb_; { const unsigned lv_ = (unsigned)(unsigned long)F.lds; asm volatile("s_nop 0\n\tv_readfirstlane_b32 %0, %1" : "=s"(lb_) : "v"(lv_)); }
    LAS unsigned char* const L0 = (LAS unsigned char*)(unsigned long)lb_;
    if (F.G == 256) {
        { const int bh = F.vcu >> 2, quarter = F.vcu & 3;
          bool pre = false; int b0 = 0;
          for (int i = 0; i < 8; ++i) { const int s = quarter * 4 + (i >> 1), qt = (i & 1) ? 31 - s : s; const int i2 = i + 1, s2 = quarter * 4 + (i2 >> 1), qt2 = (i2 & 1) ? 31 - s2 : s2;
              float msh = 0.f; bool mypre = pre; for (int a = 0; a < 8; ++a) { if (!att::unit<true>(L0, QK, VT, AO, ksum, bh >> 2, bh & 3, qt, msh, mypre, i < 7, bh >> 2, bh & 3, qt2, b0)) break; mypre = false; } pre = i < 7; } }
        { const int bh = F.vcu >> 1, half = F.vcu & 1;
          bool pre = false; int b0 = 0;
          for (int i = 0; i < 8; ++i) { const int s = half * 4 + (i >> 1), qt = (i & 1) ? 15 - s : s; const int i2 = i + 1, s2 = half * 4 + (i2 >> 1), qt2 = (i2 & 1) ? 15 - s2 : s2;
              float msh = 0.f; bool mypre = pre; for (int a = 0; a < 8; ++a) { if (!att::unit<false>(L0, QK, VT, AO, ksum, bh >> 3, bh & 7, qt, msh, mypre, i < 7, bh >> 3, bh & 7, qt2, b0)) break; mypre = false; } pre = i < 7; } }
    } else {
        for (int u = blockIdx.x; u < 2048; u += F.G) { const int bh = u >> 5; float msh = 0.f; int b0 = 0; for (int a = 0; a < 8 && att::unit<true>(L0, QK, VT, AO, ksum, bh >> 2, bh & 3, u & 31, msh, false, false, 0, 0, 0, b0); ++a) {} }
        for (int u = blockIdx.x; u < 2048; u += F.G) { const int bh = u >> 4; float msh = 0.f; int b0 = 0; for (int a = 0; a < 8 && att::unit<false>(L0, QK, VT, AO, ksum, bh >> 3, bh & 7, u & 15, msh, false, false, 0, 0, 0, b0); ++a) {} }
    }
}

__device__ __forceinline__ unsigned f2key(float f) { const unsigned u = __float_as_uint(f); return (u & 0x80000000u) ? ~u : (u | 0x80000000u); }
typedef short s16x2 __attribute__((ext_vector_type(2)));
__device__ __forceinline__ unsigned h2key2(unsigned w) { const s16x2 s = __builtin_bit_cast(s16x2, w) >> 15; return w ^ (__builtin_bit_cast(unsigned, s) | 0x80008000u); }
__device__ __forceinline__ unsigned h2key(unsigned x) { return (x & 0x80000000u) ? ~x : (x | 0x80000000u); }
__device__ __forceinline__ float key2h(unsigned k) { const unsigned hb = ((k & 0x80000000u) ? (k & 0x7fffffffu) : ~k) >> 16; return (float)__builtin_bit_cast(_Float16, (unsigned short)hb); }
__device__ __forceinline__ float key2f(unsigned k) { const unsigned u = (k & 0x80000000u) ? (k & 0x7fffffffu) : ~k; return __uint_as_float(u); }
__device__ __forceinline__ void ins16(unsigned (&L)[16], unsigned x) {
    unsigned prev = L[0]; L[0] = max(prev, x);
#pragma unroll
    for (int k = 1; k < 16; ++k) { const unsigned cur = L[k]; L[k] = min(max(prev, cur), max(min(prev, cur), x)); prev = cur; }
}
#define SORT16_DESC(L) do { unsigned t_; \
    t_ = max(L[0], L[1]); L[1] = min(L[0], L[1]); L[0] = t_; \
    t_ = max(L[2], L[3]); L[3] = min(L[2], L[3]); L[2] = t_; \
    t_ = max(L[0], L[2]); L[2] = min(L[0], L[2]); L[0] = t_; \
    t_ = max(L[1], L[3]); L[3] = min(L[1], L[3]); L[1] = t_; \
    t_ = max(L[1], L[2]); L[2] = min(L[1], L[2]); L[1] = t_; \
    t_ = max(L[4], L[5]); L[5] = min(L[4], L[5]); L[4] = t_; \
    t_ = max(L[6], L[7]); L[7] = min(L[6], L[7]); L[6] = t_; \
    t_ = max(L[4], L[6]); L[6] = min(L[4], L[6]); L[4] = t_; \
    t_ = max(L[5], L[7]); L[7] = min(L[5], L[7]); L[5] = t_; \
    t_ = max(L[5], L[6]); L[6] = min(L[5], L[6]); L[5] = t_; \
    t_ = max(L[0], L[4]); L[4] = min(L[0], L[4]); L[0] = t_; \
    t_ = max(L[2], L[6]); L[6] = min(L[2], L[6]); L[2] = t_; \
    t_ = max(L[2], L[4]); L[4] = min(L[2], L[4]); L[2] = t_; \
    t_ = max(L[1], L[5]); L[5] = min(L[1], L[5]); L[1] = t_; \
    t_ = max(L[3], L[7]); L[7] = min(L[3], L[7]); L[3] = t_; \
    t_ = max(L[3], L[5]); L[5] = min(L[3], L[5]); L[3] = t_; \
    t_ = max(L[1], L[2]); L[2] = min(L[1], L[2]); L[1] = t_; \
    t_ = max(L[3], L[4]); L[4] = min(L[3], L[4]); L[3] = t_; \
    t_ = max(L[5], L[6]); L[6] = min(L[5], L[6]); L[5] = t_; \
    t_ = max(L[8], L[9]); L[9] = min(L[8], L[9]); L[8] = t_; \
    t_ = max(L[10], L[11]); L[11] = min(L[10], L[11]); L[10] = t_; \
    t_ = max(L[8], L[10]); L[10] = min(L[8], L[10]); L[8] = t_; \
    t_ = max(L[9], L[11]); L[11] = min(L[9], L[11]); L[9] = t_; \
    t_ = max(L[9], L[10]); L[10] = min(L[9], L[10]); L[9] = t_; \
    t_ = max(L[12], L[13]); L[13] = min(L[12], L[13]); L[12] = t_; \
    t_ = max(L[14], L[15]); L[15] = min(L[14], L[15]); L[14] = t_; \
    t_ = max(L[12], L[14]); L[14] = min(L[12], L[14]); L[12] = t_; \
    t_ = max(L[13], L[15]); L[15] = min(L[13], L[15]); L[13] = t_; \
    t_ = max(L[13], L[14]); L[14] = min(L[13], L[14]); L[13] = t_; \
    t_ = max(L[8], L[12]); L[12] = min(L[8], L[12]); L[8] = t_; \
    t_ = max(L[10], L[14]); L[14] = min(L[10], L[14]); L[10] = t_; \
    t_ = max(L[10], L[12]); L[12] = min(L[10], L[12]); L[10] = t_; \
    t_ = max(L[9], L[13]); L[13] = min(L[9], L[13]); L[9] = t_; \
    t_ = max(L[11], L[15]); L[15] = min(L[11], L[15]); L[11] = t_; \
    t_ = max(L[11], L[13]); L[13] = min(L[11], L[13]); L[11] = t_; \
    t_ = max(L[9], L[10]); L[10] = min(L[9], L[10]); L[9] = t_; \
    t_ = max(L[11], L[12]); L[12] = min(L[11], L[12]); L[11] = t_; \
    t_ = max(L[13], L[14]); L[14] = min(L[13], L[14]); L[13] = t_; \
    t_ = max(L[0], L[8]); L[8] = min(L[0], L[8]); L[0] = t_; \
    t_ = max(L[4], L[12]); L[12] = min(L[4], L[12]); L[4] = t_; \
    t_ = max(L[4], L[8]); L[8] = min(L[4], L[8]); L[4] = t_; \
    t_ = max(L[2], L[10]); L[10] = min(L[2], L[10]); L[2] = t_; \
    t_ = max(L[6], L[14]); L[14] = min(L[6], L[14]); L[6] = t_; \
    t_ = max(L[6], L[10]); L[10] = min(L[6], L[10]); L[6] = t_; \
    t_ = max(L[2], L[4]); L[4] = min(L[2], L[4]); L[2] = t_; \
    t_ = max(L[6], L[8]); L[8] = min(L[6], L[8]); L[6] = t_; \
    t_ = max(L[10], L[12]); L[12] = min(L[10], L[12]); L[10] = t_; \
    t_ = max(L[1], L[9]); L[9] = min(L[1], L[9]); L[1] = t_; \
    t_ = max(L[5], L[13]); L[13] = min(L[5], L[13]); L[5] = t_; \
    t_ = max(L[5], L[9]); L[9] = min(L[5], L[9]); L[5] = t_; \
    t_ = max(L[3], L[11]); L[11] = min(L[3], L[11]); L[3] = t_; \
    t_ = max(L[7], L[15]); L[15] = min(L[7], L[15]); L[7] = t_; \
    t_ = max(L[7], L[11]); L[11] = min(L[7], L[11]); L[7] = t_; \
    t_ = max(L[3], L[5]); L[5] = min(L[3], L[5]); L[3] = t_; \
    t_ = max(L[7], L[9]); L[9] = min(L[7], L[9]); L[7] = t_; \
    t_ = max(L[11], L[13]); L[13] = min(L[11], L[13]); L[11] = t_; \
    t_ = max(L[1], L[2]); L[2] = min(L[1], L[2]); L[1] = t_; \
    t_ = max(L[3], L[4]); L[4] = min(L[3], L[4]); L[3] = t_; \
    t_ = max(L[5], L[6]); L[6] = min(L[5], L[6]); L[5] = t_; \
    t_ = max(L[7], L[8]); L[8] = min(L[7], L[8]); L[7] = t_; \
    t_ = max(L[9], L[10]); L[10] = min(L[9], L[10]); L[9] = t_; \
    t_ = max(L[11], L[12]); L[12] = min(L[11], L[12]); L[11] = t_; \
    t_ = max(L[13], L[14]); L[14] = min(L[13], L[14]); L[13] = t_; \
} while (0)
#define BITONIC16_DESC(L) do { unsigned t_; \
    t_ = max(L[0], L[8]); L[8] = min(L[0], L[8]); L[0] = t_; \
    t_ = max(L[1], L[9]); L[9] = min(L[1], L[9]); L[1] = t_; \
    t_ = max(L[2], L[10]); L[10] = min(L[2], L[10]); L[2] = t_; \
    t_ = max(L[3], L[11]); L[11] = min(L[3], L[11]); L[3] = t_; \
    t_ = max(L[4], L[12]); L[12] = min(L[4], L[12]); L[4] = t_; \
    t_ = max(L[5], L[13]); L[13] = min(L[5], L[13]); L[5] = t_; \
    t_ = max(L[6], L[14]); L[14] = min(L[6], L[14]); L[6] = t_; \
    t_ = max(L[7], L[15]); L[15] = min(L[7], L[15]); L[7] = t_; \
    t_ = max(L[0], L[4]); L[4] = min(L[0], L[4]); L[0] = t_; \
    t_ = max(L[1], L[5]); L[5] = min(L[1], L[5]); L[1] = t_; \
    t_ = max(L[2], L[6]); L[6] = min(L[2], L[6]); L[2] = t_; \
    t_ = max(L[3], L[7]); L[7] = min(L[3], L[7]); L[3] = t_; \
    t_ = max(L[8], L[12]); L[12] = min(L[8], L[12]); L[8] = t_; \
    t_ = max(L[9], L[13]); L[13] = min(L[9], L[13]); L[9] = t_; \
    t_ = max(L[10], L[14]); L[14] = min(L[10], L[14]); L[10] = t_; \
    t_ = max(L[11], L[15]); L[15] = min(L[11], L[15]); L[11] = t_; \
    t_ = max(L[0], L[2]); L[2] = min(L[0], L[2]); L[0] = t_; \
    t_ = max(L[1], L[3]); L[3] = min(L[1], L[3]); L[1] = t_; \
    t_ = max(L[4], L[6]); L[6] = min(L[4], L[6]); L[4] = t_; \
    t_ = max(L[5], L[7]); L[7] = min(L[5], L[7]); L[5] = t_; \
    t_ = max(L[8], L[10]); L[10] = min(L[8], L[10]); L[8] = t_; \
    t_ = max(L[9], L[11]); L[11] = min(L[9], L[11]); L[9] = t_; \
    t_ = max(L[12], L[14]); L[14] = min(L[12], L[14]); L[12] = t_; \
    t_ = max(L[13], L[15]); L[15] = min(L[13], L[15]); L[13] = t_; \
    t_ = max(L[0], L[1]); L[1] = min(L[0], L[1]); L[0] = t_; \
    t_ = max(L[2], L[3]); L[3] = min(L[2], L[3]); L[2] = t_; \
    t_ = max(L[4], L[5]); L[5] = min(L[4], L[5]); L[4] = t_; \
    t_ = max(L[6], L[7]); L[7] = min(L[6], L[7]); L[6] = t_; \
    t_ = max(L[8], L[9]); L[9] = min(L[8], L[9]); L[8] = t_; \
    t_ = max(L[10], L[11]); L[11] = min(L[10], L[11]); L[10] = t_; \
    t_ = max(L[12], L[13]); L[13] = min(L[12], L[13]); L[12] = t_; \
    t_ = max(L[14], L[15]); L[15] = min(L[14], L[15]); L[14] = t_; \
} while (0)
__device__ __forceinline__ void topk_panel(Frame& F, const void* P, int pm) {
    const int tid = F.tid, row = tid & 255, hq = tid >> 8;
    LAS unsigned* OUT = (LAS unsigned*)(F.lds + 16384) + row * 132;
    for (int hh = 0; hh < 4; ++hh) {
        const int h = hq * 4 + hh;
        unsigned L1[16], L2[16];
#pragma unroll
        for (int k = 0; k < 16; ++k) { L1[k] = 0u; L2[k] = 0u; }
        const u32x2* p1 = (const u32x2*)P + ((size_t)(h * 2) * 32 * 256 + row);
        const u32x2* p2 = p1 + (size_t)32 * 256;
        u32x2 cv[4], cw[4], nv[4], nw[4];
#pragma unroll
        for (int q = 0; q < 4; ++q) { cv[q] = p1[(size_t)q * 256]; cw[q] = p2[(size_t)q * 256]; }
#pragma unroll
        for (int c = 0; c < 8; ++c) {
            const int cn = (c < 7) ? c + 1 : 7;
#pragma unroll
            for (int q = 0; q < 4; ++q) { nv[q] = p1[(size_t)(cn * 4 + q) * 256]; nw[q] = p2[(size_t)(cn * 4 + q) * 256]; }
            unsigned C1[16], C2[16];
#pragma unroll
            for (int q = 0; q < 4; ++q)
#pragma unroll
                for (int e = 0; e < 4; e += 2) { const unsigned idx = (unsigned)(127 - (c * 16 + q * 4 + e));
                    const unsigned k1 = h2key2(cv[q][e >> 1]), k2 = h2key2(cw[q][e >> 1]);
                    C1[q * 4 + e] = (k1 << 16) | idx; C1[q * 4 + e + 1] = (k1 & 0xffff0000u) | (idx - 1u);
                    C2[q * 4 + e] = (k2 << 16) | idx; C2[q * 4 + e + 1] = (k2 & 0xffff0000u) | (idx - 1u); }
            SORT16_DESC(C1); SORT16_DESC(C2);
            if (c == 0) {
#pragma unroll
                for (int i = 0; i < 16; ++i) { L1[i] = C1[i]; L2[i] = C2[i]; }
            } else {
#pragma unroll
                for (int i = 0; i < 16; ++i) { L1[i] = max(L1[i], C1[15 - i]); L2[i] = max(L2[i], C2[15 - i]); }
                BITONIC16_DESC(L1); BITONIC16_DESC(L2);
            }
#pragma unroll
            for (int q = 0; q < 4; ++q) { cv[q] = nv[q]; cw[q] = nw[q]; }
        }
        float v1[16], v2[16];
#pragma unroll
        for (int k = 0; k < 16; ++k) { v1[k] = key2h(L1[k]) * (1.f / 64.f); v2[k] = key2h(L2[k]) * (1.f / 64.f); }
        LAS unsigned* myw = (LAS unsigned*)(F.lds + tid * 32);
#pragma unroll
        for (int q = 0; q < 4; ++q) {
            myw[q] = (127u - (L1[4 * q] & 127u)) | ((127u - (L1[4 * q + 1] & 127u)) << 8) | ((127u - (L1[4 * q + 2] & 127u)) << 16) | ((127u - (L1[4 * q + 3] & 127u)) << 24);
            myw[4 + q] = (127u - (L2[4 * q] & 127u)) | ((127u - (L2[4 * q + 1] & 127u)) << 8) | ((127u - (L2[4 * q + 2] & 127u)) << 16) | ((127u - (L2[4 * q + 3] & 127u)) << 24);
        }
        const LAS unsigned char* myb = (const LAS unsigned char*)myw;
#define CKEY(a, bb) ((f2key(v1[a] + v2[bb]) & ~255u) | (unsigned)(255 - ((a) * 16 + (bb))))
        unsigned L[16];
#pragma unroll
        for (int k = 0; k < 16; ++k) L[k] = CKEY(0, k);
#pragma unroll
        for (int a = 1; a <= 4; ++a) {
#pragma unroll
            for (int bb = 0; bb < 16; ++bb) if ((a + 1) * (bb + 1) <= 16) L[15 - bb] = max(L[15 - bb], CKEY(a, bb));
            BITONIC16_DESC(L);
        }
#pragma unroll
        for (int a = 5; a < 16; ++a)
#pragma unroll
            for (int bb = 0; bb < 16; ++bb)
                if ((a + 1) * (bb + 1) <= 16) ins16(L, CKEY(a, bb));
#undef CKEY
        float w[16]; float ssum = 0.f;
        const float mtop = key2f((L[0] & ~255u) | 128u);
#pragma unroll
        for (int k = 0; k < 16; ++k) { w[k] = __expf(key2f((L[k] & ~255u) | 128u) - mtop); ssum += w[k]; }
        const float inv = 1.0f / ssum;
#pragma unroll
        for (int k = 0; k < 16; ++k) {
            const int ci = 255 - (int)(L[k] & 255u);
            const int e1 = myb[ci >> 4], e2 = myb[16 + (ci & 15)];
            const int pos = (k & 7) * 16 + h * 2 + (k >> 3);
            OUT[pos] = (unsigned)(e1 * 128 + e2) | (pk2(0.f, w[k] * inv) & 0xffff0000u);
        }
    }
    __syncthreads();
    {
        unsigned char* PE = F.ws + WS_PE + (size_t)pm * (256 * 256); unsigned char* PG = F.ws + WS_PG + (size_t)pm * (256 * 256);
#pragma unroll
        for (int i = 0; i < 8; ++i) {
            const int c = tid + 512 * i, r = c >> 4, part = c & 15;
            const LAS u32x4* q = (const LAS u32x4*)(F.lds + 16384 + r * 528 + part * 32);
            const u32x4 a = q[0], b2 = q[1];
            *(u32x4*)(PE + (size_t)c * 16) = (u32x4){(a.x & 0xffffu) | (a.y << 16), (a.z & 0xffffu) | (a.w << 16), (b2.x & 0xffffu) | (b2.y << 16), (b2.z & 0xffffu) | (b2.w << 16)};
            *(u32x4*)(PG + (size_t)c * 16) = (u32x4){(a.x >> 16) | (a.y & 0xffff0000u), (a.z >> 16) | (a.w & 0xffff0000u), (b2.x >> 16) | (b2.y & 0xffff0000u), (b2.z >> 16) | (b2.w & 0xffff0000u)};
        }
    }
}

__device__ __forceinline__ float gelu_erf(float v) { return 0.5f * v * (1.0f + erff(v * 0.70710678118654752f)); }
typedef float f32x2 __attribute__((ext_vector_type(2)));
typedef int i32x2 __attribute__((ext_vector_type(2)));
typedef int i32x8 __attribute__((ext_vector_type(8)));
__device__ __forceinline__ float dpp_x1(float v) { return __int_as_float(__builtin_amdgcn_update_dpp(0, __float_as_int(v), 0xB1, 0xf, 0xf, false)); }
__device__ __forceinline__ float dpp_x2(float v) { return __int_as_float(__builtin_amdgcn_update_dpp(0, __float_as_int(v), 0x4E, 0xf, 0xf, false)); }
__device__ __forceinline__ float dpp_hm(float v) { return __int_as_float(__builtin_amdgcn_update_dpp(0, __float_as_int(v), 0x141, 0xf, 0xf, false)); }
__device__ __forceinline__ float dpp_r8(float v) { return __int_as_float(__builtin_amdgcn_update_dpp(0, __float_as_int(v), 0x128, 0xf, 0xf, false)); }
__device__ __forceinline__ unsigned e16_of(const u32x4& ea, const u32x4& eb, int i) { const unsigned w = (i < 8) ? ea[(i & 7) >> 1] : eb[(i & 7) >> 1]; return (i & 1) ? (w >> 16) : (w & 0xffffu); }

__device__ __forceinline__ void peer_u_phase(Frame& F) {
    const int lane = F.lane, wave = F.wave, g = lane >> 3, l8 = lane & 7, n = lane & 15, kg = lane >> 4;
    const unsigned char* PE = F.ws + WS_PE; const unsigned char* H8 = F.ws + WS_H8; bf16_t* PART = (bf16_t*)(F.ws + WS_PART);
    LAS unsigned char* stg = F.lds + wave * 16384;
    LAS unsigned char* ebuf = F.lds + 131072 + wave * 2048;
    const int soff0 = (l8 ^ (g >> 1)) << 4, soff1 = soff0 ^ 64;
    const int rkey = (n >> 1) & 7, rd0 = n * 128 + ((kg ^ rkey) << 4), rd1 = n * 128 + (((4 + kg) ^ rkey) << 4);
    const int erd = g * 32, brd = 512 + kg * 16;
    for (int it = blockIdx.x; it < 256; it += F.G) {
        const int x = it & 3, cb = it >> 2;
        const unsigned char* Ux = F.ws + WS_U8 + (size_t)x * (NEXP * 128);
        bf16_t* part = PART + (size_t)x * ((size_t)MT * 128);
        const int tok0 = cb * 1024 + wave * 128, tokl = tok0 + 127;
        const unsigned char* pe = PE + lane * 4; const unsigned char* ph = H8 + x * 256 + lane * 4;
#define U_DMA_E(tok, par) __builtin_amdgcn_global_load_lds((const unsigned*)(pe + (size_t)(tok) * 256), (LAS unsigned*)(ebuf + (par) * 256), 4, 0, 0)
#define U_DMA_B(tok, par) __builtin_amdgcn_global_load_lds((const unsigned*)(ph + (size_t)(tok) * 1024), (LAS unsigned*)(ebuf + 512 + (par) * 512), 4, 0, 0)
#define U_TILES(ea, eb) do { _Pragma("unroll") for (int j_ = 0; j_ < 16; ++j_) \
        __builtin_amdgcn_global_load_lds((const unsigned*)(Ux + (size_t)e16_of(ea, eb, j_) * 128 + ((j_ & 1) ? soff1 : soff0)), (LAS unsigned*)(stg + j_ * 1024), 16, 0, 0); } while (0)
#define U_TOKEN(tok, par, tokn1, tokn2) do { \
            U_DMA_E(tokn2, par); U_DMA_B(tokn1, (par) ^ 1); \
              \
            asm volatile("s_waitcnt vmcnt(3)" ::: "memory"); \
            u32x4 img[16]; \
            _Pragma("unroll") for (int T = 0; T < 8; ++T) { img[2 * T] = *(const LAS u32x4*)(stg + T * 2048 + rd0); img[2 * T + 1] = *(const LAS u32x4*)(stg + T * 2048 + rd1); } \
            const u32x4 eC0 = *(const LAS u32x4*)(ebuf + ((par) ^ 1) * 256 + erd), eC1 = *(const LAS u32x4*)(ebuf + ((par) ^ 1) * 256 + erd + 16); \
            const u32x4 h0 = *(const LAS u32x4*)(ebuf + (par) * 512 + brd), h1 = *(const LAS u32x4*)(ebuf + (par) * 512 + brd + 64), h2_ = *(const LAS u32x4*)(ebuf + (par) * 512 + brd + 128), h3 = *(const LAS u32x4*)(ebuf + (par) * 512 + brd + 192); \
            asm volatile("s_waitcnt lgkmcnt(0)" ::: "memory");                    \
            U_TILES(eC0, eC1); \
            const i32x8 A0_ = {(int)h0.x, (int)h0.y, (int)h0.z, (int)h0.w, (int)h1.x, (int)h1.y, (int)h1.z, (int)h1.w}; \
            const i32x8 A1_ = {(int)h2_.x, (int)h2_.y, (int)h2_.z, (int)h2_.w, (int)h3.x, (int)h3.y, (int)h3.z, (int)h3.w}; \
            float res[8]; \
            _Pragma("unroll") for (int T = 0; T < 8; ++T) { \
                const i32x8 B0_ = {(int)img[2 * T].x, (int)img[2 * T].y, (int)img[2 * T].z, (int)img[2 * T].w, 0, 0, 0, 0}; \
                const i32x8 B1_ = {(int)img[2 * T + 1].x, (int)img[2 * T + 1].y, (int)img[2 * T + 1].z, (int)img[2 * T + 1].w, 0, 0, 0, 0}; \
                f32x4 d_ = __builtin_amdgcn_mfma_scale_f32_16x16x128_f8f6f4(A0_, B0_, (f32x4){0.f, 0.f, 0.f, 0.f}, 0, 4, 0, 0, 0, 0); \
                d_ = __builtin_amdgcn_mfma_scale_f32_16x16x128_f8f6f4(A1_, B1_, d_, 0, 4, 0, 0, 0, 0); \
                res[T] = d_[0]; }                                  \
              \
            unsigned d2_[8]; \
            _Pragma("unroll") for (int T = 0; T < 8; ++T) { const float p_ = dpp_r8(res[T]); d2_[T] = (n < 8) ? pk2(res[T], p_) : pk2(p_, res[T]); } \
            if (lane < 16) *(u32x4*)(part + (size_t)(tok) * 128 + 16 * (n & 7) + 8 * (n >> 3)) = (n < 8) ? (u32x4){d2_[0], d2_[1], d2_[2], d2_[3]} : (u32x4){d2_[4], d2_[5], d2_[6], d2_[7]}; \
        } while (0)
        {
            U_DMA_E(tok0, 0); U_DMA_E(tok0 + 1, 1); U_DMA_B(tok0, 0);
            asm volatile("s_waitcnt vmcnt(0)" ::: "memory");
            const u32x4 eX0 = *(const LAS u32x4*)(ebuf + erd), eX1 = *(const LAS u32x4*)(ebuf + erd + 16);
            asm volatile("s_waitcnt lgkmcnt(0)" ::: "memory");
            U_TILES(eX0, eX1);
            U_DMA_E(tok0 + 1, 1);
        }
        for (int tt = 0; tt < 128; tt += 2) {
            const int t0 = tok0 + tt, t1 = t0 + 1, t2 = min(t0 + 2, tokl), t3 = min(t0 + 3, tokl);
            U_TOKEN(t0, 0, t1, t2);
            U_TOKEN(t1, 1, t2, t3);
        }
        asm volatile("s_waitcnt vmcnt(0)" ::: "memory");
#undef U_TOKEN
#undef U_TILES
#undef U_DMA_B
#undef U_DMA_E
    }
}
__device__ __forceinline__ void peer_w_phase(Frame& F) {
    const u32x4* PART = (const u32x4*)(F.ws + WS_PART); const u32x4* PG = (const u32x4*)(F.ws + WS_PG); const u32x4* PE = (const u32x4*)(F.ws + WS_PE); const float* vs = (const float*)(F.ws + WS_VS); const float* us = (const float*)(F.ws + WS_US);
    const size_t n16 = (size_t)MT * 8, stride = (size_t)F.G * 512, slice = (size_t)MT * 16;
    for (size_t p = (size_t)blockIdx.x * 512 + F.tid; p < n16; p += stride) {
        float s[16];
#pragma unroll
        for (int e = 0; e < 16; ++e) s[e] = 0.f;
#pragma unroll
        for (int x = 0; x < 4; ++x) {
#pragma unroll
            for (int h = 0; h < 2; ++h) { const u32x4 w_ = PART[(size_t)x * slice + 2 * p + h];
                s[8 * h + 0] += bf_lo(w_.x); s[8 * h + 1] += bf_hi(w_.x); s[8 * h + 2] += bf_lo(w_.y); s[8 * h + 3] += bf_hi(w_.y); s[8 * h + 4] += bf_lo(w_.z); s[8 * h + 5] += bf_hi(w_.z); s[8 * h + 6] += bf_lo(w_.w); s[8 * h + 7] += bf_hi(w_.w); } }
        float o[16]; float mx = 0.f;
#pragma unroll
        for (int h = 0; h < 2; ++h) { const u32x4 g_ = PG[2 * p + h], e_ = PE[2 * p + h];
#pragma unroll
            for (int k = 0; k < 4; ++k) { const unsigned gw = g_[k], ew = e_[k]; const int e0 = (int)(ew & 0xffffu), e1 = (int)(ew >> 16);
                const float o0 = bf_lo(gw) * gelu_erf(s[8 * h + 2 * k] * us[e0]) * vs[e0], o1 = bf_hi(gw) * gelu_erf(s[8 * h + 2 * k + 1] * us[e1]) * vs[e1];
                o[8 * h + 2 * k] = o0; o[8 * h + 2 * k + 1] = o1; mx = fmaxf(mx, fmaxf(fabsf(o0), fabsf(o1))); } }
#pragma unroll
        for (int off = 1; off < 8; off <<= 1) mx = fmaxf(mx, __shfl_xor(mx, off));
        const float inv = mx > 0.f ? 256.f / mx : 0.f;
        u32x4 hi4, lo4;
#pragma unroll
        for (int k = 0; k < 4; ++k) { const float a0 = o[4 * k] * inv, a1 = o[4 * k + 1] * inv, a2 = o[4 * k + 2] * inv, a3 = o[4 * k + 3] * inv;
            int hw = 0; hw = __builtin_amdgcn_cvt_pk_fp8_f32(a0, a1, hw, false); hw = __builtin_amdgcn_cvt_pk_fp8_f32(a2, a3, hw, true);
            int lw = 0; lw = __builtin_amdgcn_cvt_pk_fp8_f32(16.f * (a0 - __builtin_amdgcn_cvt_f32_fp8(hw, 0)), 16.f * (a1 - __builtin_amdgcn_cvt_f32_fp8(hw, 1)), lw, false);
            lw = __builtin_amdgcn_cvt_pk_fp8_f32(16.f * (a2 - __builtin_amdgcn_cvt_f32_fp8(hw, 2)), 16.f * (a3 - __builtin_amdgcn_cvt_f32_fp8(hw, 3)), lw, true);
            hi4[k] = (unsigned)hw; lo4[k] = (unsigned)lw; }
        unsigned char* rec = F.ws + WS_WB + (p >> 3) * 512; const int q = (int)(p & 7);
        *(u32x4*)(rec + 16 * q) = hi4; *(u32x4*)(rec + 128 + 16 * q) = lo4;
        if (q == 0) *(float*)(rec + 256) = mx * (1.f / 256.f);
    }
}
__device__ __forceinline__ void peer_v_phase(Frame& F) {
    const int lane = F.lane, wave = F.wave, g = lane >> 3, l8 = lane & 7, n = lane & 15, kg = lane >> 4;
    const unsigned char* PE = F.ws + WS_PE; const unsigned char* WB = F.ws + WS_WB; bf16_t* Y = (bf16_t*)(F.ws + WS_Y);
    LAS unsigned char* stg = F.lds + wave * 16384;
    LAS unsigned char* ebuf = F.lds + 131072 + wave * 2048;
    const int soff0 = (l8 ^ (g >> 1)) << 4, soff1 = soff0 ^ 64;
    const int kq = (n >> 1) & 7, tb = (32 * kg + n) * 128;
    unsigned tba[8];
#pragma unroll
    for (int c2 = 0; c2 < 8; ++c2) tba[c2] = (unsigned)(unsigned long)(stg + tb + ((c2 ^ kq) << 4));
    const int erd = 2 * g, ard = 512 + (n & 1) * 128 + kg * 16;
    for (int it = blockIdx.x; it < 256; it += F.G) {
        const int x = it & 3, cb = it >> 2;
        const unsigned char* Vx = F.ws + WS_V8 + (size_t)x * (NEXP * 128);
        const int tok0 = cb * 1024 + wave * 128, tokl = tok0 + 127;
        const unsigned char* pe = PE + lane * 4; const unsigned char* pw = WB + lane * 4; const unsigned char* psc = WB + 256;
#define V_DMA_E(tok, par) __builtin_amdgcn_global_load_lds((const unsigned*)(pe + (size_t)(tok) * 256), (LAS unsigned*)(ebuf + (par) * 256), 4, 0, 0)
#define V_DMA_A(tok, par) do { __builtin_amdgcn_global_load_lds((const unsigned*)(pw + (size_t)(tok) * 512), (LAS unsigned*)(ebuf + 512 + (par) * 512), 4, 0, 0); \
                               __builtin_amdgcn_global_load_lds((const unsigned*)(psc + (size_t)(tok) * 512), (LAS unsigned*)(ebuf + 512 + (par) * 512 + 256), 4, 0, 0); } while (0)
#define V_IDS(par, id) do { _Pragma("unroll") for (int j_ = 0; j_ < 16; ++j_) id[j_] = *(const LAS unsigned short*)(ebuf + (par) * 256 + 16 * j_ + erd); } while (0)
#define V_TILES(id) do { _Pragma("unroll") for (int j_ = 0; j_ < 16; ++j_) \
        __builtin_amdgcn_global_load_lds((const unsigned*)(Vx + (size_t)id[j_] * 128 + ((j_ & 1) ? soff1 : soff0)), (LAS unsigned*)(stg + j_ * 1024), 16, 0, 0); } while (0)
#define V_TOKEN(tok, par, tokn1, tokn2) do { \
            V_DMA_E(tokn2, par); V_DMA_A(tokn1, (par) ^ 1); \
              \
            asm volatile("s_waitcnt vmcnt(5)" ::: "memory"); \
            i32x2 bt[32]; unsigned id[16]; \
              \
            _Pragma("unroll") for (int c = 0; c < 16; ++c) { \
                asm volatile("ds_read_b64_tr_b4 %0, %1 offset:%2" : "=v"(bt[2 * c]) : "v"(tba[c >> 1]), "n"((c & 1) * 8)); \
                asm volatile("ds_read_b64_tr_b4 %0, %1 offset:%2" : "=v"(bt[2 * c + 1]) : "v"(tba[c >> 1]), "n"((c & 1) * 8 + 2048)); } \
            V_IDS((par) ^ 1, id); \
            const u32x4 a0 = *(const LAS u32x4*)(ebuf + (par) * 512 + ard), a1 = *(const LAS u32x4*)(ebuf + (par) * 512 + ard + 64); \
            const float wsc = *(const LAS float*)(ebuf + 512 + (par) * 512 + 256); \
            asm volatile("s_waitcnt lgkmcnt(0)" : "+v"(bt[0]), "+v"(bt[1]), "+v"(bt[2]), "+v"(bt[3]), "+v"(bt[4]), "+v"(bt[5]), "+v"(bt[6]), "+v"(bt[7]), "+v"(bt[8]), "+v"(bt[9]), "+v"(bt[10]), "+v"(bt[11]) :: "memory");    \
            asm volatile("" : "+v"(bt[12]), "+v"(bt[13]), "+v"(bt[14]), "+v"(bt[15]), "+v"(bt[16]), "+v"(bt[17]), "+v"(bt[18]), "+v"(bt[19]), "+v"(bt[20]), "+v"(bt[21]), "+v"(bt[22]), "+v"(bt[23])); \
            asm volatile("" : "+v"(bt[24]), "+v"(bt[25]), "+v"(bt[26]), "+v"(bt[27]), "+v"(bt[28]), "+v"(bt[29]), "+v"(bt[30]), "+v"(bt[31])); \
            V_TILES(id); \
            const i32x8 A_ = {(int)a0.x, (int)a0.y, (int)a0.z, (int)a0.w, (int)a1.x, (int)a1.y, (int)a1.z, (int)a1.w}; \
            float res[16]; \
            _Pragma("unroll") for (int c = 0; c < 16; ++c) { \
                const i32x8 B_ = {bt[2 * c].x, bt[2 * c].y, bt[2 * c + 1].x, bt[2 * c + 1].y, 0, 0, 0, 0}; \
                const f32x4 d_ = __builtin_amdgcn_mfma_scale_f32_16x16x128_f8f6f4(A_, B_, (f32x4){0.f, 0.f, 0.f, 0.f}, 0, 4, 0, 0, 0, 0); \
                res[c] = (d_[0] + d_[1] * 0.0625f) * wsc; }                          \
            _Pragma("unroll") for (int c = 0; c < 16; ++c) asm volatile("" : "+v"(res[c]));        \
            if (lane < 16) { u32x4* yp = (u32x4*)(Y + (size_t)(tok) * 1024 + x * 256 + 16 * n); \
                yp[0] = (u32x4){pk2(res[0], res[1]), pk2(res[2], res[3]), pk2(res[4], res[5]), pk2(res[6], res[7])}; \
                yp[1] = (u32x4){pk2(res[8], res[9]), pk2(res[10], res[11]), pk2(res[12], res[13]), pk2(res[14], res[15])}; } \
        } while (0)
        {
            V_DMA_E(tok0, 0); V_DMA_E(tok0 + 1, 1); V_DMA_A(tok0, 0);
            asm volatile("s_waitcnt vmcnt(0)" ::: "memory");
            unsigned id[16]; V_IDS(0, id);
            asm volatile("s_waitcnt lgkmcnt(0)" ::: "memory");
            V_TILES(id);
            V_DMA_A(tok0, 0);
        }
        for (int tt = 0; tt < 128; tt += 2) {
            const int t0 = tok0 + tt, t1 = t0 + 1, t2 = min(t0 + 2, tokl), t3 = min(t0 + 3, tokl);
            V_TOKEN(t0, 0, t1, t2);
            V_TOKEN(t1, 1, t2, t3);
        }
        asm volatile("s_waitcnt vmcnt(0)" ::: "memory");
#undef V_TOKEN
#undef V_TILES
#undef V_IDS
#undef V_DMA_A
#undef V_DMA_E
    }
}
__device__ __forceinline__ void final_phase(Frame& F) {
    const bf16_t* Y = (const bf16_t*)(F.ws + WS_Y); const float* mod = (const float*)(F.ws + WS_MOD);
    const int gw = F.vcu * 8 + F.wave, NGW = F.G * 8;
    int tid_ = threadIdx.x; asm volatile("" : "+v"(tid_));
    const int lane = tid_ & 63;
    f32x4 fg[4];
#pragma unroll
    for (int j = 0; j < 4; ++j) fg[j] = *(const f32x4*)(F.final_g + 4 * lane + 256 * j);
    for (int tokb = gw * 32; tokb < MT; tokb += NGW * 32) {
        const int b = tokb >> 12;
        f32x4 g2[4];
#pragma unroll
        for (int j = 0; j < 4; ++j) g2[j] = *(const f32x4*)(mod + b * 6144 + 5120 + 4 * lane + 256 * j);
        for (int tok = tokb; tok < tokb + 32; ++tok) {
            float* orow = F.out + (size_t)tok * 1024 + 4 * lane;
            const bf16_t* xrow = (const bf16_t*)F.out + (size_t)tok * 2048 + 4 * lane; const bf16_t* yrow = Y + (size_t)tok * 1024 + 4 * lane;
            u32x2 w[4], yv[4];
#pragma unroll
            for (int j = 0; j < 4; ++j) { w[j] = *(const u32x2*)(xrow + 256 * j); yv[j] = *(const u32x2*)(yrow + 256 * j); }
            asm volatile("s_waitcnt vmcnt(0)" ::: "memory");
            f32x4 v[4]; float ss = 0.f;
#pragma unroll
            for (int j = 0; j < 4; ++j) { v[j] = (f32x4){bf_lo(w[j].x), bf_hi(w[j].x), bf_lo(w[j].y), bf_hi(w[j].y)} + g2[j] * (f32x4){bf_lo(yv[j].x), bf_hi(yv[j].x), bf_lo(yv[j].y), bf_hi(yv[j].y)};
                ss += v[j][0] * v[j][0] + v[j][1] * v[j][1] + v[j][2] * v[j][2] + v[j][3] * v[j][3]; }
            ss = wave_sum(ss);
            const float rstd = 1.0f / sqrtf(ss * (1.f / 1024.f) + NORM_EPS);
#pragma unroll
            for (int j = 0; j < 4; ++j) *(f32x4*)(orow + 256 * j) = v[j] * rstd * fg[j];
        }
    }
}

#ifndef MK_N_LAUNCHES
#define MK_N_LAUNCHES 1
#endif
constexpr int N_PHASES = 9;
struct Args { const float* in[16]; float* out; unsigned char* ws; int ph_lo, ph_hi; };
__global__ void __launch_bounds__(512, 2) mk_fwd(Args args) {
    extern __shared__ __attribute__((aligned(16))) unsigned char lds[];
    Frame F;
    F.lds = (LAS unsigned char*)lds;
    F.tid = threadIdx.x; F.lane = F.tid & 63; F.wave = __builtin_amdgcn_readfirstlane(F.tid >> 6);
    F.G = gridDim.x; { const int bx = blockIdx.x; F.vcu = (F.G % 8 == 0) ? (bx % 8) * (F.G / 8) + bx / 8 : bx; }
    F.x = args.in[0]; F.c = args.in[1]; F.rel_bias = args.in[2]; F.w_ada = args.in[3]; F.b_ada = args.in[4]; F.norm1_g = args.in[5]; F.w_in = args.in[6]; F.diff_lambda = args.in[7];
    F.subln_g = args.in[8]; F.w_out = args.in[9]; F.norm2_g = args.in[10]; F.peer_wq = args.in[11]; F.peer_keys = args.in[12]; F.peer_u = args.in[13]; F.peer_v = args.in[14]; F.final_g = args.in[15];
    F.out = args.out; F.ws = args.ws;
    volatile LAS unsigned* MISC = (volatile LAS unsigned*)(F.lds + MISC_OFF);
    if (F.tid < 64) MISC[F.tid] = 0u;
    __syncthreads();
    XcdBarrier bar; bar.bar = (unsigned*)(F.ws + WS_CTL) + CW_BAR; bar.x = 0; bar.st = nullptr;
    const int lo = args.ph_lo, hi = args.ph_hi;
    if (hi - lo > 1) bar = xcd_barrier_post((unsigned*)(F.ws + WS_CTL) + CW_BAR, MISC + 8);
#define IN(k) (lo <= (k) && (k) < hi)
#define SEAM(k) do { if (IN(k) && IN((k) + 1)) xcd_barrier(bar); } while (0)
    bf16_t* H = (bf16_t*)(F.ws + WS_H);
    if (IN(0)) { p0_prologue(F); }
    if (IN(0) && IN(1)) {
        if (F.tid == 0) { unsigned* cm = (unsigned*)(F.ws + WS_CTL) + CW_MOD; XB_SPIN(xb_ld(cm) < 192u, bar.bar); __builtin_amdgcn_fence(__ATOMIC_ACQUIRE, "agent"); asm volatile("s_waitcnt vmcnt(0)" ::: "memory"); }
        __syncthreads();
    }
    if (IN(1)) { norm_phase<false>(F, F.x, F.norm1_g, 0, 1024, H, nullptr); } SEAM(1);
    if (IN(2)) {
        { pg8::Gemm g{H, (const bf16_t*)(F.ws + WS_WQK), MT, 2048, 1024}; pg8::StaticOrder S; S.init(MT, 2048, F.G, (int)blockIdx.x);
          pg8::EpiQK E{(bf16_t*)(F.ws + WS_QK), (float*)(F.ws + WS_KSUM), C2};
          pg8::gemm_phase<pg8::EpiQK, pg8::StaticOrder, true, true>(F.lds, g, S, E); }
        __syncthreads();
        { pg8::Gemm g{(const bf16_t*)(F.ws + WS_WV), H, 1024, MT, 1024}; pg8::StaticOrder S; S.init(1024, MT, F.G, (int)blockIdx.x);
          pg8::EpiVT E{(bf16_t*)(F.ws + WS_VT), MT};
          pg8::gemm_phase<pg8::EpiVT, pg8::StaticOrder, true, true>(F.lds, g, S, E); }
    } SEAM(2);
    if (IN(3)) { attn_phase(F); } SEAM(3);
    if (IN(4)) {
        const int pm = (int)blockIdx.x;
        { pg8::Gemm g{(const bf16_t*)(F.ws + WS_AO), (const bf16_t*)(F.ws + WS_WO), MT, 1024, 1024}; pg8::PanelOrder S{pm, 4};
          pg8::EpiRes E{F.x, (bf16_t*)F.out, (const float*)(F.ws + WS_MOD)};
          pg8::gemm_phase<pg8::EpiRes, pg8::PanelOrder, true, true>(F.lds, g, S, E); }
        __syncthreads();
        norm_phase<true>(F, F.out, F.norm2_g, 3072, 4096, H, F.ws + WS_H8);
        asm volatile("s_waitcnt vmcnt(0)" ::: "memory"); __syncthreads();
        float* scp = (float*)(F.ws + (pm < 192 ? WS_SCA + (size_t)pm * (2 * MiB) : WS_SCB + (size_t)(pm - 192) * (2 * MiB)));
        { pg8::Gemm g{(const bf16_t*)(F.ws + WS_H8), (const bf16_t*)(F.ws + WS_WC8), MT, 2048, 512}; pg8::PanelOrder S{pm, 8};
          pg8::EpiSC E{scp};
          pg8::gemm_phase<pg8::EpiSC, pg8::PanelOrder, true, true, true>(F.lds, g, S, E); }
        __syncthreads();
        topk_panel(F, scp, pm);
    } SEAM(4);
    if (IN(5)) { peer_u_phase(F); } SEAM(5);
    if (IN(6)) { peer_w_phase(F); } SEAM(6);
    if (IN(7)) { peer_v_phase(F); } SEAM(7);
    if (IN(8)) { final_phase(F); }
#undef IN
#undef SEAM
}

extern "C" void kernel_launch(void* const* d_in, const int* in_sizes, int n_in, void* d_out, int out_size, void* d_ws, size_t ws_size, hipStream_t stream) {
    static int grid = 0;
    if (grid == 0) {
        if (n_in != 16 || in_sizes[0] != MT * DM || out_size != MT * DM || ws_size < WS_END) { fprintf(stderr, "kernel_launch: unexpected shapes (n_in %d, in0 %d, out %d, ws %zu); nothing launched\n", n_in, n_in > 0 ? in_sizes[0] : -1, out_size, ws_size); grid = -1; return; }
        int dev = 0, cus = 0, per_cu = 0;
        if (hipGetDevice(&dev) != hipSuccess || hipDeviceGetAttribute(&cus, hipDeviceAttributeMultiprocessorCount, dev) != hipSuccess) { grid = -1; return; }
        if (hipFuncSetAttribute((const void*)mk_fwd, hipFuncAttributeMaxDynamicSharedMemorySize, LDS_BYTES) != hipSuccess) { fprintf(stderr, "kernel_launch: hipFuncSetAttribute failed\n"); grid = -1; return; }
        if (hipOccupancyMaxActiveBlocksPerMultiprocessor(&per_cu, (const void*)mk_fwd, 512, LDS_BYTES) != hipSuccess || per_cu < 1) fprintf(stderr, "kernel_launch: note: occupancy query reports %d\n", per_cu);
        (void)hipGetLastError();
        grid = cus;
        if (grid != 256) { fprintf(stderr, "kernel_launch: built for a 256-CU device (one 256-row panel per workgroup in the fused phase); found %d CUs; nothing launched\n", cus); grid = -1; return; }
    }
    if (grid < 0) return;
    if (hipMemsetAsync((char*)d_ws + WS_CTL, 0, CTL_ZERO_BYTES, stream) != hipSuccess) return;
    Args a{};
    for (int i = 0; i < 16; ++i) a.in[i] = (const float*)d_in[i];
    a.out = (float*)d_out; a.ws = (unsigned char*)d_ws;
#if MK_N_LAUNCHES == 1
    a.ph_lo = 0; a.ph_hi = N_PHASES;
    hipLaunchKernelGGL(mk_fwd, dim3(grid), dim3(512), LDS_BYTES, stream, a);
#else
    for (int p = 0; p < N_PHASES; ++p) { a.ph_lo = p; a.ph_hi = p + 1; hipLaunchKernelGGL(mk_fwd, dim3(grid), dim3(512), LDS_BYTES, stream, a); }
#endif
}
```
